# Optimizing an MI355X kernel written in HIP

```python
import jax
import jax.numpy as jnp
from jax import lax
import numpy as np

D_MODEL = 1024
BATCH = 16
SEQ = 2048
DEPTH = 2

GRID_W = 64
CTX_LEN = 256
ML_HEADS = 4
ML_DH = D_MODEL // 16
ML_W = ML_HEADS * ML_DH
ML_CONV = 3
HG_HEADS = 4
HG_DK = D_MODEL // 16
HG_DV = D_MODEL // 16
HG_WK = HG_HEADS * HG_DK
HG_W = HG_HEADS * HG_DV
MLA_HEADS = 8
MLA_NOPE = D_MODEL // 16
MLA_ROPE = D_MODEL // 32
MLA_DQK = MLA_NOPE + MLA_ROPE
MLA_DV = D_MODEL // 16
MLA_W = MLA_HEADS * MLA_DV
MLA_Q_RANK = D_MODEL // 4
MLA_KV_RANK = D_MODEL // 8
MIX_W = ML_W + HG_W + MLA_W
N_EXPERTS = 16
EC_CAPACITY = 2
D_EXPERT = D_MODEL
CHUNK = 64
Q_BLOCK = 128
ROPE_THETA = 10000.0
EPS = 1e-6
IN_SPLITS = (2 * ML_W, ML_W, ML_W, 4 * ML_HEADS,
             HG_WK, HG_W, HG_W, 2 * HG_WK,
             MLA_Q_RANK, MLA_KV_RANK, MLA_ROPE)
D_IN = sum(IN_SPLITS)

kernel_name = 'hybrid_mlstm_hgrn2_mla_ecmoe_dit'


def _rms(x, g):
    xf = x.astype(jnp.float32)
    y = xf * lax.rsqrt(jnp.mean(xf * xf, axis=-1, keepdims=True) + EPS)
    return (y * g.astype(jnp.float32)).astype(x.dtype)


def _heads(a, n_heads):
    b, n, _ = a.shape
    return a.reshape(b, n, n_heads, -1).transpose(0, 2, 1, 3)


def _merge_heads(a):
    b, h, n, d = a.shape
    return a.transpose(0, 2, 1, 3).reshape(b, n, h * d)


def _head_norm_merge(a, g):
    b, h, n, d = a.shape
    return _rms(a.transpose(0, 2, 1, 3), g.reshape(h, d)).reshape(b, n, h * d)


def _dwconv(a, w, bias):
    ch = a.shape[-1]
    y = lax.conv_general_dilated(a, w[:, None, :].astype(a.dtype), window_strides=(1,), padding='SAME',
                                 dimension_numbers=('NWC', 'WIO', 'NWC'), feature_group_count=ch)
    return y + bias.astype(a.dtype)


def _split_proj(h, w_in, b_in):
    points = np.cumsum(IN_SPLITS)[:-1].tolist()
    return jnp.split(h @ w_in + b_in, points, axis=-1)


def _rope_tables(pos):
    half = MLA_ROPE // 2
    inv = ROPE_THETA ** (-jnp.arange(0, half, 2, dtype=jnp.float32) / half)
    ang = pos.astype(jnp.float32)[:, None] * inv[None, :]
    ang = jnp.concatenate([ang, ang], axis=-1)
    return jnp.cos(ang), jnp.sin(ang)


def _rotate(x, cos, sin):
    x1, x2 = jnp.split(x, 2, axis=-1)
    return (x * cos + jnp.concatenate([-x2, x1], axis=-1) * sin).astype(x.dtype)


def _axial_rope(x, rope):
    cos_r, sin_r, cos_c, sin_c = rope
    x_nope, x_row, x_col = jnp.split(x, [MLA_NOPE, MLA_NOPE + MLA_ROPE // 2], axis=-1)
    return jnp.concatenate([x_nope, _rotate(x_row, cos_r, sin_r), _rotate(x_col, cos_c, sin_c)], axis=-1)


def _to_chunks(a):
    b, h, n = a.shape[:3]
    return jnp.moveaxis(a.reshape((b, h, n // CHUNK, CHUNK) + a.shape[3:]), 2, 0)


def _from_chunks(y):
    nc, b, h, l = y.shape[:4]
    return jnp.moveaxis(y, 0, 2).reshape((b, h, nc * l) + y.shape[4:])


def _chunked_scan(out_fn, update_fn, inputs, state0):
    def step(state, chunk):
        return update_fn(state, chunk), out_fn(state, chunk)
    state, ys = lax.scan(step, state0, tuple(_to_chunks(a) for a in inputs))
    return _from_chunks(ys), state


def _mlstm_out(state, chunk):
    c_mat, n_vec, m = state
    q, k, v, log_f, ig = chunk
    L = log_f.shape[-1]
    seen = jnp.tril(jnp.ones((L, L), dtype=bool))
    b = jnp.cumsum(log_f, axis=-1)
    d = jnp.where(seen, b[..., :, None] - b[..., None, :] + ig[..., None, :], -jnp.inf)
    inter = b + m[..., None]
    m_t = jnp.maximum(inter, d.max(axis=-1))
    w_tok = jnp.exp(d - m_t[..., None])
    w_st = jnp.exp(inter - m_t)
    s = jnp.einsum('bhtd,bhsd->bhts', q, k) * w_tok
    num = jnp.einsum('bhts,bhsv->bhtv', s, v) + w_st[..., None] * jnp.einsum('bhtk,bhkv->bhtv', q, c_mat)
    den = s.sum(axis=-1) + w_st * jnp.einsum('bhtk,bhk->bht', q, n_vec)
    return num / jnp.maximum(jnp.abs(den), jnp.exp(-m_t))[..., None]


def _mlstm_update(state, chunk):
    c_mat, n_vec, m = state
    _, k, v, log_f, ig = chunk
    b = jnp.cumsum(log_f, axis=-1)
    b_end = b[..., -1]
    w_log = b_end[..., None] - b + ig
    m_new = jnp.maximum(b_end + m, w_log.max(axis=-1))
    w_tok = jnp.exp(w_log - m_new[..., None])
    w_st = jnp.exp(b_end + m - m_new)
    c_new = w_st[..., None, None] * c_mat + jnp.einsum('bhs,bhsk,bhsv->bhkv', w_tok, k, v)
    n_new = w_st[..., None] * n_vec + jnp.einsum('bhs,bhsk->bhk', w_tok, k)
    return (c_new, n_new, m_new)


def _hgrn_out(s_mat, chunk):
    q, k, v, log_f = chunk
    L = log_f.shape[-2]
    seen = jnp.tril(jnp.ones((L, L), dtype=bool))[:, :, None]
    b = jnp.cumsum(log_f, axis=-2)
    dec = jnp.exp(jnp.where(seen, b[..., :, None, :] - b[..., None, :, :], -jnp.inf))
    a = jnp.einsum('bhtk,bhsk,bhtsk->bhts', q, k, dec)
    return jnp.einsum('bhts,bhsv->bhtv', a, v) + jnp.einsum('bhtk,bhkv->bhtv', q * jnp.exp(b), s_mat)


def _hgrn_update(s_mat, chunk):
    _, k, v, log_f = chunk
    b = jnp.cumsum(log_f, axis=-2)
    b_end = b[..., -1:, :]
    return jnp.exp(b_end[..., 0, :])[..., None] * s_mat + jnp.einsum('bhsk,bhsv->bhkv', k * jnp.exp(b_end - b), v)


def _flip_time(inputs):
    return tuple(jnp.flip(a, axis=2) for a in inputs)


def _bidir_recurrence(out_fn, update_fn, ctx_dirs, lat_dirs, state0, need_ctx):
    y_ctx, y_lat = None, None
    for d in range(2):
        c_in, l_in = ctx_dirs[d], lat_dirs[d]
        if d == 1:
            c_in, l_in = _flip_time(c_in), _flip_time(l_in)
        if need_ctx:
            yc, state = _chunked_scan(out_fn, update_fn, c_in, state0)
            yc = jnp.flip(yc, axis=2) if d == 1 else yc
            y_ctx = yc if y_ctx is None else y_ctx + yc
        else:
            state = update_fn(state0, c_in)
        yl, _ = _chunked_scan(out_fn, update_fn, l_in, state)
        yl = jnp.flip(yl, axis=2) if d == 1 else yl
        y_lat = yl if y_lat is None else y_lat + yl
    return y_ctx, y_lat


def _mlstm_dirs(qk, v, gates):
    f32 = jnp.float32
    q, k = jnp.split(qk, 2, axis=-1)
    q = _heads(q, ML_HEADS).astype(f32)
    k = _heads(k, ML_HEADS).astype(f32) * (ML_DH ** -0.5)
    v = _heads(v, ML_HEADS).astype(f32)
    b, n, _ = gates.shape
    g = jnp.moveaxis(gates.astype(f32).reshape(b, n, 2, 2, ML_HEADS), 1, -1)
    return tuple((q, k, v, jax.nn.log_sigmoid(g[:, d, 1]), g[:, d, 0]) for d in range(2))


def _hgrn_dirs(q, i, f, lb):
    f32 = jnp.float32
    q = _heads(jax.nn.silu(q), HG_HEADS).astype(f32)
    v = _heads(i, HG_HEADS).astype(f32)
    b, n, _ = f.shape
    f = f.astype(f32).reshape(b, n, 2, HG_WK)
    dirs = []
    for d in range(2):
        pre, low = f[:, :, d], lb[d]
        log_f = jnp.logaddexp(jnp.log(low), jnp.log1p(-low) + jax.nn.log_sigmoid(pre))
        k = (1.0 - low) * jax.nn.sigmoid(-pre)
        dirs.append((q, _heads(k, HG_HEADS), v, _heads(log_f, HG_HEADS)))
    return tuple(dirs)


def _mla_q(cq, p, rope):
    b, n, _ = cq.shape
    q = (_rms(cq, p['mla_q_norm_g']) @ p['mla_w_uq']).reshape(b, n, MLA_HEADS, MLA_DQK)
    q = _rms(q, p['mla_q_qk_g']).transpose(0, 2, 1, 3)
    return q if rope is None else _axial_rope(q, rope)


def _mla_kv(ckv, kr, p, rope):
    b, n, _ = ckv.shape
    kv = (_rms(ckv, p['mla_kv_norm_g']) @ p['mla_w_ukv']).reshape(b, n, MLA_HEADS, MLA_NOPE + MLA_DV)
    k_nope, v = jnp.split(kv, [MLA_NOPE], axis=-1)
    k_rope = jnp.broadcast_to(kr[:, :, None, :], (b, n, MLA_HEADS, MLA_ROPE))
    k = _rms(jnp.concatenate([k_nope, k_rope], axis=-1), p['mla_k_qk_g']).transpose(0, 2, 1, 3)
    k = k if rope is None else _axial_rope(k, rope)
    return k, v.transpose(0, 2, 1, 3)


def _attend(q, k, v):
    s = jnp.einsum('bhqd,bhkd->bhqk', q, k).astype(jnp.float32) * (MLA_DQK ** -0.5)
    pr = jax.nn.softmax(s, axis=-1).astype(v.dtype)
    return jnp.einsum('bhqk,bhkd->bhqd', pr, v)


def _block_attend(q, k, v):
    b, h, n, d = q.shape
    qb = jnp.moveaxis(q.reshape(b, h, n // Q_BLOCK, Q_BLOCK, d), 2, 0)
    o = lax.map(lambda qq: _attend(qq, k, v), qb)
    return jnp.moveaxis(o, 0, 2).reshape(b, h, n, -1)


def _token_mixers(hc, hl, rope, lb, p, need_ctx):
    f32 = jnp.float32
    pc = _split_proj(hc, p['w_in'], p['b_in'])
    pl = _split_proj(hl, p['w_in'], p['b_in'])
    bsz = hl.shape[0]

    def ml_dirs(parts):
        qk = jax.nn.silu(_dwconv(parts[0], p['ml_conv_w'], p['ml_conv_b']))
        return _mlstm_dirs(qk, parts[1], parts[3])
    ml_state0 = (jnp.zeros((bsz, ML_HEADS, ML_DH, ML_DH), f32),
                 jnp.zeros((bsz, ML_HEADS, ML_DH), f32),
                 jnp.zeros((bsz, ML_HEADS), f32))
    ml_c, ml_l = _bidir_recurrence(_mlstm_out, _mlstm_update, ml_dirs(pc), ml_dirs(pl), ml_state0, need_ctx)

    hg_state0 = jnp.zeros((bsz, HG_HEADS, HG_DK, HG_DV), f32)
    hg_c, hg_l = _bidir_recurrence(_hgrn_out, _hgrn_update, _hgrn_dirs(pc[4], pc[5], pc[7], lb),
                                   _hgrn_dirs(pl[4], pl[5], pl[7], lb), hg_state0, need_ctx)

    k_c, v_c = _mla_kv(pc[9], pc[10], p, None)
    k_l, v_l = _mla_kv(pl[9], pl[10], p, rope)
    q_l = _mla_q(pl[8], p, rope)
    at_l = _block_attend(q_l, jnp.concatenate([k_c, k_l], axis=2), jnp.concatenate([v_c, v_l], axis=2))

    def merge(parts, ml, hg, at, dtype):
        y = jnp.concatenate([
            _head_norm_merge(ml, p['ml_norm_g']) * jax.nn.sigmoid(parts[2].astype(f32)),
            _head_norm_merge(hg, p['hg_norm_g']) * jax.nn.silu(parts[6].astype(f32)),
            _merge_heads(at).astype(f32)], axis=-1).astype(dtype)
        return y @ p['w_out']

    y_lat = merge(pl, ml_l, hg_l, at_l, hl.dtype)
    if not need_ctx:
        return None, y_lat
    at_c = _attend(_mla_q(pc[8], p, None), k_c, v_c)
    return merge(pc, ml_c, hg_c, at_c, hc.dtype), y_lat


def _expert_choice_ffn(h, router_w, w_gate, w_up, w_down):
    b, n, _ = h.shape
    cap = EC_CAPACITY * n // N_EXPERTS
    aff = jax.nn.softmax((h @ router_w).astype(jnp.float32), axis=-1)
    gate, idx = lax.top_k(jnp.swapaxes(aff, 1, 2), cap)
    bidx = jnp.arange(b)[:, None, None]
    xs = h[bidx, idx]
    hid = jax.nn.silu(jnp.einsum('becd,edf->becf', xs, w_gate)) * jnp.einsum('becd,edf->becf', xs, w_up)
    out = jnp.einsum('becf,efd->becd', hid, w_down) * gate[..., None].astype(h.dtype)
    return jnp.zeros_like(h).at[bidx, idx].add(out)


def setup_inputs(seed: int = 0) -> dict:
    key = jax.random.key(seed)
    ks = jax.random.split(key, 26)
    nrm = jax.random.normal
    f32 = jnp.float32
    D, L = D_MODEL, DEPTH
    fb = np.zeros((D_IN,), np.float32)
    off = 4 * ML_W
    fb[off + ML_HEADS: off + 2 * ML_HEADS] = np.linspace(3.0, 6.0, ML_HEADS)
    fb[off + 3 * ML_HEADS: off + 4 * ML_HEADS] = np.linspace(3.0, 6.0, ML_HEADS)
    return {
        'x': nrm(ks[0], (BATCH, SEQ, D), f32),
        'c': nrm(ks[1], (BATCH, D), f32),
        'ctx': nrm(ks[2], (BATCH, CTX_LEN, D), f32),
        'c_ctx': nrm(ks[3], (D,), f32),
        'ada_w': nrm(ks[4], (L, D, 6 * D), f32) * (0.5 * D ** -0.5),
        'ada_b': nrm(ks[5], (L, 6 * D), f32) * 0.02,
        'norm1_g': 1.0 + 0.05 * nrm(ks[6], (L, D), f32),
        'norm2_g': 1.0 + 0.05 * nrm(ks[7], (L, D), f32),
        'w_in': nrm(ks[8], (L, D, D_IN), f32) * D ** -0.5,
        'b_in': nrm(ks[9], (L, D_IN), f32) * 0.02 + jnp.asarray(fb),
        'ml_conv_w': nrm(ks[10], (L, ML_CONV, 2 * ML_W), f32) * ML_CONV ** -0.5,
        'ml_conv_b': nrm(ks[11], (L, 2 * ML_W), f32) * 0.02,
        'ml_norm_g': 1.0 + 0.05 * nrm(ks[12], (L, ML_W), f32),
        'hg_lb_logits': nrm(ks[13], (L, 2, HG_WK), f32) * 0.1,
        'hg_norm_g': 1.0 + 0.05 * nrm(ks[14], (L, HG_W), f32),
        'mla_q_norm_g': 1.0 + 0.05 * nrm(ks[15], (L, MLA_Q_RANK), f32),
        'mla_w_uq': nrm(ks[16], (L, MLA_Q_RANK, MLA_HEADS * MLA_DQK), f32) * MLA_Q_RANK ** -0.5,
        'mla_kv_norm_g': 1.0 + 0.05 * nrm(ks[17], (L, MLA_KV_RANK), f32),
        'mla_w_ukv': nrm(ks[18], (L, MLA_KV_RANK, MLA_HEADS * (MLA_NOPE + MLA_DV)), f32) * MLA_KV_RANK ** -0.5,
        'mla_q_qk_g': 1.0 + 0.05 * nrm(ks[19], (L, MLA_DQK), f32),
        'mla_k_qk_g': 1.0 + 0.05 * nrm(ks[20], (L, MLA_DQK), f32),
        'w_out': nrm(ks[21], (L, MIX_W, D), f32) * MIX_W ** -0.5,
        'router_w': nrm(ks[22], (L, D, N_EXPERTS), f32) * D ** -0.5,
        'ex_w_gate': nrm(ks[23], (L, N_EXPERTS, D, D_EXPERT), f32) * D ** -0.5,
        'ex_w_up': nrm(ks[24], (L, N_EXPERTS, D, D_EXPERT), f32) * D ** -0.5,
        'ex_w_down': nrm(ks[25], (L, N_EXPERTS, D_EXPERT, D), f32) * D_EXPERT ** -0.5,
    }


def reference(x, c, ctx, c_ctx, ada_w, ada_b, norm1_g, norm2_g, w_in, b_in, ml_conv_w, ml_conv_b,
              ml_norm_g, hg_lb_logits, hg_norm_g, mla_q_norm_g, mla_w_uq, mla_kv_norm_g, mla_w_ukv,
              mla_q_qk_g, mla_k_qk_g, w_out, router_w, ex_w_gate, ex_w_up, ex_w_down):
    n_lat = x.shape[1]
    rows = n_lat // GRID_W
    row_pos = jnp.repeat(jnp.arange(rows), GRID_W)
    col_pos = jnp.broadcast_to(jnp.arange(GRID_W), (rows, GRID_W)).reshape(-1)
    cos_r, sin_r = _rope_tables(row_pos)
    cos_c, sin_c = _rope_tables(col_pos)
    rope = (cos_r, sin_r, cos_c, sin_c)

    lb_all = jnp.cumsum(jax.nn.softmax(hg_lb_logits.astype(jnp.float32), axis=0), axis=0)
    lb_all = lb_all - lb_all[:1]

    for layer in range(DEPTH):
        need_ctx = layer < DEPTH - 1
        p = {'w_in': w_in[layer], 'b_in': b_in[layer], 'ml_conv_w': ml_conv_w[layer],
             'ml_conv_b': ml_conv_b[layer], 'ml_norm_g': ml_norm_g[layer], 'hg_norm_g': hg_norm_g[layer],
             'mla_q_norm_g': mla_q_norm_g[layer], 'mla_w_uq': mla_w_uq[layer],
             'mla_kv_norm_g': mla_kv_norm_g[layer], 'mla_w_ukv': mla_w_ukv[layer],
             'mla_q_qk_g': mla_q_qk_g[layer], 'mla_k_qk_g': mla_k_qk_g[layer], 'w_out': w_out[layer]}
        mod = jnp.split(jax.nn.silu(c) @ ada_w[layer] + ada_b[layer], 6, axis=-1)
        sh1, sc1, g1, sh2, sc2, g2 = [m[:, None, :] for m in mod]
        csh1, csc1, cg1, csh2, csc2, cg2 = jnp.split(jax.nn.silu(c_ctx) @ ada_w[layer] + ada_b[layer], 6, axis=-1)

        hl = _rms(x, norm1_g[layer]) * (1.0 + sc1) + sh1
        hc = _rms(ctx, norm1_g[layer]) * (1.0 + csc1) + csh1
        y_ctx, y_lat = _token_mixers(hc, hl, rope, lb_all[layer], p, need_ctx)
        x = x + g1 * y_lat
        x = x + g2 * _expert_choice_ffn(_rms(x, norm2_g[layer]) * (1.0 + sc2) + sh2, router_w[layer],
                                        ex_w_gate[layer], ex_w_up[layer], ex_w_down[layer])
        if need_ctx:
            ctx = ctx + cg1 * y_ctx
            ctx = ctx + cg2 * _expert_choice_ffn(_rms(ctx, norm2_g[layer]) * (1.0 + csc2) + csh2, router_w[layer],
                                                 ex_w_gate[layer], ex_w_up[layer], ex_w_down[layer])
    return x
```

```cpp
#ifndef EMU
#include <hip/hip_runtime.h>
#include <hip/hip_cooperative_groups.h>
#endif
#include <cstdio>
#include <cstdint>
#include <cmath>

#ifndef BATCH
#define BATCH 16
#endif
#ifndef SEQ
#define SEQ 2048
#endif
#ifndef CTXL
#define CTXL 256
#endif

#define DEV __device__ __forceinline__
typedef unsigned short bf16_t;
typedef short bf16x8 __attribute__((ext_vector_type(8)));
typedef short bf16x4 __attribute__((ext_vector_type(4)));
typedef float f32x16 __attribute__((ext_vector_type(16)));
typedef float f32x4 __attribute__((ext_vector_type(4)));
typedef unsigned int u32x4 __attribute__((ext_vector_type(4)));
typedef unsigned int u32x2 __attribute__((ext_vector_type(2)));

constexpr int D = 1024;
constexpr int T = CTXL + SEQ;
constexpr int R = BATCH * T;
constexpr int NTHR = 256;
constexpr int DIN_P = 2816;
constexpr int PBW = 2208;
constexpr int NEXP = 16;
constexpr int CAP_L = SEQ / 8, CAP_C = CTXL / 8;
constexpr int NC = T / 64;
constexpr float EPS = 1e-6f;
constexpr int PB_MLQK = 0, PB_MLV = 512, PB_MLOG = 768, PB_HGQ = 1024, PB_HGV = 1280, PB_HGOG = 1536, PB_CQ = 1792, PB_CKV = 2048, PB_KR = 2176;

constexpr size_t al256(size_t x) { return (x + 255) & ~(size_t)255; }
constexpr size_t SZ_WIN = (size_t)DIN_P * 1024 * 2, SZ_WUQ = 768 * 256 * 2, SZ_WUKV = 1024 * 128 * 2, SZ_WOUT = 1024 * 1024 * 2;
constexpr size_t SZ_WGU = (size_t)NEXP * 2048 * 1024 * 2, SZ_WD = (size_t)NEXP * 1024 * 1024 * 2, SZ_WR = 32 * 1024 * 2;
constexpr size_t OFF_WIN = 0;
constexpr size_t OFF_WUQ = OFF_WIN + SZ_WIN;
constexpr size_t OFF_WUKV = OFF_WUQ + SZ_WUQ;
constexpr size_t OFF_WOUT = OFF_WUKV + SZ_WUKV;
constexpr size_t OFF_WGU = OFF_WOUT + SZ_WOUT;
constexpr size_t OFF_WD = OFF_WGU + SZ_WGU;
constexpr size_t OFF_WR = OFF_WD + SZ_WD;
constexpr size_t OFF_BPERM = OFF_WR + SZ_WR;
constexpr size_t OFF_PB = al256(OFF_BPERM + DIN_P * 4);
constexpr int ME_MAX = BATCH * (CAP_L + CAP_C);
constexpr size_t SZ_PB = ((size_t)R * PBW * 2 > (size_t)NEXP * ME_MAX * 1024 * 2) ? (size_t)R * PBW * 2 : (size_t)NEXP * ME_MAX * 1024 * 2;
constexpr size_t OFF_PF = al256(OFF_PB + SZ_PB);
constexpr size_t OFF_GT = al256(OFF_PF + (size_t)R * 512 * 4);
constexpr size_t OFF_CX = al256(OFF_GT + (size_t)R * 16 * 4);
constexpr size_t OFF_QKV = al256(OFF_CX + (size_t)BATCH * CTXL * D * 4);
constexpr size_t SZ_Q = (size_t)BATCH * 8 * T * 96 * 2, SZ_V = (size_t)BATCH * 8 * T * 64 * 2;
constexpr size_t SZ_QKV = (2 * SZ_Q + SZ_V > (size_t)R * 1024 * 2) ? 2 * SZ_Q + SZ_V : (size_t)R * 1024 * 2;
constexpr size_t OFF_H = al256(OFF_QKV + SZ_QKV);
constexpr size_t OFF_MODS = al256(OFF_H + (size_t)R * 1024 * 2);
constexpr size_t OFF_LB = al256(OFF_MODS + (size_t)2 * (BATCH + 1) * 6144 * 4);
constexpr size_t OFF_ROPE = al256(OFF_LB + 2 * 512 * 4);
constexpr size_t OFF_AFF = al256(OFF_ROPE + (size_t)SEQ * 32 * 4);
constexpr size_t OFF_SELR = al256(OFF_AFF + (size_t)R * 16 * 4);
constexpr size_t OFF_SELG = al256(OFF_SELR + (size_t)NEXP * ME_MAX * 4);
constexpr size_t OFF_BAR = al256(OFF_SELG + (size_t)NEXP * ME_MAX * 4);
constexpr size_t WS_TOTAL = OFF_BAR + 65536;

struct Params {
    const float *x, *c, *ctx, *c_ctx, *ada_w, *ada_b, *norm1_g, *norm2_g, *w_in, *b_in, *ml_conv_w, *ml_conv_b, *ml_norm_g,
        *hg_lb, *hg_norm_g, *mla_q_norm_g, *mla_w_uq, *mla_kv_norm_g, *mla_w_ukv, *mla_q_qk_g, *mla_k_qk_g, *w_out, *router_w,
        *ex_w_gate, *ex_w_up, *ex_w_down;
    float* out;
    char* ws;
};

#ifdef EMU
DEV float bf2f(bf16_t v) { unsigned u = (unsigned)v << 16; float f; memcpy(&f, &u, 4); return f; }
DEV bf16_t f2bf(float x) { unsigned u; memcpy(&u, &x, 4); if ((u & 0x7fffffffu) > 0x7f800000u) return 0x7fc0; u += 0x7fffu + ((u >> 16) & 1u); return (bf16_t)(u >> 16); }
DEV f32x16 mfma32(bf16x8 a, bf16x8 b, f32x16 c) {
    emu::Wave* w = emu::cur->wave; int p = emu::wave_arrive_begin(); int lane = emu::cur->lane;
    for (int j = 0; j < 8; ++j) { w->fa[p][lane][j] = bf2f((bf16_t)a[j]); w->fb[p][lane][j] = bf2f((bf16_t)b[j]); }
    emu::wave_arrive_wait();
    int col = lane & 31, h = lane >> 5;
    for (int r = 0; r < 16; ++r) {
        int row = (r & 3) + 8 * (r >> 2) + 4 * h; float s = c[r];
        for (int k = 0; k < 16; ++k) s += w->fa[p][row + 32 * (k >> 3)][k & 7] * w->fb[p][col + 32 * (k >> 3)][k & 7];
        c[r] = s;
    }
    return c;
}
DEV float shfl_xor_f(float v, int m) { unsigned u; memcpy(&u, &v, 4); u = emu::shfl_u32(u, emu::cur->lane ^ m); float f; memcpy(&f, &u, 4); return f; }
DEV float shfl_up_f(float v, int d) { unsigned u; memcpy(&u, &v, 4); int l = emu::cur->lane; u = emu::shfl_u32(u, l >= d ? l - d : l); float f; memcpy(&f, &u, 4); return f; }
#define LAUNCH(kern, grid, smem, stream, ...) emu::launch(dim3(grid), dim3(NTHR), smem, false, [=]() { kern(__VA_ARGS__); })
#else
DEV float bf2f(bf16_t v) { return __builtin_bit_cast(float, (unsigned)v << 16); }
DEV bf16_t f2bf(float x) { return __builtin_bit_cast(unsigned short, (__bf16)x); }
DEV f32x16 mfma32(bf16x8 a, bf16x8 b, f32x16 c) { return __builtin_amdgcn_mfma_f32_32x32x16_bf16(a, b, c, 0, 0, 0); }
DEV float shfl_xor_f(float v, int m) { return __shfl_xor(v, m); }
DEV float shfl_up_f(float v, int d) { return __shfl_up(v, d); }
#define LAUNCH(kern, grid, smem, stream, ...) hipLaunchKernelGGL(kern, dim3(grid), dim3(NTHR), smem, stream, __VA_ARGS__)
#endif
DEV unsigned pack2(float lo, float hi) { return (unsigned)f2bf(lo) | ((unsigned)f2bf(hi) << 16); }
DEV float sigmoidf_(float x) { return 1.f / (1.f + __expf(-x)); }
DEV float siluf_(float x) { return x * sigmoidf_(x); }
DEV float logsigmoidf_(float x) { return fminf(x, 0.f) - log1pf(__expf(-fabsf(x))); }
#ifdef EMU
#define SMEM_DECL char* smem = emu::cur->blk->smem
#else
#define SMEM_DECL extern __shared__ __attribute__((aligned(16))) char smem[]
#endif

DEV int crow(int r, int lane) { return (r & 3) + 8 * (r >> 2) + 4 * (lane >> 5); }

constexpr int LDK = 72;
template <int WGM, int WGN, int TM, int TN> struct GemmCfg {
    static constexpr int BM = WGM * TM * 32, BN = WGN * TN * 32;
    static constexpr int A_BYTES = BM * LDK * 2, B_BYTES = BN * LDK * 2, STAGE = A_BYTES + B_BYTES, LDS = 2 * STAGE;
};
template <int WGM, int WGN, int TM, int TN, class ARow, class BRow>
DEV void gemm_mainloop(f32x16 (&acc)[TM][TN], ARow arow, BRow brow, int K, char* smem) {
    typedef GemmCfg<WGM, WGN, TM, TN> C;
    constexpr int NA = C::BM * 8 / NTHR, NB = (C::BN * 8 + NTHR - 1) / NTHR;
    const int tid = threadIdx.x, lane = tid & 63, wid = tid >> 6, wm = wid / WGN, wn = wid % WGN;
    const bf16_t* ap[NA]; const bf16_t* bp[NB];
#pragma unroll
    for (int i = 0; i < NA; ++i) { int c = tid + NTHR * i; const bf16_t* p = arow(c >> 3); ap[i] = p ? p + (c & 7) * 8 : nullptr; }
#pragma unroll
    for (int i = 0; i < NB; ++i) { int c = tid + NTHR * i; const bf16_t* p = (c < C::BN * 8) ? brow(c >> 3) : nullptr; bp[i] = p ? p + (c & 7) * 8 : nullptr; }
    u32x4 ra[NA], rb[NB];
    auto gload = [&](int k0) {
#pragma unroll
        for (int i = 0; i < NA; ++i) ra[i] = ap[i] ? *(const u32x4*)(ap[i] + k0) : (u32x4){0, 0, 0, 0};
#pragma unroll
        for (int i = 0; i < NB; ++i) rb[i] = bp[i] ? *(const u32x4*)(bp[i] + k0) : (u32x4){0, 0, 0, 0};
    };
    auto lstore = [&](int buf) {
        char* sa = smem + buf * C::STAGE; char* sb = sa + C::A_BYTES;
#pragma unroll
        for (int i = 0; i < NA; ++i) { int c = tid + NTHR * i; *(u32x4*)(sa + ((c >> 3) * LDK + (c & 7) * 8) * 2) = ra[i]; }
#pragma unroll
        for (int i = 0; i < NB; ++i) { int c = tid + NTHR * i; if (c < C::BN * 8) *(u32x4*)(sb + ((c >> 3) * LDK + (c & 7) * 8) * 2) = rb[i]; }
    };
#pragma unroll
    for (int i = 0; i < TM; ++i)
#pragma unroll
        for (int j = 0; j < TN; ++j)
#pragma unroll
            for (int r = 0; r < 16; ++r) acc[i][j][r] = 0.f;
    const int KT = K / 64;
    __syncthreads();
    gload(0); lstore(0);
    __syncthreads();
    for (int kt = 0; kt < KT; ++kt) {
        if (kt + 1 < KT) gload((kt + 1) * 64);
        const bf16_t* sa = (const bf16_t*)(smem + (kt & 1) * C::STAGE); const bf16_t* sb = (const bf16_t*)((const char*)sa + C::A_BYTES);
#pragma unroll
        for (int ks = 0; ks < 4; ++ks) {
            bf16x8 af[TM], bfr[TN];
#pragma unroll
            for (int i = 0; i < TM; ++i) af[i] = *(const bf16x8*)(sa + ((wm * TM + i) * 32 + (lane & 31)) * LDK + ks * 16 + (lane >> 5) * 8);
#pragma unroll
            for (int j = 0; j < TN; ++j) bfr[j] = *(const bf16x8*)(sb + ((wn * TN + j) * 32 + (lane & 31)) * LDK + ks * 16 + (lane >> 5) * 8);
#pragma unroll
            for (int i = 0; i < TM; ++i)
#pragma unroll
                for (int j = 0; j < TN; ++j) acc[i][j] = mfma32(af[i], bfr[j], acc[i][j]);
        }
        if (kt + 1 < KT) lstore((kt + 1) & 1);
        __syncthreads();
    }
}

DEV void phase_prep(const Params& p, int bid, int nb, char* smem) {
    const int tid = threadIdx.x;
    float* mods = (float*)(p.ws + OFF_MODS);
    float* sc = (float*)smem;
    for (int i = tid; i < (BATCH + 1) * 1024; i += NTHR) { int m = i >> 10, k = i & 1023; float v = m < BATCH ? p.c[m * 1024 + k] : p.c_ctx[k]; sc[i] = siluf_(v); }
    __syncthreads();
    float* red = sc + (BATCH + 1) * 1024;
    const int nitems = 2 * 96;
    for (int it = bid; it < nitems; it += nb) {
        int l = it / 96, n = (it % 96) * 64 + (tid & 63), kg = tid >> 6;
        float a[BATCH + 1];
#pragma unroll
        for (int m = 0; m <= BATCH; ++m) a[m] = 0.f;
        const float* w = p.ada_w + (size_t)l * 1024 * 6144 + n;
        for (int k = kg * 256; k < kg * 256 + 256; ++k) {
            float wv = w[(size_t)k * 6144];
#pragma unroll
            for (int m = 0; m <= BATCH; ++m) a[m] += sc[m * 1024 + k] * wv;
        }
        for (int q = 0; q < 4; ++q) {
            if (kg == q) {
#pragma unroll
                for (int m = 0; m <= BATCH; ++m) red[m * 64 + (tid & 63)] = (q ? red[m * 64 + (tid & 63)] : 0.f) + a[m];
            }
            __syncthreads();
        }
        for (int i = tid; i < (BATCH + 1) * 64; i += NTHR) {
            int m = i >> 6, nn = i & 63; int col = (it % 96) * 64 + nn;
            mods[((size_t)l * (BATCH + 1) + m) * 6144 + col] = red[i] + p.ada_b[l * 6144 + col];
        }
        __syncthreads();
    }
    float* lb = (float*)(p.ws + OFF_LB);
    for (int i = bid * NTHR + tid; i < 512; i += nb * NTHR) {
        float l0 = p.hg_lb[i], l1 = p.hg_lb[512 + i]; float mx = fmaxf(l0, l1); float e0 = expf(l0 - mx), e1 = expf(l1 - mx);
        lb[i] = 0.f; lb[512 + i] = e1 / (e0 + e1);
    }
    float* rope = (float*)(p.ws + OFF_ROPE);
    for (int i = bid * NTHR + tid; i < SEQ * 16; i += nb * NTHR) {
        int n = i >> 4, j = i & 7, isc = (i >> 3) & 1;
        float pos = isc ? (float)(n & 63) : (float)(n >> 6);
        float inv = powf(10000.f, -(float)(2 * j) / 16.f); float ang = pos * inv;
        rope[n * 32 + isc * 16 + j] = cosf(ang); rope[n * 32 + isc * 16 + 8 + j] = sinf(ang);
    }
}

DEV int win_src_col(int n) { return n < 1024 ? n : (n < 2720 ? n + 16 : (n < 2736 ? n - 2720 + 1024 : -1)); }
DEV void phase_convert(const Params& p, int layer, int bid, int nb, char* smem) {
    float* tile = (float*)smem;
    const int tid = threadIdx.x;
    const int n_win = 16 * 44, n_wuq = 4 * 12, n_wukv = 2 * 16, n_wout = 16 * 16, n_wgu = NEXP * 16 * 32, n_wd = NEXP * 16 * 16, n_wr = 16;
    const int total = n_win + n_wuq + n_wukv + n_wout + n_wgu + n_wd + n_wr;
    for (int it = bid; it < total; it += nb) {
        int t = it, mat, K, ntn;
        const float* src = nullptr; const float* src2 = nullptr; const float* kscale = nullptr; bf16_t* dst; int ldsrc;
        if (t < n_win) { mat = 0; K = 1024; ntn = 44; src = p.w_in + (size_t)layer * 1024 * 2736; ldsrc = 2736; dst = (bf16_t*)(p.ws + OFF_WIN); }
        else if ((t -= n_win) < n_wuq) { mat = 1; K = 256; ntn = 12; src = p.mla_w_uq + (size_t)layer * 256 * 768; ldsrc = 768; kscale = p.mla_q_norm_g + layer * 256; dst = (bf16_t*)(p.ws + OFF_WUQ); }
        else if ((t -= n_wuq) < n_wukv) { mat = 2; K = 128; ntn = 16; src = p.mla_w_ukv + (size_t)layer * 128 * 1024; ldsrc = 1024; kscale = p.mla_kv_norm_g + layer * 128; dst = (bf16_t*)(p.ws + OFF_WUKV); }
        else if ((t -= n_wukv) < n_wout) { mat = 3; K = 1024; ntn = 16; src = p.w_out + (size_t)layer * 1024 * 1024; ldsrc = 1024; dst = (bf16_t*)(p.ws + OFF_WOUT); }
        else if ((t -= n_wout) < n_wgu) { mat = 4; K = 1024; ntn = 32; int e = t / 512; t -= e * 512; src = p.ex_w_gate + ((size_t)layer * NEXP + e) * 1024 * 1024; src2 = p.ex_w_up + ((size_t)layer * NEXP + e) * 1024 * 1024; ldsrc = 1024; dst = (bf16_t*)(p.ws + OFF_WGU) + (size_t)e * 2048 * 1024; }
        else if ((t -= n_wgu) < n_wd) { mat = 5; K = 1024; ntn = 16; int e = t / 256; t -= e * 256; src = p.ex_w_down + ((size_t)layer * NEXP + e) * 1024 * 1024; ldsrc = 1024; dst = (bf16_t*)(p.ws + OFF_WD) + (size_t)e * 1024 * 1024; }
        else { t -= n_wd; mat = 6; K = 1024; ntn = 1; src = p.router_w + (size_t)layer * 1024 * 16; ldsrc = 16; dst = (bf16_t*)(p.ws + OFF_WR); }
        int kt = t / ntn, nt = t % ntn; int k0 = kt * 64, n0 = nt * 64;
        {
            int tx = tid & 63, ty = tid >> 6; int n = n0 + tx; const float* s = src; int sc;
            if (mat == 0) sc = win_src_col(n);
            else if (mat == 4) { int f = (n >> 6) * 32 + (n & 31); sc = f; if (n & 32) s = src2; }
            else if (mat == 6) sc = (n < 16) ? n : -1;
            else sc = n;
            if (mat == 6 && n >= 32) sc = -2;
            for (int kk = ty; kk < 64; kk += 4) {
                float v = 0.f;
                if (sc >= 0) { v = s[(size_t)(k0 + kk) * ldsrc + sc]; if (kscale) v *= kscale[k0 + kk]; }
                tile[kk * 65 + tx] = v;
            }
        }
        __syncthreads();
        {
            int nn = tid >> 2, part = tid & 3; int n = n0 + nn;
            if (!(mat == 6 && n >= 32)) {
                unsigned w[8];
#pragma unroll
                for (int j = 0; j < 8; ++j) w[j] = pack2(tile[(part * 16 + 2 * j) * 65 + nn], tile[(part * 16 + 2 * j + 1) * 65 + nn]);
                u32x4* d = (u32x4*)(dst + (size_t)n * K + k0 + part * 16);
                d[0] = (u32x4){w[0], w[1], w[2], w[3]}; d[1] = (u32x4){w[4], w[5], w[6], w[7]};
            }
        }
        __syncthreads();
    }
    float* bperm = (float*)(p.ws + OFF_BPERM);
    for (int i = bid * NTHR + tid; i < DIN_P; i += nb * NTHR) { int sc = win_src_col(i); bperm[i] = sc >= 0 ? p.b_in[layer * 2736 + sc] : 0.f; }
}

DEV const float* xrow_ptr(const Params& p, int layer, int r, bool post) {
    int b = r / T, t = r % T;
    if (t < CTXL) return ((layer == 0 && !post) ? p.ctx : (const float*)(p.ws + OFF_CX)) + ((size_t)b * CTXL + t) * D;
    return ((layer == 0 && !post) ? p.x : (const float*)p.out) + ((size_t)b * SEQ + (t - CTXL)) * D;
}
DEV void phase_norm(const Params& p, int layer, int which, int bid, int nb) {
    const int tid = threadIdx.x, lane = tid & 63, wid = tid >> 6;
    const float* g = (which ? p.norm2_g : p.norm1_g) + layer * D;
    const float* mods = (const float*)(p.ws + OFF_MODS) + (size_t)layer * (BATCH + 1) * 6144;
    bf16_t* h = (bf16_t*)(p.ws + OFF_H);
    const bool need_ctx = layer == 0;
    for (int r = bid * 4 + wid; r < R; r += nb * 4) {
        int b = r / T, t = r % T;
        if (which == 1 && t < CTXL && !need_ctx) continue;
        const float* xr = xrow_ptr(p, layer, r, which == 1);
        const float* mrow = mods + (size_t)(t < CTXL ? BATCH : b) * 6144 + (which ? 3 * 1024 : 0);
        f32x4 v[4]; float ss = 0.f;
#pragma unroll
        for (int i = 0; i < 4; ++i) { v[i] = *(const f32x4*)(xr + i * 256 + lane * 4); ss += v[i][0] * v[i][0] + v[i][1] * v[i][1] + v[i][2] * v[i][2] + v[i][3] * v[i][3]; }
#pragma unroll
        for (int m = 1; m < 64; m <<= 1) ss += shfl_xor_f(ss, m);
        float rstd = rsqrtf(ss * (1.f / 1024.f) + EPS);
#pragma unroll
        for (int i = 0; i < 4; ++i) {
            int c = i * 256 + lane * 4;
            f32x4 gg = *(const f32x4*)(g + c), sh = *(const f32x4*)(mrow + c), sc = *(const f32x4*)(mrow + 1024 + c);
            float o0 = v[i][0] * rstd * gg[0] * (1.f + sc[0]) + sh[0], o1 = v[i][1] * rstd * gg[1] * (1.f + sc[1]) + sh[1];
            float o2 = v[i][2] * rstd * gg[2] * (1.f + sc[2]) + sh[2], o3 = v[i][3] * rstd * gg[3] * (1.f + sc[3]) + sh[3];
            *(u32x2*)(h + (size_t)r * D + c) = (u32x2){pack2(o0, o1), pack2(o2, o3)};
        }
    }
}

DEV void phase_proj(const Params& p, int layer, int bid, int nb, char* smem) {
    const bf16_t* h = (const bf16_t*)(p.ws + OFF_H); const bf16_t* W = (const bf16_t*)(p.ws + OFF_WIN);
    const float* bperm = (const float*)(p.ws + OFF_BPERM);
    bf16_t* projb = (bf16_t*)(p.ws + OFF_PB); float* pref = (float*)(p.ws + OFF_PF); float* gates = (float*)(p.ws + OFF_GT);
    const int lane = threadIdx.x & 63, wid = threadIdx.x >> 6, wm = wid >> 1, wn = wid & 1;
    constexpr int NTN = DIN_P / 128, NTM = R / 128;
    for (int it = bid; it < NTM * NTN; it += nb) {
        int tm_ = it / NTN, tn_ = it % NTN; int r0 = tm_ * 128, n0 = tn_ * 128;
        f32x16 acc[2][2];
        gemm_mainloop<2, 2, 2, 2>(acc, [&](int i) { return h + (size_t)(r0 + i) * D; }, [&](int j) { return W + (size_t)(n0 + j) * 1024; }, 1024, smem);
#pragma unroll
        for (int i = 0; i < 2; ++i)
#pragma unroll
            for (int j = 0; j < 2; ++j) {
                int col = n0 + (wn * 2 + j) * 32 + (lane & 31); float bias = bperm[col];
#pragma unroll
                for (int r = 0; r < 16; ++r) {
                    int row = r0 + (wm * 2 + i) * 32 + crow(r, lane); float v = acc[i][j][r] + bias;
                    if (col < 1792) { if (col >= PB_HGQ && col < PB_HGV) v = siluf_(v); projb[(size_t)row * PBW + col] = f2bf(v); }
                    else if (col < 2304) pref[(size_t)row * 512 + (col - 1792)] = v;
                    else if (col < 2720) projb[(size_t)row * PBW + (col - 512)] = f2bf(v);
                    else if (col < 2736) gates[(size_t)row * 16 + (col - 2720)] = v;
                }
            }
    }
}

constexpr int SLD = 72;
DEV void mm64(f32x16& acc, const bf16_t* sA, const bf16_t* sBt, int wr, int wc, int lane) {
#pragma unroll
    for (int ks = 0; ks < 4; ++ks) {
        bf16x8 a = *(const bf16x8*)(sA + (wr * 32 + (lane & 31)) * SLD + ks * 16 + (lane >> 5) * 8);
        bf16x8 b = *(const bf16x8*)(sBt + (wc * 32 + (lane & 31)) * SLD + ks * 16 + (lane >> 5) * 8);
        acc = mfma32(a, b, acc);
    }
}
DEV int chunk_base(int dir, int c) { if (dir == 0) return c * 64; return (64 * c < CTXL) ? CTXL - 64 * (c + 1) : T + CTXL - 64 * (c + 1); }

DEV void scan_ml(const Params& p, int layer, int b, int hd, int dir, char* smem) {
    const int tid = threadIdx.x, lane = tid & 63, wid = tid >> 6, wr = wid >> 1, wc = wid & 1;
    const bool need_ctx = layer == 0;
    const bf16_t* projb = (const bf16_t*)(p.ws + OFF_PB); const float* gates = (const float*)(p.ws + OFF_GT);
    bf16_t* outp = (bf16_t*)(p.ws + OFF_H) + (size_t)dir * R * 256;
    const float* cw = p.ml_conv_w + layer * 3 * 512; const float* cb = p.ml_conv_b + layer * 512;
    bf16_t* sQ = (bf16_t*)smem; bf16_t* sK = sQ + 64 * SLD; bf16_t* sVt = sK + 64 * SLD; bf16_t* sKwT = sVt + 64 * SLD; bf16_t* sP = sKwT + 64 * SLD; bf16_t* sCt = sP + 64 * SLD;
    float* fb = (float*)(sCt + 64 * SLD);
    float* s_lf = fb, *s_ig = fb + 64, *s_b = fb + 128, *s_mt = fb + 192, *s_wst = fb + 256, *s_wt = fb + 320, *s_emt = fb + 384, *s_n = fb + 448, *s_den = fb + 512, *s_sc = fb + 576;
    f32x16 cst;
#pragma unroll
    for (int r = 0; r < 16; ++r) cst[r] = 0.f;
    __syncthreads();
    for (int i = tid; i < 64 * SLD; i += NTHR) sCt[i] = 0;
    if (tid < 64) s_n[tid] = 0.f;
    if (tid == 0) s_sc[0] = 0.f;
    __syncthreads();
    for (int c = 0; c < NC; ++c) {
        const int base = chunk_base(dir, c); const int seg_lo = base < CTXL ? 0 : CTXL, seg_hi = base < CTXL ? CTXL : T;
        const bool want_out = need_ctx || base >= CTXL;
        const size_t rb = (size_t)b * T;
        if (tid < 64) {
            int tok = dir == 0 ? base + tid : base + 63 - tid;
            const float* g = gates + (rb + tok) * 16 + dir * 8 + hd;
            float ig = g[0], lf = logsigmoidf_(g[4]);
            float bc = lf;
#pragma unroll
            for (int d = 1; d < 64; d <<= 1) { float o = shfl_up_f(bc, d); if (lane >= d) bc += o; }
            float pm = ig - bc;
#pragma unroll
            for (int d = 1; d < 64; d <<= 1) { float o = shfl_up_f(pm, d); if (lane >= d) pm = fmaxf(pm, o); }
            float mprev = s_sc[0];
            float mt = bc + fmaxf(mprev, pm);
            s_b[tid] = bc; s_ig[tid] = ig; s_mt[tid] = mt; s_wst[tid] = __expf(bc + mprev - mt); s_emt[tid] = __expf(-mt);
        }
        __syncthreads();
        if (tid < 64) { float bend = s_b[63], mnew = s_mt[63]; s_wt[tid] = __expf(bend - s_b[tid] + s_ig[tid] - mnew); }
        __syncthreads();
        for (int e = tid; e < 64 * 16; e += NTHR) {
            int j = e >> 4, ch = e & 15; int tok = dir == 0 ? base + j : base + 63 - j;
            int col = (ch < 8 ? 0 : 256) + hd * 64 + (ch & 7) * 8;
            const bf16_t* pr = projb + (rb + tok) * PBW + PB_MLQK + col;
            u32x4 c1 = *(const u32x4*)pr; u32x4 c0 = {0, 0, 0, 0}, c2 = {0, 0, 0, 0};
            if (tok - 1 >= seg_lo) c0 = *(const u32x4*)(pr - PBW);
            if (tok + 1 < seg_hi) c2 = *(const u32x4*)(pr + PBW);
            float o[8];
#pragma unroll
            for (int q = 0; q < 8; ++q) {
                unsigned s0 = c0[q >> 1], s1 = c1[q >> 1], s2 = c2[q >> 1];
                float a0 = bf2f((bf16_t)((q & 1) ? s0 >> 16 : s0 & 0xffff)), a1 = bf2f((bf16_t)((q & 1) ? s1 >> 16 : s1 & 0xffff)), a2 = bf2f((bf16_t)((q & 1) ? s2 >> 16 : s2 & 0xffff));
                int cc = col + q;
                o[q] = siluf_(cw[cc] * a0 + cw[512 + cc] * a1 + cw[1024 + cc] * a2 + cb[cc]);
            }
            if (ch < 8) {
                *(u32x4*)(sQ + j * SLD + ch * 8) = (u32x4){pack2(o[0], o[1]), pack2(o[2], o[3]), pack2(o[4], o[5]), pack2(o[6], o[7])};
            } else {
                float wt = s_wt[j];
#pragma unroll
                for (int q = 0; q < 8; ++q) o[q] *= 0.125f;
                *(u32x4*)(sK + j * SLD + (ch & 7) * 8) = (u32x4){pack2(o[0], o[1]), pack2(o[2], o[3]), pack2(o[4], o[5]), pack2(o[6], o[7])};
#pragma unroll
                for (int q = 0; q < 8; ++q) sKwT[((ch & 7) * 8 + q) * SLD + j] = f2bf(o[q] * wt);
            }
        }
        for (int e = tid; e < 64 * 8; e += NTHR) {
            int j = e >> 3, ch = e & 7; int tok = dir == 0 ? base + j : base + 63 - j;
            u32x4 vv = *(const u32x4*)(projb + (rb + tok) * PBW + PB_MLV + hd * 64 + ch * 8);
#pragma unroll
            for (int q = 0; q < 8; ++q) sVt[(ch * 8 + q) * SLD + j] = (bf16_t)((q & 1) ? vv[q >> 1] >> 16 : vv[q >> 1] & 0xffff);
        }
        __syncthreads();
        f32x16 acc;
        if (want_out) {
#pragma unroll
            for (int r = 0; r < 16; ++r) acc[r] = 0.f;
            if (!(wr == 0 && wc == 1)) mm64(acc, sQ, sK, wr, wc, lane);
            {
                int s = wc * 32 + (lane & 31); float bs = s_b[s], igs = s_ig[s];
#pragma unroll
                for (int r = 0; r < 16; ++r) {
                    int t = wr * 32 + crow(r, lane);
                    float w = (s <= t) ? __expf(s_b[t] - bs + igs - s_mt[t]) : 0.f;
                    sP[t * SLD + s] = f2bf(acc[r] * w);
                }
            }
        }
        __syncthreads();
        if (want_out) {
            if (tid < 64) {
                float dsum = 0.f, qn = 0.f;
                for (int s = 0; s < 64; ++s) { dsum += bf2f(sP[tid * SLD + s]); qn += bf2f(sQ[tid * SLD + s]) * s_n[s]; }
                s_den[tid] = fmaxf(fabsf(dsum + s_wst[tid] * qn), s_emt[tid]);
            }
#pragma unroll
            for (int r = 0; r < 16; ++r) acc[r] = 0.f;
            mm64(acc, sQ, sCt, wr, wc, lane);
#pragma unroll
            for (int r = 0; r < 16; ++r) acc[r] *= s_wst[wr * 32 + crow(r, lane)];
            mm64(acc, sP, sVt, wr, wc, lane);
        }
        __syncthreads();
        if (want_out) {
            int v = wc * 32 + (lane & 31);
#pragma unroll
            for (int r = 0; r < 16; ++r) {
                int t = wr * 32 + crow(r, lane); int tok = dir == 0 ? base + t : base + 63 - t;
                outp[(rb + tok) * 256 + hd * 64 + v] = f2bf(acc[r] / s_den[t]);
            }
        }
        {
            float ws = s_wst[63];
#pragma unroll
            for (int r = 0; r < 16; ++r) cst[r] *= ws;
            mm64(cst, sKwT, sVt, wr, wc, lane);
            float nn = 0.f;
            if (tid < 64) { for (int s = 0; s < 64; ++s) nn += bf2f(sKwT[tid * SLD + s]); nn += ws * s_n[tid]; }
            __syncthreads();
            if (tid < 64) s_n[tid] = nn;
            if (tid == 0) s_sc[0] = s_mt[63];
            int v = wc * 32 + (lane & 31);
#pragma unroll
            for (int r = 0; r < 16; ++r) sCt[v * SLD + wr * 32 + crow(r, lane)] = f2bf(cst[r]);
        }
        __syncthreads();
    }
}

DEV void scan_hg(const Params& p, int layer, int b, int hd, int dir, char* smem) {
    const int tid = threadIdx.x, lane = tid & 63, wid = tid >> 6, wr = wid >> 1, wc = wid & 1;
    const bool need_ctx = layer == 0;
    const bf16_t* projb = (const bf16_t*)(p.ws + OFF_PB); const float* pref = (const float*)(p.ws + OFF_PF);
    bf16_t* outp = (bf16_t*)(p.ws + OFF_H) + (size_t)(2 + dir) * R * 256;
    const float* lbp = (const float*)(p.ws + OFF_LB) + layer * 512 + dir * 256 + hd * 64;
    bf16_t* sQs = (bf16_t*)smem; bf16_t* sKs = sQs + 64 * SLD; bf16_t* sQb = sKs + 64 * SLD; bf16_t* sKwT = sQb + 64 * SLD; bf16_t* sVt = sKwT + 64 * SLD; bf16_t* sSt = sVt + 64 * SLD;
    bf16_t* sP = sQs;
    float* s_b = (float*)(sSt + 64 * SLD);
    float* s_ps = s_b + 64 * 65;
    f32x16 st;
#pragma unroll
    for (int r = 0; r < 16; ++r) st[r] = 0.f;
    __syncthreads();
    for (int i = tid; i < 64 * SLD; i += NTHR) sSt[i] = 0;
    __syncthreads();
    const int k = tid & 63, part = tid >> 6;
    const float low = lbp[k];
    for (int c = 0; c < NC; ++c) {
        const int base = chunk_base(dir, c);
        const bool want_out = need_ctx || base >= CTXL;
        const size_t rb = (size_t)b * T;
        float kk[16], lfc[16]; float run = 0.f;
#pragma unroll
        for (int i = 0; i < 16; ++i) {
            int j = part * 16 + i; int tok = dir == 0 ? base + j : base + 63 - j;
            float pre = pref[(rb + tok) * 512 + dir * 256 + hd * 64 + k];
            float lf = (low == 0.f) ? logsigmoidf_(pre) : __logf(low + (1.f - low) * sigmoidf_(pre));
            kk[i] = (1.f - low) * sigmoidf_(-pre);
            run += lf; lfc[i] = run;
        }
        s_ps[part * 64 + k] = run;
        __syncthreads();
        float off = 0.f;
        for (int q = 0; q < part; ++q) off += s_ps[q * 64 + k];
#pragma unroll
        for (int i = 0; i < 16; ++i) { lfc[i] += off; s_b[(part * 16 + i) * 65 + k] = lfc[i]; }
        __syncthreads();
        const float rref = s_b[31 * 65 + k], bend = s_b[63 * 65 + k];
#pragma unroll
        for (int i = 0; i < 16; ++i) {
            int j = part * 16 + i; int tok = dir == 0 ? base + j : base + 63 - j;
            float q = bf2f(projb[(rb + tok) * PBW + PB_HGQ + hd * 64 + k]);
            float bj = lfc[i];
            sQs[j * SLD + k] = f2bf(q * __expf(bj - rref));
            sKs[j * SLD + k] = f2bf(kk[i] * __expf(rref - bj));
            sQb[j * SLD + k] = f2bf(q * __expf(bj));
            sKwT[k * SLD + j] = f2bf(kk[i] * __expf(bend - bj));
            sVt[k * SLD + j] = projb[(rb + tok) * PBW + PB_HGV + hd * 64 + k];
        }
        __syncthreads();
        f32x16 acc;
#pragma unroll
        for (int r = 0; r < 16; ++r) acc[r] = 0.f;
        if (want_out && !(wr == 0 && wc == 1)) mm64(acc, sQs, sKs, wr, wc, lane);
        __syncthreads();
        if (want_out) {
            int s = wc * 32 + (lane & 31);
#pragma unroll
            for (int r = 0; r < 16; ++r) { int t = wr * 32 + crow(r, lane); sP[t * SLD + s] = f2bf(s <= t ? acc[r] : 0.f); }
        }
        __syncthreads();
        if (want_out) {
#pragma unroll
            for (int r = 0; r < 16; ++r) acc[r] = 0.f;
            mm64(acc, sQb, sSt, wr, wc, lane);
            mm64(acc, sP, sVt, wr, wc, lane);
            int v = wc * 32 + (lane & 31);
#pragma unroll
            for (int r = 0; r < 16; ++r) {
                int t = wr * 32 + crow(r, lane); int tok = dir == 0 ? base + t : base + 63 - t;
                outp[(rb + tok) * 256 + hd * 64 + v] = f2bf(acc[r]);
            }
        }
#pragma unroll
        for (int r = 0; r < 16; ++r) st[r] *= __expf(s_b[63 * 65 + wr * 32 + crow(r, lane)]);
        mm64(st, sKwT, sVt, wr, wc, lane);
        __syncthreads();
        {
            int v = wc * 32 + (lane & 31);
#pragma unroll
            for (int r = 0; r < 16; ++r) sSt[v * SLD + wr * 32 + crow(r, lane)] = f2bf(st[r]);
        }
        __syncthreads();
    }
}
DEV void phase_scan(const Params& p, int layer, int bid, int nb, char* smem) {
    const int nchains = BATCH * 4 * 2 * 2;
    for (int it = bid; it < nchains; it += nb) {
        int type = it & 1, dir = (it >> 1) & 1, hd = (it >> 2) & 3, b = it >> 4;
        if (type == 0) scan_ml(p, layer, b, hd, dir, smem); else scan_hg(p, layer, b, hd, dir, smem);
    }
}

DEV void phase_mla(const Params& p, int layer, int bid, int nb, char* smem) {
    const int tid = threadIdx.x, lane = tid & 63, wid = tid >> 6;
    const bool need_ctx = layer == 0;
    const bf16_t* projb = (const bf16_t*)(p.ws + OFF_PB);
    bf16_t* Qg = (bf16_t*)(p.ws + OFF_QKV); bf16_t* Kg = Qg + (size_t)BATCH * 8 * T * 96; bf16_t* Vt = Kg + (size_t)BATCH * 8 * T * 96;
    const float* rope = (const float*)(p.ws + OFF_ROPE);
    const bf16_t* WUQ = (const bf16_t*)(p.ws + OFF_WUQ); const bf16_t* WUKV = (const bf16_t*)(p.ws + OFF_WUKV);
    float* s_rstd = (float*)(smem + GemmCfg<4, 1, 1, 4>::LDS);
    constexpr int NTM = R / 128;
    const int nq = NTM * 8, nkv = NTM * 8;
    for (int it = bid; it < nq + nkv; it += nb) {
        const bool isq = it < nq; int t2 = isq ? it : it - nq; int tm_ = t2 >> 3, hd = t2 & 7; int r0 = tm_ * 128;
        int b = r0 / T, t0 = r0 % T; const bool islat = t0 >= CTXL;
        if (isq && !islat && !need_ctx) continue;
        __syncthreads();
        {
            int row = tid >> 1, half = tid & 1; int ncol = isq ? 256 : 128; const bf16_t* src = projb + (size_t)(r0 + row) * PBW + (isq ? PB_CQ : PB_CKV) + half * (ncol / 2);
            float ss = 0.f;
            for (int i = 0; i < ncol / 2; i += 8) { u32x4 v = *(const u32x4*)(src + i);
#pragma unroll
                for (int q = 0; q < 4; ++q) { float lo = bf2f((bf16_t)(v[q] & 0xffff)), hi = bf2f((bf16_t)(v[q] >> 16)); ss += lo * lo + hi * hi; } }
            ss += shfl_xor_f(ss, 1);
            if (half == 0) s_rstd[row] = rsqrtf(ss / (float)ncol + EPS);
        }
        const int wrow0 = r0 + wid * 32;
        if (isq) {
            f32x16 acc[1][3];
            gemm_mainloop<4, 1, 1, 3>(acc, [&](int i) { return projb + (size_t)(r0 + i) * PBW + PB_CQ; }, [&](int j) { return WUQ + (size_t)(hd * 96 + j) * 256; }, 256, smem);
            const float* gq = p.mla_q_qk_g + layer * 96;
            float ssq[16];
#pragma unroll
            for (int r = 0; r < 16; ++r) { float rs = s_rstd[wid * 32 + crow(r, lane)]; float s = 0.f;
#pragma unroll
                for (int j = 0; j < 3; ++j) { acc[0][j][r] *= rs; s += acc[0][j][r] * acc[0][j][r]; }
                ssq[r] = s; }
#pragma unroll
            for (int m = 1; m < 32; m <<= 1)
#pragma unroll
                for (int r = 0; r < 16; ++r) ssq[r] += shfl_xor_f(ssq[r], m);
            const int cl = lane & 31;
#pragma unroll
            for (int r = 0; r < 16; ++r) {
                float rn = rsqrtf(ssq[r] * (1.f / 96.f) + EPS); int rl = crow(r, lane); int t = t0 + wid * 32 + rl;
                float v0 = acc[0][0][r] * rn * gq[cl], v1 = acc[0][1][r] * rn * gq[32 + cl], v2 = acc[0][2][r] * rn * gq[64 + cl];
                float pv = shfl_xor_f(v2, 8);
                if (islat) { const float* rt = rope + (size_t)(t - CTXL) * 32 + (cl >> 4) * 16; int j = cl & 7; float cs = rt[j], sn = rt[8 + j]; v2 = v2 * cs + ((cl & 8) ? pv : -pv) * sn; }
                bf16_t* q = Qg + (((size_t)b * 8 + hd) * T + t) * 96;
                q[cl] = f2bf(v0); q[32 + cl] = f2bf(v1); q[64 + cl] = f2bf(v2);
            }
            (void)wrow0;
        } else {
            f32x16 acc[1][4];
            gemm_mainloop<4, 1, 1, 4>(acc, [&](int i) { return projb + (size_t)(r0 + i) * PBW + PB_CKV; }, [&](int j) { return WUKV + (size_t)(hd * 128 + j) * 128; }, 128, smem);
            const float* gk = p.mla_k_qk_g + layer * 96;
            const int cl = lane & 31;
            float ssq[16], kr[16];
#pragma unroll
            for (int r = 0; r < 16; ++r) { int rl = crow(r, lane); float rs = s_rstd[wid * 32 + rl];
#pragma unroll
                for (int j = 0; j < 4; ++j) acc[0][j][r] *= rs;
                kr[r] = bf2f(projb[(size_t)(wrow0 + rl) * PBW + PB_KR + cl]);
                ssq[r] = acc[0][0][r] * acc[0][0][r] + acc[0][1][r] * acc[0][1][r] + kr[r] * kr[r]; }
#pragma unroll
            for (int m = 1; m < 32; m <<= 1)
#pragma unroll
                for (int r = 0; r < 16; ++r) ssq[r] += shfl_xor_f(ssq[r], m);
#pragma unroll
            for (int r = 0; r < 16; ++r) {
                float rn = rsqrtf(ssq[r] * (1.f / 96.f) + EPS); int rl = crow(r, lane); int t = t0 + wid * 32 + rl;
                float v0 = acc[0][0][r] * rn * gk[cl], v1 = acc[0][1][r] * rn * gk[32 + cl], v2 = kr[r] * rn * gk[64 + cl];
                float pv = shfl_xor_f(v2, 8);
                if (islat) { const float* rt = rope + (size_t)(t - CTXL) * 32 + (cl >> 4) * 16; int j = cl & 7; float cs = rt[j], sn = rt[8 + j]; v2 = v2 * cs + ((cl & 8) ? pv : -pv) * sn; }
                bf16_t* kp = Kg + (((size_t)b * 8 + hd) * T + t) * 96;
                kp[cl] = f2bf(v0); kp[32 + cl] = f2bf(v1); kp[64 + cl] = f2bf(v2);
            }
#pragma unroll
            for (int j = 0; j < 2; ++j)
#pragma unroll
                for (int g = 0; g < 4; ++g) {
                    int t = t0 + wid * 32 + 8 * g + 4 * (lane >> 5); int dv = j * 32 + cl;
                    *(u32x2*)(Vt + (((size_t)b * 8 + hd) * 64 + dv) * T + t) = (u32x2){pack2(acc[0][2 + j][4 * g], acc[0][2 + j][4 * g + 1]), pack2(acc[0][2 + j][4 * g + 2], acc[0][2 + j][4 * g + 3])};
                }
        }
    }
}

constexpr int KLD = 104;
DEV void phase_attn(const Params& p, int layer, int bid, int nb, char* smem) {
    const int tid = threadIdx.x, lane = tid & 63, wid = tid >> 6, cl = lane & 31, hh = lane >> 5;
    const bool need_ctx = layer == 0;
    const bf16_t* Qg = (const bf16_t*)(p.ws + OFF_QKV); const bf16_t* Kg = Qg + (size_t)BATCH * 8 * T * 96; const bf16_t* Vt = Kg + (size_t)BATCH * 8 * T * 96;
    bf16_t* ao = (bf16_t*)(p.ws + OFF_PF);
    constexpr int KB = 64 * KLD * 2, VB = 64 * SLD * 2, STG = KB + VB;
    constexpr int NQT = T / 128;
    const float scl = 0.10206207261596577f * 1.4426950408889634f;
    for (int it = bid; it < BATCH * 8 * NQT; it += nb) {
        int qt = it % NQT, bh = it / NQT; int t0 = qt * 128; const bool islat = t0 >= CTXL;
        if (!islat && !need_ctx) continue;
        const int nkeys = islat ? T : CTXL; const int nkt = nkeys / 64;
        const bf16_t* Kb = Kg + (size_t)bh * T * 96; const bf16_t* Vb = Vt + (size_t)bh * 64 * T;
        bf16x8 qf[6];
        { const bf16_t* q = Qg + ((size_t)bh * T + t0 + wid * 32 + cl) * 96 + hh * 8;
#pragma unroll
          for (int s = 0; s < 6; ++s) qf[s] = *(const bf16x8*)(q + s * 16); }
        f32x16 o0, o1;
#pragma unroll
        for (int r = 0; r < 16; ++r) { o0[r] = 0.f; o1[r] = 0.f; }
        float mrun = -1e30f, lrun = 0.f;
        u32x4 rk[3], rv[2];
        auto gload = [&](int kt) {
#pragma unroll
            for (int i = 0; i < 3; ++i) { int c = tid + NTHR * i; int row = c / 12, cc = c % 12; rk[i] = *(const u32x4*)(Kb + (size_t)(kt * 64 + row) * 96 + cc * 8); }
#pragma unroll
            for (int i = 0; i < 2; ++i) { int c = tid + NTHR * i; int row = c >> 3, cc = c & 7; rv[i] = *(const u32x4*)(Vb + (size_t)row * T + kt * 64 + cc * 8); }
        };
        auto lstore = [&](int buf) {
            char* sk = smem + buf * STG; char* sv = sk + KB;
#pragma unroll
            for (int i = 0; i < 3; ++i) { int c = tid + NTHR * i; int row = c / 12, cc = c % 12; *(u32x4*)(sk + (row * KLD + cc * 8) * 2) = rk[i]; }
#pragma unroll
            for (int i = 0; i < 2; ++i) { int c = tid + NTHR * i; int row = c >> 3, cc = c & 7; *(u32x4*)(sv + (row * SLD + cc * 8) * 2) = rv[i]; }
        };
        __syncthreads();
        gload(0); lstore(0);
        __syncthreads();
        for (int kt = 0; kt < nkt; ++kt) {
            if (kt + 1 < nkt) gload(kt + 1);
            const bf16_t* sk = (const bf16_t*)(smem + (kt & 1) * STG); const bf16_t* sv = (const bf16_t*)((const char*)sk + KB);
            f32x16 s0, s1;
#pragma unroll
            for (int r = 0; r < 16; ++r) { s0[r] = 0.f; s1[r] = 0.f; }
#pragma unroll
            for (int s = 0; s < 6; ++s) {
                bf16x8 k0 = *(const bf16x8*)(sk + cl * KLD + s * 16 + hh * 8), k1 = *(const bf16x8*)(sk + (32 + cl) * KLD + s * 16 + hh * 8);
                s0 = mfma32(k0, qf[s], s0); s1 = mfma32(k1, qf[s], s1);
            }
            float mx = -1e30f;
#pragma unroll
            for (int r = 0; r < 16; ++r) { s0[r] *= scl; s1[r] *= scl; mx = fmaxf(mx, fmaxf(s0[r], s1[r])); }
            mx = fmaxf(mx, shfl_xor_f(mx, 32));
            float mnew = fmaxf(mrun, mx), alpha = exp2f(mrun - mnew); mrun = mnew;
            float ls = 0.f;
#pragma unroll
            for (int r = 0; r < 16; ++r) { s0[r] = exp2f(s0[r] - mnew); s1[r] = exp2f(s1[r] - mnew); ls += s0[r] + s1[r]; }
            lrun = lrun * alpha + ls;
#pragma unroll
            for (int r = 0; r < 16; ++r) { o0[r] *= alpha; o1[r] *= alpha; }
#pragma unroll
            for (int s = 0; s < 4; ++s) {
                const f32x16& sx = (s < 2) ? s0 : s1; int rbase = (s & 1) * 8;
                bf16x8 pb;
#pragma unroll
                for (int j = 0; j < 8; ++j) pb[j] = (short)f2bf(sx[rbase + j]);
#pragma unroll
                for (int i = 0; i < 2; ++i) {
                    const bf16_t* vr = sv + (i * 32 + cl) * SLD + s * 16 + 4 * hh;
                    bf16x4 lo = *(const bf16x4*)vr, hi = *(const bf16x4*)(vr + 8);
                    bf16x8 va = {lo[0], lo[1], lo[2], lo[3], hi[0], hi[1], hi[2], hi[3]};
                    if (i == 0) o0 = mfma32(va, pb, o0); else o1 = mfma32(va, pb, o1);
                }
            }
            if (kt + 1 < nkt) lstore((kt + 1) & 1);
            __syncthreads();
        }
        lrun += shfl_xor_f(lrun, 32);
        float inv = 1.f / lrun;
        int b = bh >> 3, hd = bh & 7; size_t row = (size_t)b * T + t0 + wid * 32 + cl;
#pragma unroll
        for (int i = 0; i < 2; ++i)
#pragma unroll
            for (int g = 0; g < 4; ++g) {
                const f32x16& ox = i ? o1 : o0; int dv = i * 32 + 8 * g + 4 * hh;
                *(u32x2*)(ao + row * 512 + hd * 64 + dv) = (u32x2){pack2(ox[4 * g] * inv, ox[4 * g + 1] * inv), pack2(ox[4 * g + 2] * inv, ox[4 * g + 3] * inv)};
            }
    }
}

DEV void phase_merge(const Params& p, int layer, int bid, int nb) {
    const int tid = threadIdx.x, lane = tid & 63, wid = tid >> 6;
    const bool need_ctx = layer == 0;
    const bf16_t* so = (const bf16_t*)(p.ws + OFF_H); const bf16_t* projb = (const bf16_t*)(p.ws + OFF_PB); const bf16_t* ao = (const bf16_t*)(p.ws + OFF_PF);
    bf16_t* y = (bf16_t*)(p.ws + OFF_QKV);
    for (int r = bid * 4 + wid; r < R; r += nb * 4) {
        if (!need_ctx && (r % T) < CTXL) continue;
        int c0 = lane * 16;
        unsigned outw[8];
        const bool isml = lane < 16; const int cc = c0 & 255;
        float v[16]; float ss = 0.f;
        if (lane < 32) {
            const bf16_t* a0 = so + ((size_t)(isml ? 0 : 2) * R + r) * 256 + cc; const bf16_t* a1 = so + ((size_t)(isml ? 1 : 3) * R + r) * 256 + cc;
            u32x4 x0 = *(const u32x4*)a0, x1 = *(const u32x4*)(a0 + 8), y0 = *(const u32x4*)a1, y1 = *(const u32x4*)(a1 + 8);
#pragma unroll
            for (int i = 0; i < 16; ++i) {
                unsigned wa = (i < 8 ? x0 : x1)[(i & 7) >> 1], wb = (i < 8 ? y0 : y1)[(i & 7) >> 1];
                v[i] = bf2f((bf16_t)((i & 1) ? wa >> 16 : wa & 0xffff)) + bf2f((bf16_t)((i & 1) ? wb >> 16 : wb & 0xffff)); ss += v[i] * v[i];
            }
        }
        ss += shfl_xor_f(ss, 1); ss += shfl_xor_f(ss, 2);
        if (lane < 32) {
            const bf16_t* gt = projb + (size_t)r * PBW + (isml ? PB_MLOG : PB_HGOG) + cc;
            const float* g = (isml ? p.ml_norm_g : p.hg_norm_g) + layer * 256 + cc;
            float rn = rsqrtf(ss * (1.f / 64.f) + EPS);
#pragma unroll
            for (int i = 0; i < 16; i += 2) {
                float g0 = bf2f(gt[i]), g1 = bf2f(gt[i + 1]);
                float a = v[i] * rn * g[i] * (isml ? sigmoidf_(g0) : siluf_(g0)), bb = v[i + 1] * rn * g[i + 1] * (isml ? sigmoidf_(g1) : siluf_(g1));
                outw[i >> 1] = pack2(a, bb);
            }
        } else {
            const u32x4* a = (const u32x4*)(ao + (size_t)r * 512 + (c0 - 512));
            u32x4 x0 = a[0], x1 = a[1];
            outw[0] = x0[0]; outw[1] = x0[1]; outw[2] = x0[2]; outw[3] = x0[3]; outw[4] = x1[0]; outw[5] = x1[1]; outw[6] = x1[2]; outw[7] = x1[3];
        }
        u32x4* d = (u32x4*)(y + (size_t)r * D + c0);
        d[0] = (u32x4){outw[0], outw[1], outw[2], outw[3]}; d[1] = (u32x4){outw[4], outw[5], outw[6], outw[7]};
    }
}

DEV void phase_outproj(const Params& p, int layer, int bid, int nb, char* smem) {
    const bool need_ctx = layer == 0;
    const bf16_t* y = (const bf16_t*)(p.ws + OFF_QKV); const bf16_t* W = (const bf16_t*)(p.ws + OFF_WOUT);
    const float* mods = (const float*)(p.ws + OFF_MODS) + (size_t)layer * (BATCH + 1) * 6144;
    const int lane = threadIdx.x & 63, wid = threadIdx.x >> 6, wm = wid >> 1, wn = wid & 1;
    constexpr int NTM = R / 128, NTN = 8;
    for (int it = bid; it < NTM * NTN; it += nb) {
        int tm_ = it / NTN, tn_ = it % NTN; int r0 = tm_ * 128, n0 = tn_ * 128;
        int b = r0 / T, t0 = r0 % T; const bool islat = t0 >= CTXL;
        if (!islat && !need_ctx) continue;
        f32x16 acc[2][2];
        gemm_mainloop<2, 2, 2, 2>(acc, [&](int i) { return y + (size_t)(r0 + i) * D; }, [&](int j) { return W + (size_t)(n0 + j) * 1024; }, 1024, smem);
        const float* g1 = mods + (size_t)(islat ? b : BATCH) * 6144 + 2 * 1024;
#pragma unroll
        for (int i = 0; i < 2; ++i)
#pragma unroll
            for (int j = 0; j < 2; ++j) {
                int col = n0 + (wn * 2 + j) * 32 + (lane & 31); float gv = g1[col];
#pragma unroll
                for (int r = 0; r < 16; ++r) {
                    int t = t0 + (wm * 2 + i) * 32 + crow(r, lane);
                    if (islat) { size_t o = ((size_t)b * SEQ + (t - CTXL)) * D + col; float xv = (layer == 0 ? p.x : p.out)[o]; p.out[o] = xv + gv * acc[i][j][r]; }
                    else { size_t o = ((size_t)b * CTXL + t) * D + col; float* cx = (float*)(p.ws + OFF_CX); cx[o] = p.ctx[o] + gv * acc[i][j][r]; }
                }
            }
    }
}

DEV void phase_router(const Params& p, int layer, int bid, int nb, char* smem) {
    const bool need_ctx = layer == 0;
    const bf16_t* h2 = (const bf16_t*)(p.ws + OFF_H); const bf16_t* WR = (const bf16_t*)(p.ws + OFF_WR);
    float* aff = (float*)(p.ws + OFF_AFF);
    const int lane = threadIdx.x & 63, wid = threadIdx.x >> 6;
    constexpr int NTM = R / 128;
    for (int it = bid; it < NTM; it += nb) {
        int r0 = it * 128; if (!need_ctx && (r0 % T) < CTXL) continue;
        f32x16 acc[1][1];
        gemm_mainloop<4, 1, 1, 1>(acc, [&](int i) { return h2 + (size_t)(r0 + i) * D; }, [&](int j) { return WR + (size_t)j * 1024; }, 1024, smem);
        const int cl = lane & 31;
#pragma unroll
        for (int r = 0; r < 16; ++r) {
            float v = cl < 16 ? acc[0][0][r] : -1e30f; float mx = v;
#pragma unroll
            for (int m = 1; m < 16; m <<= 1) mx = fmaxf(mx, shfl_xor_f(mx, m));
            float e = cl < 16 ? __expf(v - mx) : 0.f; float s = e;
#pragma unroll
            for (int m = 1; m < 16; m <<= 1) s += shfl_xor_f(s, m);
            if (cl < 16) aff[(size_t)(r0 + wid * 32 + crow(r, lane)) * 16 + cl] = e / s;
        }
    }
}

DEV void phase_topk(const Params& p, int layer, int bid, int nb, char* smem) {
    const bool need_ctx = layer == 0; const int tid = threadIdx.x;
    const float* aff = (const float*)(p.ws + OFF_AFF);
    int* selr = (int*)(p.ws + OFF_SELR); float* selg = (float*)(p.ws + OFF_SELG);
    float* sa = (float*)smem;
    const int capT = need_ctx ? CAP_L + CAP_C : CAP_L;
    const int nitems = BATCH * NEXP * 2;
    for (int it = bid; it < nitems; it += nb) {
        int seg = it & 1, e = (it >> 1) % NEXP, b = (it >> 1) / NEXP;
        if (seg == 1 && !need_ctx) continue;
        const int n = seg ? CTXL : SEQ, cap = seg ? CAP_C : CAP_L; const int rbase = b * T + (seg ? 0 : CTXL);
        __syncthreads();
        for (int i = tid; i < n; i += NTHR) sa[i] = aff[(size_t)(rbase + i) * 16 + e];
        __syncthreads();
        for (int i = tid; i < n; i += NTHR) {
            float a = sa[i]; int rank = 0;
            for (int j = 0; j < n; ++j) { float o = sa[j]; rank += (o > a || (o == a && j < i)) ? 1 : 0; }
            if (rank < cap) { int slot = e * ME_MAX + b * capT + (seg ? CAP_L : 0) + rank; selr[slot] = rbase + i; selg[slot] = a; }
        }
    }
}

DEV void phase_gateup(const Params& p, int layer, int bid, int nb, char* smem) {
    const bool need_ctx = layer == 0; const int Me = BATCH * (need_ctx ? CAP_L + CAP_C : CAP_L);
    const bf16_t* h2 = (const bf16_t*)(p.ws + OFF_H); const bf16_t* WGU = (const bf16_t*)(p.ws + OFF_WGU);
    const int* selr = (const int*)(p.ws + OFF_SELR);
    bf16_t* hid = (bf16_t*)(p.ws + OFF_PB);
    const int lane = threadIdx.x & 63, wid = threadIdx.x >> 6, wm = wid >> 1, wn = wid & 1;
    const int ntm = (Me + 127) / 128; constexpr int NTN = 16;
    for (int it = bid; it < NEXP * ntm * NTN; it += nb) {
        int tn_ = it % NTN, tm_ = (it / NTN) % ntm, e = it / (NTN * ntm); int m0 = tm_ * 128, n0 = tn_ * 128;
        const int* sr = selr + e * ME_MAX; const bf16_t* W = WGU + (size_t)e * 2048 * 1024;
        f32x16 acc[2][2];
        gemm_mainloop<2, 2, 2, 2>(acc, [&](int i) { return (m0 + i < Me) ? h2 + (size_t)sr[m0 + i] * D : (const bf16_t*)nullptr; }, [&](int j) { return W + (size_t)(n0 + j) * 1024; }, 1024, smem);
        int f = n0 / 2 + wn * 32 + (lane & 31);
#pragma unroll
        for (int i = 0; i < 2; ++i)
#pragma unroll
            for (int r = 0; r < 16; ++r) {
                int m = m0 + (wm * 2 + i) * 32 + crow(r, lane);
                if (m < Me) hid[((size_t)e * Me + m) * 1024 + f] = f2bf(siluf_(acc[i][0][r]) * acc[i][1][r]);
            }
    }
}
DEV void phase_down(const Params& p, int layer, int bid, int nb, char* smem) {
    const bool need_ctx = layer == 0; const int Me = BATCH * (need_ctx ? CAP_L + CAP_C : CAP_L);
    const bf16_t* hid = (const bf16_t*)(p.ws + OFF_PB); const bf16_t* WD = (const bf16_t*)(p.ws + OFF_WD);
    const int* selr = (const int*)(p.ws + OFF_SELR); const float* selg = (const float*)(p.ws + OFF_SELG);
    const float* mods = (const float*)(p.ws + OFF_MODS) + (size_t)layer * (BATCH + 1) * 6144;
    const int lane = threadIdx.x & 63, wid = threadIdx.x >> 6, wm = wid >> 1, wn = wid & 1;
    const int ntm = (Me + 127) / 128; constexpr int NTN = 8;
    for (int it = bid; it < NEXP * ntm * NTN; it += nb) {
        int tn_ = it % NTN, tm_ = (it / NTN) % ntm, e = it / (NTN * ntm); int m0 = tm_ * 128, n0 = tn_ * 128;
        const bf16_t* A = hid + (size_t)e * Me * 1024; const bf16_t* W = WD + (size_t)e * 1024 * 1024;
        f32x16 acc[2][2];
        gemm_mainloop<2, 2, 2, 2>(acc, [&](int i) { return (m0 + i < Me) ? A + (size_t)(m0 + i) * 1024 : (const bf16_t*)nullptr; }, [&](int j) { return W + (size_t)(n0 + j) * 1024; }, 1024, smem);
#pragma unroll
        for (int i = 0; i < 2; ++i)
#pragma unroll
            for (int r = 0; r < 16; ++r) {
                int m = m0 + (wm * 2 + i) * 32 + crow(r, lane);
                if (m < Me) {
                    int row = selr[e * ME_MAX + m]; float gate = selg[e * ME_MAX + m]; int b = row / T, t = row % T;
                    const float* g2 = mods + (size_t)(t < CTXL ? BATCH : b) * 6144 + 5 * 1024;
                    float* dst = (t < CTXL) ? (float*)(p.ws + OFF_CX) + ((size_t)b * CTXL + t) * D : p.out + ((size_t)b * SEQ + (t - CTXL)) * D;
#pragma unroll
                    for (int j = 0; j < 2; ++j) { int col = n0 + (wn * 2 + j) * 32 + (lane & 31); atomicAdd(dst + col, acc[i][j][r] * gate * g2[col]); }
                }
            }
    }
}

constexpr int SMEM_BYTES = 75 * 1024;
__global__ void __launch_bounds__(NTHR, 2) k_prep(Params p) { SMEM_DECL; phase_prep(p, blockIdx.x, gridDim.x, smem); }
__global__ void __launch_bounds__(NTHR, 2) k_convert(Params p, int layer) { SMEM_DECL; phase_convert(p, layer, blockIdx.x, gridDim.x, smem); }
__global__ void __launch_bounds__(NTHR, 2) k_norm(Params p, int layer, int which) { phase_norm(p, layer, which, blockIdx.x, gridDim.x); }
__global__ void __launch_bounds__(NTHR, 2) k_proj(Params p, int layer) { SMEM_DECL; phase_proj(p, layer, blockIdx.x, gridDim.x, smem); }
__global__ void __launch_bounds__(NTHR, 2) k_scan(Params p, int layer) { SMEM_DECL; phase_scan(p, layer, blockIdx.x, gridDim.x, smem); }
__global__ void __launch_bounds__(NTHR, 2) k_mla(Params p, int layer) { SMEM_DECL; phase_mla(p, layer, blockIdx.x, gridDim.x, smem); }
__global__ void __launch_bounds__(NTHR, 2) k_attn(Params p, int layer) { SMEM_DECL; phase_attn(p, layer, blockIdx.x, gridDim.x, smem); }
__global__ void __launch_bounds__(NTHR, 2) k_merge(Params p, int layer) { phase_merge(p, layer, blockIdx.x, gridDim.x); }
__global__ void __launch_bounds__(NTHR, 2) k_outproj(Params p, int layer) { SMEM_DECL; phase_outproj(p, layer, blockIdx.x, gridDim.x, smem); }
__global__ void __launch_bounds__(NTHR, 2) k_router(Params p, int layer) { SMEM_DECL; phase_router(p, layer, blockIdx.x, gridDim.x, smem); }
__global__ void __launch_bounds__(NTHR, 2) k_topk(Params p, int layer) { SMEM_DECL; phase_topk(p, layer, blockIdx.x, gridDim.x, smem); }
__global__ void __launch_bounds__(NTHR, 2) k_gateup(Params p, int layer) { SMEM_DECL; phase_gateup(p, layer, blockIdx.x, gridDim.x, smem); }
__global__ void __launch_bounds__(NTHR, 2) k_down(Params p, int layer) { SMEM_DECL; phase_down(p, layer, blockIdx.x, gridDim.x, smem); }

#ifdef EMU
void emu_dump(const char* name, const void* ptr, size_t bytes);
#define DUMP(name, off, bytes) emu_dump(name, p.ws + (off), bytes)
#else
#define DUMP(name, off, bytes)
#endif

extern "C" void kernel_launch(void* const* d_in, const int* in_sizes, int n_in, void* d_out, int out_size, void* d_ws, size_t ws_size, hipStream_t stream) {
    Params p{};
    const float** f = (const float**)&p;
    for (int i = 0; i < 26; ++i) f[i] = (const float*)d_in[i];
    p.out = (float*)d_out; p.ws = (char*)d_ws;
    if (ws_size < WS_TOTAL) { fprintf(stderr, "workspace too small: %zu < %zu\n", ws_size, (size_t)WS_TOTAL); return; }
    const int G = 512;
#ifndef EMU
    static bool attr_done = false;
    if (!attr_done) {
        attr_done = true;
        const void* ks[] = {(const void*)k_prep, (const void*)k_convert, (const void*)k_proj, (const void*)k_scan, (const void*)k_mla, (const void*)k_attn,
                            (const void*)k_outproj, (const void*)k_router, (const void*)k_topk, (const void*)k_gateup, (const void*)k_down};
        for (const void* k : ks) hipFuncSetAttribute(k, hipFuncAttributeMaxDynamicSharedMemorySize, SMEM_BYTES);
    }
#endif
    LAUNCH(k_prep, 192, SMEM_BYTES, stream, p);
    for (int l = 0; l < 2; ++l) {
        char nm[64];
        LAUNCH(k_convert, G * 2, SMEM_BYTES, stream, p, l);
        LAUNCH(k_norm, G * 2, 0, stream, p, l, 0);
        snprintf(nm, 64, "L%d_h", l); DUMP(nm, OFF_H, (size_t)R * 1024 * 2);
        LAUNCH(k_proj, G * 2, SMEM_BYTES, stream, p, l);
        snprintf(nm, 64, "L%d_projb", l); DUMP(nm, OFF_PB, (size_t)R * PBW * 2);
        snprintf(nm, 64, "L%d_pref", l); DUMP(nm, OFF_PF, (size_t)R * 512 * 4);
        snprintf(nm, 64, "L%d_gates", l); DUMP(nm, OFF_GT, (size_t)R * 16 * 4);
        LAUNCH(k_scan, BATCH * 16, SMEM_BYTES, stream, p, l);
        snprintf(nm, 64, "L%d_scan", l); DUMP(nm, OFF_H, (size_t)4 * R * 256 * 2);
        LAUNCH(k_mla, G * 2, SMEM_BYTES, stream, p, l);
        snprintf(nm, 64, "L%d_qkv", l); DUMP(nm, OFF_QKV, 2 * SZ_Q + SZ_V);
        LAUNCH(k_attn, G * 2, SMEM_BYTES, stream, p, l);
        snprintf(nm, 64, "L%d_ao", l); DUMP(nm, OFF_PF, (size_t)R * 512 * 2);
        LAUNCH(k_merge, G * 2, 0, stream, p, l);
        snprintf(nm, 64, "L%d_y", l); DUMP(nm, OFF_QKV, (size_t)R * 1024 * 2);
        LAUNCH(k_outproj, G * 2, SMEM_BYTES, stream, p, l);
        LAUNCH(k_norm, G * 2, 0, stream, p, l, 1);
        snprintf(nm, 64, "L%d_h2", l); DUMP(nm, OFF_H, (size_t)R * 1024 * 2);
        LAUNCH(k_router, G, SMEM_BYTES, stream, p, l);
        snprintf(nm, 64, "L%d_aff", l); DUMP(nm, OFF_AFF, (size_t)R * 16 * 4);
        LAUNCH(k_topk, BATCH * NEXP * 2, SMEM_BYTES, stream, p, l);
        LAUNCH(k_gateup, G * 2, SMEM_BYTES, stream, p, l);
        LAUNCH(k_down, G * 2, SMEM_BYTES, stream, p, l);
    }
}
```

```cpp
#ifndef EMU
#include <hip/hip_runtime.h>
#include <hip/hip_cooperative_groups.h>
#endif
#include <cstdio>
#include <cstdint>
#include <cmath>

#ifndef PROBE
#define PROBE 0
#endif
#ifndef BATCH
#define BATCH 16
#endif
#ifndef SEQ
#define SEQ 2048
#endif
#ifndef CTXL
#define CTXL 256
#endif

#define DEV __device__ __forceinline__
typedef unsigned short bf16_t;
typedef short bf16x8 __attribute__((ext_vector_type(8)));
typedef short bf16x4 __attribute__((ext_vector_type(4)));
typedef float f32x16 __attribute__((ext_vector_type(16)));
typedef float f32x4 __attribute__((ext_vector_type(4)));
typedef unsigned int u32x4 __attribute__((ext_vector_type(4)));
typedef unsigned int u32x2 __attribute__((ext_vector_type(2)));

constexpr int D = 1024;
constexpr int T = CTXL + SEQ;
constexpr int R = BATCH * T;
constexpr int NTHR = 256;
constexpr int DIN_P = 2816;
constexpr int PBW = 2208;
constexpr int NEXP = 16;
constexpr int CAP_L = SEQ / 8, CAP_C = CTXL / 8;
constexpr int NC = T / 64;
constexpr float EPS = 1e-6f;
constexpr float QSCL = 0.10206207261596577f * 1.4426950408889634f;
constexpr int PB_MLQK = 0, PB_MLV = 512, PB_MLOG = 768, PB_HGQ = 1024, PB_HGV = 1280, PB_HGOG = 1536, PB_CQ = 1792, PB_CKV = 2048, PB_KR = 2176;

constexpr size_t al256(size_t x) { return (x + 255) & ~(size_t)255; }
constexpr size_t SZ_WIN = (size_t)DIN_P * 1024 * 2, SZ_WUQ = 768 * 256 * 2, SZ_WUKV = 1024 * 128 * 2, SZ_WOUT = 1024 * 1024 * 2;
constexpr size_t SZ_WGU = (size_t)NEXP * 2048 * 1024 * 2, SZ_WD = (size_t)NEXP * 1024 * 1024 * 2, SZ_WR = 32 * 1024 * 2;
constexpr size_t OFF_WIN = 0;
constexpr size_t OFF_WUQ = OFF_WIN + SZ_WIN;
constexpr size_t OFF_WUKV = OFF_WUQ + SZ_WUQ;
constexpr size_t OFF_WOUT = OFF_WUKV + SZ_WUKV;
constexpr size_t OFF_WGU = OFF_WOUT + SZ_WOUT;
constexpr size_t OFF_WD = OFF_WGU + SZ_WGU;
constexpr size_t OFF_WR = OFF_WD + SZ_WD;
constexpr size_t OFF_BPERM = OFF_WR + SZ_WR;
constexpr size_t OFF_PB = al256(OFF_BPERM + DIN_P * 4);
constexpr int ME_MAX = BATCH * (CAP_L + CAP_C);
constexpr size_t SZ_PB = ((size_t)R * PBW * 2 > (size_t)NEXP * ME_MAX * 1024 * 2) ? (size_t)R * PBW * 2 : (size_t)NEXP * ME_MAX * 1024 * 2;
constexpr size_t OFF_PF = al256(OFF_PB + SZ_PB);
constexpr size_t OFF_GT = al256(OFF_PF + (size_t)R * 512 * 4);
constexpr size_t OFF_CX = al256(OFF_GT + (size_t)R * 16 * 4);
constexpr size_t OFF_QKV = al256(OFF_CX + (size_t)BATCH * CTXL * D * 4);
constexpr size_t SZ_Q = (size_t)BATCH * 8 * T * 96 * 2, SZ_V = (size_t)BATCH * 8 * T * 64 * 2;
constexpr size_t SZ_QKV = (2 * SZ_Q + SZ_V > (size_t)R * 1024 * 2) ? 2 * SZ_Q + SZ_V : (size_t)R * 1024 * 2;
constexpr size_t OFF_H = al256(OFF_QKV + SZ_QKV);
constexpr size_t OFF_MODS = al256(OFF_H + (size_t)R * 1024 * 2);
constexpr size_t OFF_LB = al256(OFF_MODS + (size_t)2 * (BATCH + 1) * 6144 * 4);
constexpr size_t OFF_ROPE = al256(OFF_LB + 2 * 512 * 4);
constexpr size_t OFF_AFF = al256(OFF_ROPE + (size_t)SEQ * 32 * 4);
constexpr size_t OFF_SELR = al256(OFF_AFF + (size_t)R * 16 * 4);
constexpr size_t OFF_SELG = al256(OFF_SELR + (size_t)NEXP * ME_MAX * 4);
constexpr size_t OFF_INV = al256(OFF_SELG + (size_t)NEXP * ME_MAX * 4);
constexpr size_t OFF_INVG = al256(OFF_INV + (size_t)R * 16 * 4);
constexpr size_t OFF_BAR = al256(OFF_INVG + (size_t)R * 16 * 4);
constexpr size_t OFF_QCTR = OFF_BAR + 16384;
constexpr size_t OFF_ZERO = OFF_BAR + 32768;
constexpr size_t WS_TOTAL = OFF_BAR + 65536;

struct Params {
    const float *x, *c, *ctx, *c_ctx, *ada_w, *ada_b, *norm1_g, *norm2_g, *w_in, *b_in, *ml_conv_w, *ml_conv_b, *ml_norm_g,
        *hg_lb, *hg_norm_g, *mla_q_norm_g, *mla_w_uq, *mla_kv_norm_g, *mla_w_ukv, *mla_q_qk_g, *mla_k_qk_g, *w_out, *router_w,
        *ex_w_gate, *ex_w_up, *ex_w_down;
    float* out;
    char* ws;
};

#ifdef EMU
DEV float bf2f(bf16_t v) { unsigned u = (unsigned)v << 16; float f; memcpy(&f, &u, 4); return f; }
DEV bf16_t f2bf(float x) { unsigned u; memcpy(&u, &x, 4); if ((u & 0x7fffffffu) > 0x7f800000u) return 0x7fc0; u += 0x7fffu + ((u >> 16) & 1u); return (bf16_t)(u >> 16); }
DEV f32x16 mfma32(bf16x8 a, bf16x8 b, f32x16 c) {
    emu::Wave* w = emu::cur->wave; int p = emu::wave_arrive_begin(); int lane = emu::cur->lane;
    for (int j = 0; j < 8; ++j) { w->fa[p][lane][j] = bf2f((bf16_t)a[j]); w->fb[p][lane][j] = bf2f((bf16_t)b[j]); }
    emu::wave_arrive_wait();
    int col = lane & 31, h = lane >> 5;
    for (int r = 0; r < 16; ++r) {
        int row = (r & 3) + 8 * (r >> 2) + 4 * h; float s = c[r];
        for (int k = 0; k < 16; ++k) s += w->fa[p][row + 32 * (k >> 3)][k & 7] * w->fb[p][col + 32 * (k >> 3)][k & 7];
        c[r] = s;
    }
    return c;
}
DEV float shfl_xor_f(float v, int m) { unsigned u; memcpy(&u, &v, 4); u = emu::shfl_u32(u, emu::cur->lane ^ m); float f; memcpy(&f, &u, 4); return f; }
DEV float shfl_idx_f(float v, int src) { unsigned u; memcpy(&u, &v, 4); u = emu::shfl_u32(u, src); float f; memcpy(&f, &u, 4); return f; }
DEV float shfl_up_f(float v, int d) { unsigned u; memcpy(&u, &v, 4); int l = emu::cur->lane; u = emu::shfl_u32(u, l >= d ? l - d : l); float f; memcpy(&f, &u, 4); return f; }
#define LAUNCH(kern, grid, smem, stream, ...) emu::launch(dim3(grid), dim3(NTHR), smem, false, [=]() { kern(__VA_ARGS__); })
#else
DEV float bf2f(bf16_t v) { return __builtin_bit_cast(float, (unsigned)v << 16); }
DEV bf16_t f2bf(float x) { return __builtin_bit_cast(unsigned short, (__bf16)x); }
DEV f32x16 mfma32(bf16x8 a, bf16x8 b, f32x16 c) { return __builtin_amdgcn_mfma_f32_32x32x16_bf16(a, b, c, 0, 0, 0); }
DEV float shfl_xor_f(float v, int m) { return __shfl_xor(v, m); }
DEV float shfl_up_f(float v, int d) { return __shfl_up(v, d); }
DEV float shfl_idx_f(float v, int src) { return __shfl(v, src); }
#define LAUNCH(kern, grid, smem, stream, ...) hipLaunchKernelGGL(kern, dim3(grid), dim3(NTHR), smem, stream, __VA_ARGS__)
#endif
#ifdef EMU
DEV int get_tid() { return threadIdx.x; }
#else
DEV int get_tid() { int t = threadIdx.x; asm volatile("" : "+v"(t)); return t; }
#endif
#ifdef EMU
DEV bf16x4 ds_tr(const bf16_t* a) {
    emu::Wave* w = emu::cur->wave; int p = emu::wave_arrive_begin(); int lane = emu::cur->lane;
    w->pv[p][lane] = a;
    emu::wave_arrive_wait();
    int g = lane & ~15, i = lane & 15; bf16x4 r;
    for (int q = 0; q < 4; ++q) r[q] = (short)((const bf16_t*)w->pv[p][g + 4 * q + (i >> 2)])[i & 3];
    return r;
}
#else
DEV bf16x4 ds_tr(const bf16_t* a) { return __builtin_amdgcn_ds_read_tr16_b64_v4i16((__attribute__((address_space(3))) bf16x4*)a); }
#endif
#ifdef EMU
DEV void glds16(const bf16_t* g, bf16_t* l) {
    emu::Wave* w = emu::cur->wave; int p = emu::wave_arrive_begin(); int lane = emu::cur->lane;
    w->pv[p][lane] = l;
    emu::wave_arrive_wait();
    if ((const char*)l - (const char*)w->pv[p][0] != lane * 16) { fprintf(stderr, "glds16: LDS destination not wave-linear (lane %d)\n", lane); abort(); }
    memcpy(l, g, 16);
}
DEV void glds_wait() {}
#else
DEV void glds16(const bf16_t* g, bf16_t* l) {
    __builtin_amdgcn_global_load_lds((const __attribute__((address_space(1))) void*)g, (__attribute__((address_space(3))) void*)l, 16, 0, 0);
}
DEV void glds_wait() { asm volatile("s_waitcnt vmcnt(0)" ::: "memory"); }
#endif
#ifdef NO_TR
DEV bf16x8 tr_frag(const bf16_t* X, int ldx, int ks, int c0, int lane) {
    const bf16_t* a = X + (16 * ks + 8 * (lane >> 5)) * ldx + c0 + (lane & 31);
    bf16x8 r;
#pragma unroll
    for (int j = 0; j < 8; ++j) r[j] = (short)a[j * ldx];
    return r;
}
#else
DEV bf16x8 tr_frag(const bf16_t* X, int ldx, int ks, int c0, int lane) {
    const bf16_t* a = X + (16 * ks + 8 * (lane >> 5) + ((lane & 15) >> 2)) * ldx + c0 + 16 * ((lane >> 4) & 1) + 4 * (lane & 3);
    bf16x4 lo = ds_tr(a), hi = ds_tr(a + 4 * ldx);
    return (bf16x8){lo[0], lo[1], lo[2], lo[3], hi[0], hi[1], hi[2], hi[3]};
}
#endif
#ifdef EMU
DEV float fast_exp2(float x) { return exp2f(x); }
DEV bool wave_all(bool pred) { unsigned v = pred ? 1u : 0u; for (int m = 1; m < 64; m <<= 1) v &= emu::shfl_u32(v, emu::cur->lane ^ m); return v != 0; }
#else
DEV float fast_exp2(float x) { return __builtin_amdgcn_exp2f(x); }
DEV bool wave_all(bool pred) { return __all(pred); }
#endif
#ifdef EMU
DEV int launder(int v) { return v; }
#else
DEV int launder(int v) { asm volatile("" : "+v"(v)); return v; }
#endif
#ifdef EMU
#define SCHED_FENCE()
#else
#define SCHED_FENCE() __builtin_amdgcn_sched_barrier(0)
#endif
#ifdef EMU
DEV float wave_scan_add(float v, int lane) { for (int d = 1; d < 64; d <<= 1) { float o = shfl_up_f(v, d); if (lane >= d) v += o; } return v; }
DEV float wave_scan_max(float v, int lane) { for (int d = 1; d < 64; d <<= 1) { float o = shfl_up_f(v, d); if (lane >= d) v = fmaxf(v, o); } return v; }
#else
template <int CTRL, int ROWMASK> DEV float dpp_f(float ident, float v) {
    return __builtin_bit_cast(float, __builtin_amdgcn_update_dpp(__builtin_bit_cast(int, ident), __builtin_bit_cast(int, v), CTRL, ROWMASK, 0xf, false));
}
DEV float wave_scan_add(float v, int) {
    v += dpp_f<0x111, 0xf>(0.f, v); v += dpp_f<0x112, 0xf>(0.f, v); v += dpp_f<0x114, 0xf>(0.f, v); v += dpp_f<0x118, 0xf>(0.f, v);
    v += dpp_f<0x142, 0xa>(0.f, v); v += dpp_f<0x143, 0xc>(0.f, v);
    return v;
}
DEV float wave_scan_max(float v, int) {
    const float NI = -3.0e38f;
    v = fmaxf(v, dpp_f<0x111, 0xf>(NI, v)); v = fmaxf(v, dpp_f<0x112, 0xf>(NI, v)); v = fmaxf(v, dpp_f<0x114, 0xf>(NI, v)); v = fmaxf(v, dpp_f<0x118, 0xf>(NI, v));
    v = fmaxf(v, dpp_f<0x142, 0xa>(NI, v)); v = fmaxf(v, dpp_f<0x143, 0xc>(NI, v));
    return v;
}
#endif
#ifdef EMU
DEV void st_nt(u32x4* p, u32x4 v) { *p = v; }
DEV float ld_nt(const float* p) { return *p; }
#else
DEV void st_nt(u32x4* p, u32x4 v) { __builtin_nontemporal_store(v, p); }
DEV float ld_nt(const float* p) { return __builtin_nontemporal_load(p); }
#endif
DEV unsigned pack2(float lo, float hi) { return (unsigned)f2bf(lo) | ((unsigned)f2bf(hi) << 16); }
#ifdef EMU
DEV float fast_rcp(float x) { return 1.f / x; }
#else
DEV float fast_rcp(float x) { return __builtin_amdgcn_rcpf(x); }
#endif
DEV float sigmoidf_(float x) { return fast_rcp(1.f + __expf(-x)); }
DEV float siluf_(float x) { return x * sigmoidf_(x); }
DEV float logsigmoidf_(float x) { return fminf(x, 0.f) - __logf(1.f + __expf(-fabsf(x))); }
#ifdef EMU
#define SMEM_DECL char* smem = emu::cur->blk->smem
#else
#define SMEM_DECL extern __shared__ __attribute__((aligned(16))) char smem[]
#endif

DEV int crow(int r, int lane) { return (r & 3) + 8 * (r >> 2) + 4 * (lane >> 5); }

template <int WGM, int WGN, int TM, int TN> struct GemmCfg {
    static constexpr int BM = WGM * TM * 32, BN = WGN * TN * 32;
    static constexpr int A_BYTES = BM * 128, B_BYTES = BN * 128, STAGE = A_BYTES + B_BYTES, LDS = 2 * STAGE;
};
DEV int swz(int row, int c) { return c ^ ((row >> 1) & 7); }
DEV int swz4(int row, int c) { return c ^ ((row >> 2) & 3); }
template <int WGM, int WGN, int TM, int TN, class ARow, class BRow>
DEV void gemm_mainloop(f32x16 (&acc)[TM][TN], ARow arow, BRow brow, int K, char* smem, const bf16_t* zrow) {
    typedef GemmCfg<WGM, WGN, TM, TN> C;
    constexpr int NA = C::BM / 32, NB = C::BN / 32;
    const int tid = get_tid(), lane = tid & 63, wid = tid >> 6, wm = wid / WGN, wn = wid % WGN;
    const bf16_t* ap[NA]; const bf16_t* bp[NB];
#pragma unroll
    for (int i = 0; i < NA; ++i) { int row = (i * 4 + wid) * 8 + (lane >> 3); const bf16_t* p = arow(row); ap[i] = p ? p + swz(row, lane & 7) * 8 : nullptr; }
#pragma unroll
    for (int i = 0; i < NB; ++i) { int row = (i * 4 + wid) * 8 + (lane >> 3); const bf16_t* p = brow(row); bp[i] = p ? p + swz(row, lane & 7) * 8 : nullptr; }
    auto stage_load = [&](int buf, int k0) {
        bf16_t* sa = (bf16_t*)(smem + buf * C::STAGE); bf16_t* sb = (bf16_t*)(smem + buf * C::STAGE + C::A_BYTES);
#pragma unroll
        for (int i = 0; i < NA; ++i) glds16(ap[i] ? ap[i] + k0 : zrow, sa + (i * 4 + wid) * 512 + lane * 8);
#pragma unroll
        for (int i = 0; i < NB; ++i) glds16(bp[i] ? bp[i] + k0 : zrow, sb + (i * 4 + wid) * 512 + lane * 8);
    };
#pragma unroll
    for (int i = 0; i < TM; ++i)
#pragma unroll
        for (int j = 0; j < TN; ++j)
#pragma unroll
            for (int r = 0; r < 16; ++r) acc[i][j][r] = 0.f;
    const int KT = K / 64;
    __syncthreads();
    stage_load(0, 0);
    glds_wait();
    __syncthreads();
    for (int kt = 0; kt < KT; ++kt) {
        if (kt + 1 < KT) stage_load((kt + 1) & 1, (kt + 1) * 64);
        const bf16_t* sa = (const bf16_t*)(smem + (kt & 1) * C::STAGE); const bf16_t* sb = (const bf16_t*)((const char*)sa + C::A_BYTES);
#pragma unroll
        for (int ks = 0; ks < 4; ++ks) {
            bf16x8 af[TM], bfr[TN];
            const int c = ks * 2 + (lane >> 5);
#pragma unroll
            for (int i = 0; i < TM; ++i) { int r = (wm * TM + i) * 32 + (lane & 31); af[i] = *(const bf16x8*)(sa + r * 64 + swz(r, c) * 8); }
#pragma unroll
            for (int j = 0; j < TN; ++j) { int r = (wn * TN + j) * 32 + (lane & 31); bfr[j] = *(const bf16x8*)(sb + r * 64 + swz(r, c) * 8); }
#pragma unroll
            for (int i = 0; i < TM; ++i)
#pragma unroll
                for (int j = 0; j < TN; ++j) acc[i][j] = mfma32(af[i], bfr[j], acc[i][j]);
        }
        glds_wait();
        __syncthreads();
    }
}

constexpr int CLD = 136;
template <class F>
DEV void stage_tile_bf16(const f32x16 (&acc)[2][2], char* smem, int lane, int wm, int wn, F f) {
    bf16_t* st = (bf16_t*)smem;
#pragma unroll
    for (int i = 0; i < 2; ++i)
#pragma unroll
        for (int j = 0; j < 2; ++j) {
            int col = (wn * 2 + j) * 32 + (lane & 31);
#pragma unroll
            for (int r = 0; r < 16; ++r) { int row = (wm * 2 + i) * 32 + crow(r, lane); st[row * CLD + col] = f2bf(f(acc[i][j][r], row, col)); }
        }
}
DEV void stage_tile_f32(const f32x16 (&acc)[2][2], char* smem, int lane, int wm, int wn) {
    float* st = (float*)smem;
#pragma unroll
    for (int i = 0; i < 2; ++i)
#pragma unroll
        for (int j = 0; j < 2; ++j) {
            int col = (wn * 2 + j) * 32 + (lane & 31);
#pragma unroll
            for (int r = 0; r < 16; ++r) { int row = (wm * 2 + i) * 32 + crow(r, lane); st[row * 128 + col] = acc[i][j][r]; }
        }
}

DEV void xcd_range(int bid, int nb, int N, int& first, int& end, int& stride) {
    if (nb % 8 != 0) { first = bid; end = N; stride = nb; return; }
    int g = bid & 7, j = bid >> 3; stride = nb >> 3;
    int s0 = (int)(((long long)g * N) / 8); end = (int)(((long long)(g + 1) * N) / 8); first = s0 + j;
}
DEV void tile_decode(int L, int NTM, int NTN, int& tm, int& tn) {
    constexpr int GM = 8; const int full = NTM / GM, rem = NTM % GM; const int nf = full * GM * NTN;
    if (L < nf) { int grp = L / (GM * NTN), r = L % (GM * NTN); tn = r / GM; tm = grp * GM + r % GM; }
    else { int r = L - nf; tn = r / rem; tm = full * GM + r % rem; }
}
constexpr int EPI_OFF = 32768;
template <class Rows, class Epi>
DEV void gemm_tiles(int first, int ntiles, int stride, int K, char* smem, const bf16_t* zrow, Rows rows, Epi epi) {
    typedef GemmCfg<2, 2, 2, 2> C;
    const int tid = get_tid(), lane = tid & 63, wid = tid >> 6, wm = wid >> 1, wn = wid & 1;
    if (first >= ntiles) return;
    const bf16_t* ap[4]; const bf16_t* bp[4];
    auto setptrs = [&](int t) {
#pragma unroll
        for (int i = 0; i < 4; ++i) {
            int row = (i * 4 + wid) * 8 + (lane >> 3);
            const bf16_t* pa = rows(t, 0, row); ap[i] = pa ? pa + swz(row, lane & 7) * 8 : nullptr;
            const bf16_t* pb = rows(t, 1, row); bp[i] = pb ? pb + swz(row, lane & 7) * 8 : nullptr;
        }
    };
    auto stage_load = [&](int buf, int k0) {
        bf16_t* sa = (bf16_t*)(smem + buf * C::STAGE); bf16_t* sb = (bf16_t*)(smem + buf * C::STAGE + C::A_BYTES);
#pragma unroll
        for (int i = 0; i < 4; ++i) glds16(ap[i] ? ap[i] + k0 : zrow, sa + (i * 4 + wid) * 512 + lane * 8);
#pragma unroll
        for (int i = 0; i < 4; ++i) glds16(bp[i] ? bp[i] + k0 : zrow, sb + (i * 4 + wid) * 512 + lane * 8);
    };
    const int KT = K / 64;
    __syncthreads();
    setptrs(first); stage_load(0, 0);
    glds_wait();
    __syncthreads();
    for (int t = first; t < ntiles; t += stride) {
        f32x16 acc[2][2];
#pragma unroll
        for (int i = 0; i < 2; ++i)
#pragma unroll
            for (int j = 0; j < 2; ++j)
#pragma unroll
                for (int r = 0; r < 16; ++r) acc[i][j][r] = 0.f;
        for (int kt = 0; kt < KT; ++kt) {
            if (kt + 1 < KT) stage_load((kt + 1) & 1, (kt + 1) * 64);
            else if (t + stride < ntiles) { setptrs(t + stride); stage_load(0, 0); }
            const bf16_t* sa = (const bf16_t*)(smem + (kt & 1) * C::STAGE); const bf16_t* sb = (const bf16_t*)((const char*)sa + C::A_BYTES);
#pragma unroll
            for (int ks = 0; ks < 4; ++ks) {
                bf16x8 af[2], bfr[2];
                const int c = ks * 2 + (lane >> 5);
#pragma unroll
                for (int i = 0; i < 2; ++i) { int r = (wm * 2 + i) * 32 + (lane & 31); af[i] = *(const bf16x8*)(sa + r * 64 + swz(r, c) * 8); }
#pragma unroll
                for (int j = 0; j < 2; ++j) { int r = (wn * 2 + j) * 32 + (lane & 31); bfr[j] = *(const bf16x8*)(sb + r * 64 + swz(r, c) * 8); }
#pragma unroll
                for (int i = 0; i < 2; ++i)
#pragma unroll
                    for (int j = 0; j < 2; ++j) acc[i][j] = mfma32(af[i], bfr[j], acc[i][j]);
            }
            glds_wait();
            __syncthreads();
        }
        epi(t, acc);
        __syncthreads();
    }
}
constexpr int G2_STAGE = (256 + 128) * 64;
#ifdef EMU
DEV void lds_barrier() { __syncthreads(); }
template <int N> DEV void vm_wait() {}
#else
DEV void lds_barrier() { asm volatile("s_waitcnt lgkmcnt(0)" ::: "memory"); __builtin_amdgcn_s_barrier(); asm volatile("" ::: "memory"); }
template <int N> DEV void vm_wait() { asm volatile("s_waitcnt vmcnt(%0)" :: "n"(N) : "memory"); }
#endif
template <int MODE = 0, class Rows, class Epi>
DEV void gemm_tiles256(int first, int end, int stride, int K, char* smem, const bf16_t* zrow, Rows rows, Epi epi) {
    const int tid = get_tid(), lane = tid & 63, wid = tid >> 6, wm = wid >> 1, wn = wid & 1;
    if (first >= end) return;
    const int nt = (end - first + stride - 1) / stride; const int KT = K / 32; const int G = nt * KT;
    unsigned ap[4], bp[2];
    auto setptrs = [&](int t) {
#pragma unroll
        for (int i = 0; i < 4; ++i) { int row = (i * 4 + wid) * 16 + (lane >> 2); const bf16_t* pa = rows(t, 0, row); ap[i] = pa ? (unsigned)(pa + swz4(row, lane & 3) * 8 - zrow) : 0u; }
#pragma unroll
        for (int i = 0; i < 2; ++i) { int row = (i * 4 + wid) * 16 + (lane >> 2); const bf16_t* pb = rows(t, 1, row); bp[i] = pb ? (unsigned)(pb + swz4(row, lane & 3) * 8 - zrow) : 0u; }
    };
    int lg = 0, lkt = 0, lli = 0, lst = 0;
    auto issue = [&]() {
        if (lkt == 0) setptrs(first + lli * stride);
        bf16_t* sa = (bf16_t*)(smem + lst * G2_STAGE); bf16_t* sb = (bf16_t*)(smem + lst * G2_STAGE + 256 * 64);
        if (MODE != 2) {
#pragma unroll
        for (int i = 0; i < 4; ++i) glds16(ap[i] ? zrow + (int)(ap[i] + lkt * 32) : zrow, sa + (i * 4 + wid) * 512 + lane * 8);
#pragma unroll
        for (int i = 0; i < 2; ++i) glds16(bp[i] ? zrow + (int)(bp[i] + lkt * 32) : zrow, sb + (i * 4 + wid) * 512 + lane * 8);
        }
        ++lg; if (++lkt == KT) { lkt = 0; ++lli; } if (++lst == 3) lst = 0;
    };
    __syncthreads();
    issue(); if (G > 1) issue();
    int g = 0, cst = 0;
    for (int li = 0; li < nt; ++li) {
        f32x16 acc[4][2];
#pragma unroll
        for (int i = 0; i < 4; ++i)
#pragma unroll
            for (int j = 0; j < 2; ++j)
#pragma unroll
                for (int r = 0; r < 16; ++r) acc[i][j][r] = 0.f;
        for (int kt = 0; kt < KT; ++kt, ++g) {
            if (g + 1 < G) vm_wait<6>(); else vm_wait<0>();
            lds_barrier();
            if (lg < G) issue();
            const bf16_t* sa = (const bf16_t*)(smem + cst * G2_STAGE); const bf16_t* sb = sa + 256 * 32;
            if (MODE != 1)
#pragma unroll
            for (int ks = 0; ks < 2; ++ks) {
                bf16x8 bfr[2];
                const int c = ks * 2 + (lane >> 5);
#pragma unroll
                for (int j = 0; j < 2; ++j) { int r = wn * 64 + j * 32 + (lane & 31); bfr[j] = *(const bf16x8*)(sb + r * 32 + swz4(r, c) * 8); }
#pragma unroll
                for (int ip = 0; ip < 2; ++ip) {
                    bf16x8 af[2];
#pragma unroll
                    for (int i = 0; i < 2; ++i) { int r = wm * 128 + (ip * 2 + i) * 32 + (lane & 31); af[i] = *(const bf16x8*)(sa + r * 32 + swz4(r, c) * 8); }
#pragma unroll
                    for (int i = 0; i < 2; ++i)
#pragma unroll
                        for (int j = 0; j < 2; ++j) acc[ip * 2 + i][j] = mfma32(af[i], bfr[j], acc[ip * 2 + i][j]);
                }
            }
            if (kt + 1 < KT) { if (++cst == 3) cst = 0; }
        }
        lds_barrier();
        epi(first + li * stride, acc, smem + cst * G2_STAGE);
        vm_wait<0>();
        if (++cst == 3) cst = 0;
    }
    __syncthreads();
}
template <class F, class S>
DEV void epi256_bf16(const f32x16 (&acc)[4][2], char* stg, int tid, F f, S store) {
    const int lane = tid & 63, wid = tid >> 6, wm = wid >> 1, wn = wid & 1;
    bf16_t* st = (bf16_t*)stg;
#pragma unroll
    for (int q = 0; q < 4; ++q) {
        if (wm == (q >> 1)) {
#pragma unroll
            for (int ii = 0; ii < 2; ++ii)
#pragma unroll
                for (int j = 0; j < 2; ++j) {
                    int col = wn * 64 + j * 32 + (lane & 31);
#pragma unroll
                    for (int r = 0; r < 16; ++r) { int row = ii * 32 + crow(r, lane); st[row * CLD + col] = f2bf(f(acc[(q & 1) * 2 + ii][j][r], q * 64 + row, col)); }
                }
        }
        lds_barrier();
        { const int t2 = launder(tid);
#pragma unroll
        for (int k = 0; k < 4; ++k) { int id = t2 + NTHR * k; int row = id >> 4, c = id & 15; store(q * 64 + row, c, *(const u32x4*)(st + row * CLD + c * 8)); } }
        lds_barrier();
    }
}
template <class S>
DEV void epi256_f32(const f32x16 (&acc)[4][2], char* stg, int tid, S store) {
    const int lane = tid & 63, wid = tid >> 6, wm = wid >> 1, wn = wid & 1;
    float* st = (float*)stg;
#pragma unroll
    for (int q = 0; q < 8; ++q) {
        if (wm == (q >> 2)) {
#pragma unroll
            for (int j = 0; j < 2; ++j) {
                int col = wn * 64 + j * 32 + (lane & 31);
#pragma unroll
                for (int r = 0; r < 16; ++r) st[crow(r, lane) * 128 + col] = acc[q & 3][j][r];
            }
        }
        lds_barrier();
        { const int t2 = launder(tid);
#pragma unroll
        for (int k = 0; k < 4; ++k) { int id = t2 + NTHR * k; int row = id >> 5, c = id & 31; store(q * 32 + row, c, *(const f32x4*)(st + row * 128 + c * 4)); } }
        lds_barrier();
    }
}

template <class St>
DEV void epi_f32_halves(const f32x16 (&acc)[2][2], char* smem, int tid, St store) {
    const int lane = tid & 63, wid = tid >> 6, wm = wid >> 1, wn = wid & 1;
    float* st = (float*)(smem + EPI_OFF);
#pragma unroll
    for (int half = 0; half < 2; ++half) {
        if (wm == half) {
#pragma unroll
            for (int i = 0; i < 2; ++i)
#pragma unroll
                for (int j = 0; j < 2; ++j) {
                    int col = (wn * 2 + j) * 32 + (lane & 31);
#pragma unroll
                    for (int r = 0; r < 16; ++r) st[(i * 32 + crow(r, lane)) * 128 + col] = acc[i][j][r];
                }
        }
        __syncthreads();
#pragma unroll
        for (int q = 0; q < 8; ++q) { int id = tid + NTHR * q; int row = id >> 5, c = id & 31; store(half * 64 + row, c, *(const f32x4*)(st + row * 128 + c * 4)); }
        __syncthreads();
    }
}

DEV void phase_prep(const Params& p, int bid, int nb, char* smem) {
    const int tid = get_tid();
    float* mods = (float*)(p.ws + OFF_MODS);
    float* sc = (float*)smem;
    for (int i0 = tid; i0 < (BATCH + 1) * 1024; i0 += NTHR * 4) {
        float cv[4];
#pragma unroll
        for (int q = 0; q < 4; ++q) { int i = i0 + q * NTHR; int m = i >> 10, k = i & 1023; cv[q] = i < (BATCH + 1) * 1024 ? (m < BATCH ? p.c[m * 1024 + k] : p.c_ctx[k]) : 0.f; }
#pragma unroll
        for (int q = 0; q < 4; ++q) { int i = i0 + q * NTHR; if (i < (BATCH + 1) * 1024) sc[i] = siluf_(cv[q]); }
    }
    __syncthreads();
    float* red = sc + (BATCH + 1) * 1024;
    const int nitems = 2 * 192;
    for (int it = bid; it < nitems; it += nb) {
        int l = it / 192, n = (it % 192) * 32 + (tid & 31), kg = tid >> 5;
        float a[BATCH + 1];
#pragma unroll
        for (int m = 0; m <= BATCH; ++m) a[m] = 0.f;
        const float* w = p.ada_w + (size_t)l * 1024 * 6144 + n;
        for (int k = kg * 128; k < kg * 128 + 128; k += 16) {
            float wv[16];
#pragma unroll
            for (int j = 0; j < 16; ++j) wv[j] = w[(size_t)(k + j) * 6144];
#pragma unroll
            for (int j = 0; j < 16; ++j)
#pragma unroll
                for (int m = 0; m <= BATCH; ++m) a[m] += sc[m * 1024 + k + j] * wv[j];
        }
        for (int q = 0; q < 8; ++q) {
            if (kg == q) {
#pragma unroll
                for (int m = 0; m <= BATCH; ++m) red[m * 32 + (tid & 31)] = (q ? red[m * 32 + (tid & 31)] : 0.f) + a[m];
            }
            __syncthreads();
        }
        for (int i = tid; i < (BATCH + 1) * 32; i += NTHR) {
            int m = i >> 5, nn = i & 31; int col = (it % 192) * 32 + nn;
            mods[((size_t)l * (BATCH + 1) + m) * 6144 + col] = red[i] + p.ada_b[l * 6144 + col];
        }
        __syncthreads();
    }
    if (bid == 0 && tid < 64) ((unsigned*)(p.ws + OFF_ZERO))[tid] = 0u;
    float* lb = (float*)(p.ws + OFF_LB);
    for (int i = bid * NTHR + tid; i < 512; i += nb * NTHR) {
        float l0 = p.hg_lb[i], l1 = p.hg_lb[512 + i]; float mx = fmaxf(l0, l1); float e0 = expf(l0 - mx), e1 = expf(l1 - mx);
        lb[i] = 0.f; lb[512 + i] = e1 / (e0 + e1);
    }
    float* rope = (float*)(p.ws + OFF_ROPE);
    for (int i = bid * NTHR + tid; i < SEQ * 16; i += nb * NTHR) {
        int n = i >> 4, j = i & 7, isc = (i >> 3) & 1;
        float pos = isc ? (float)(n & 63) : (float)(n >> 6);
        float inv = powf(10000.f, -(float)(2 * j) / 16.f); float ang = pos * inv;
        rope[n * 32 + isc * 16 + j] = cosf(ang); rope[n * 32 + isc * 16 + 8 + j] = sinf(ang);
    }
}

DEV int win_src_col(int n) { return n < 1024 ? n : (n < 2720 ? n + 16 : (n < 2736 ? n - 2720 + 1024 : -1)); }
DEV void phase_convert(const Params& p, int layer, int bid, int nb, char* smem, int part = 0, unsigned* queue = nullptr) {
    float* tile = (float*)smem;
    const int tid = get_tid();
    const int n_win = 4 * 44, n_wuq = 1 * 12, n_wukv = 1 * 16, n_wout = 4 * 16, n_wgu = NEXP * 4 * 32, n_wd = NEXP * 4 * 16, n_wr = 4;
    const int total = n_win + n_wuq + n_wukv + n_wout + n_wgu + n_wd + n_wr;
    const int n_small = n_win + n_wuq + n_wukv + n_wout;
    const int it_lo = part == 2 ? n_small : 0, it_hi = part == 1 ? n_small : total;
    int* s_next = (int*)(smem + 256 * 65 * 4);
    for (int it = it_lo + bid;; it += nb) {
        if (queue) {
            __syncthreads();
            if (tid == 0) *s_next = it_lo + (int)atomicAdd(queue, 1u);
            __syncthreads();
            it = *s_next;
        }
        if (it >= it_hi) break;
        int t = it, mat, K, ntn;
        const float* src = nullptr; const float* src2 = nullptr; const float* kscale = nullptr; bf16_t* dst; int ldsrc;
        if (t < n_win) { mat = 0; K = 1024; ntn = 44; src = p.w_in + (size_t)layer * 1024 * 2736; ldsrc = 2736; dst = (bf16_t*)(p.ws + OFF_WIN); }
        else if ((t -= n_win) < n_wuq) { mat = 1; K = 256; ntn = 12; src = p.mla_w_uq + (size_t)layer * 256 * 768; ldsrc = 768; kscale = p.mla_q_norm_g + layer * 256; dst = (bf16_t*)(p.ws + OFF_WUQ); }
        else if ((t -= n_wuq) < n_wukv) { mat = 2; K = 128; ntn = 16; src = p.mla_w_ukv + (size_t)layer * 128 * 1024; ldsrc = 1024; kscale = p.mla_kv_norm_g + layer * 128; dst = (bf16_t*)(p.ws + OFF_WUKV); }
        else if ((t -= n_wukv) < n_wout) { mat = 3; K = 1024; ntn = 16; src = p.w_out + (size_t)layer * 1024 * 1024; ldsrc = 1024; dst = (bf16_t*)(p.ws + OFF_WOUT); }
        else if ((t -= n_wout) < n_wgu) { mat = 4; K = 1024; ntn = 32; int e = t / 128; t -= e * 128; src = p.ex_w_gate + ((size_t)layer * NEXP + e) * 1024 * 1024; src2 = p.ex_w_up + ((size_t)layer * NEXP + e) * 1024 * 1024; ldsrc = 1024; dst = (bf16_t*)(p.ws + OFF_WGU) + (size_t)e * 2048 * 1024; }
        else if ((t -= n_wgu) < n_wd) { mat = 5; K = 1024; ntn = 16; int e = t / 64; t -= e * 64; src = p.ex_w_down + ((size_t)layer * NEXP + e) * 1024 * 1024; ldsrc = 1024; dst = (bf16_t*)(p.ws + OFF_WD) + (size_t)e * 1024 * 1024; }
        else { t -= n_wd; mat = 6; K = 1024; ntn = 1; src = p.router_w + (size_t)layer * 1024 * 16; ldsrc = 16; dst = (bf16_t*)(p.ws + OFF_WR); }
        int kt = t / ntn, nt = t % ntn; int k0 = kt * 256, n0 = nt * 64; const int kn = K - k0 < 256 ? K - k0 : 256;
        {
            int tx = tid & 63, ty = tid >> 6; int n = n0 + tx; const float* sp = src; int sc;
            if (mat == 0) sc = win_src_col(n);
            else if (mat == 4) { sc = (n >> 6) * 32 + (n & 31); if (n & 32) sp = src2; }
            else if (mat == 6) sc = (n < 16) ? n : -1;
            else sc = n;
            float v[64];
#pragma unroll
            for (int q = 0; q < 64; ++q) { int kk = ty + 4 * q; v[q] = (sc >= 0 && kk < kn) ? ld_nt(sp + (size_t)(k0 + kk) * ldsrc + sc) : 0.f; }
            if (kscale) {
#pragma unroll
                for (int q = 0; q < 64; ++q) { int kk = ty + 4 * q; if (kk < kn) v[q] *= kscale[k0 + kk]; }
            }
#pragma unroll
            for (int q = 0; q < 64; ++q) tile[(ty + 4 * q) * 65 + tx] = v[q];
        }
        __syncthreads();
        {
            int nn = tid >> 2, part = tid & 3; int n = n0 + nn;
            if (!(mat == 6 && n >= 32) && part * 64 < kn) {
#pragma unroll
                for (int g = 0; g < 8; ++g) {
                    unsigned w[4];
#pragma unroll
                    for (int j = 0; j < 4; ++j) w[j] = pack2(tile[(part * 64 + g * 8 + 2 * j) * 65 + nn], tile[(part * 64 + g * 8 + 2 * j + 1) * 65 + nn]);
                    *(u32x4*)(dst + (size_t)n * K + k0 + part * 64 + g * 8) = (u32x4){w[0], w[1], w[2], w[3]};
                }
            }
        }
        __syncthreads();
    }
    float* bperm = (float*)(p.ws + OFF_BPERM);
    if (part != 2) for (int i = bid * NTHR + tid; i < DIN_P; i += nb * NTHR) { int sc = win_src_col(i); bperm[i] = sc >= 0 ? p.b_in[layer * 2736 + sc] : 0.f; }
}

DEV bf16_t* lat_work_row(const Params& p, int b, int tl) { return (bf16_t*)p.out + ((size_t)b * SEQ + tl) * (2 * D); }
DEV const float* xrow_ptr(const Params& p, int layer, int r, bool post) {
    int b = r / T, t = r % T;
    if (t < CTXL) return ((layer == 0 && !post) ? p.ctx : (const float*)(p.ws + OFF_CX)) + ((size_t)b * CTXL + t) * D;
    return p.x + ((size_t)b * SEQ + (t - CTXL)) * D;
}
DEV f32x4 ld_bf4(const bf16_t* q) { u32x2 w = *(const u32x2*)q; return (f32x4){bf2f((bf16_t)(w[0] & 0xffff)), bf2f((bf16_t)(w[0] >> 16)), bf2f((bf16_t)(w[1] & 0xffff)), bf2f((bf16_t)(w[1] >> 16))}; }
DEV void st_bf4(bf16_t* q, f32x4 v) { *(u32x2*)q = (u32x2){pack2(v[0], v[1]), pack2(v[2], v[3])}; }
DEV void ffn_sum(const Params& p, int clayer, int r, int lane, f32x4 (&s)[4]);
DEV void phase_norm(const Params& p, int layer, int which, int bid, int nb, int clayer = -1) {
    const int tid = get_tid(), lane = tid & 63, wid = tid >> 6;
    const float* g = (which ? p.norm2_g : p.norm1_g) + layer * D;
    const float* mods = (const float*)(p.ws + OFF_MODS) + (size_t)layer * (BATCH + 1) * 6144;
    bf16_t* h = (bf16_t*)(p.ws + OFF_H);
    const bool need_ctx = layer == 0;
    for (int r = bid * 4 + wid; r < R; r += nb * 4) {
        int b = r / T, t = r % T;
        if (which == 1 && t < CTXL && !need_ctx) continue;
        const float* xr = xrow_ptr(p, layer, r, which == 1);
        const bool lat_work = t >= CTXL && !(layer == 0 && which == 0);
        bf16_t* wr_ = lat_work_row(p, b, t - CTXL);
        const float* mrow = mods + (size_t)(t < CTXL ? BATCH : b) * 6144 + (which ? 3 * 1024 : 0);
        f32x4 v[4]; float ss = 0.f;
#pragma unroll
        for (int i = 0; i < 4; ++i) v[i] = lat_work ? ld_bf4(wr_ + i * 256 + lane * 4) : *(const f32x4*)(xr + i * 256 + lane * 4);
        if (clayer >= 0) {
            f32x4 sacc[4]; ffn_sum(p, clayer, r, lane, sacc);
            const float* g2 = (const float*)(p.ws + OFF_MODS) + ((size_t)clayer * (BATCH + 1) + (t < CTXL ? BATCH : b)) * 6144 + 5 * 1024;
#pragma unroll
            for (int i = 0; i < 4; ++i) { int c = i * 256 + lane * 4; v[i] = v[i] + *(const f32x4*)(g2 + c) * sacc[i]; if (lat_work) st_bf4(wr_ + c, v[i]); else *(f32x4*)((float*)xr + c) = v[i]; }
        }
#pragma unroll
        for (int i = 0; i < 4; ++i) ss += v[i][0] * v[i][0] + v[i][1] * v[i][1] + v[i][2] * v[i][2] + v[i][3] * v[i][3];
#pragma unroll
        for (int m = 1; m < 64; m <<= 1) ss += shfl_xor_f(ss, m);
        float rstd = rsqrtf(ss * (1.f / 1024.f) + EPS);
#pragma unroll
        for (int i = 0; i < 4; ++i) {
            int c = i * 256 + lane * 4;
            f32x4 gg = *(const f32x4*)(g + c), sh = *(const f32x4*)(mrow + c), sc = *(const f32x4*)(mrow + 1024 + c);
            float o0 = v[i][0] * rstd * gg[0] * (1.f + sc[0]) + sh[0], o1 = v[i][1] * rstd * gg[1] * (1.f + sc[1]) + sh[1];
            float o2 = v[i][2] * rstd * gg[2] * (1.f + sc[2]) + sh[2], o3 = v[i][3] * rstd * gg[3] * (1.f + sc[3]) + sh[3];
            *(u32x2*)(h + (size_t)r * D + c) = (u32x2){pack2(o0, o1), pack2(o2, o3)};
        }
    }
}

DEV void phase_proj(const Params& p, int layer, int bid, int nb, char* smem) {
    const bf16_t* h = (const bf16_t*)(p.ws + OFF_H); const bf16_t* W = (const bf16_t*)(p.ws + OFF_WIN);
    const float* bperm = (const float*)(p.ws + OFF_BPERM);
    bf16_t* projb = (bf16_t*)(p.ws + OFF_PB); float* pref = (float*)(p.ws + OFF_PF); float* gates = (float*)(p.ws + OFF_GT);
    const int tid = get_tid(); const int lane = tid & 63, wid = tid >> 6, wm = wid >> 1, wn = wid & 1;
    constexpr int NTN = DIN_P / 128, NTM = R / 256;
    int tf, te, tstr; xcd_range(bid, nb, NTM * NTN, tf, te, tstr);
    gemm_tiles256(tf, te, tstr, 1024, smem, (const bf16_t*)(p.ws + OFF_ZERO),
        [&](int t, int which, int row) { int tm, tn; tile_decode(t, NTM, NTN, tm, tn); return which ? W + (size_t)(tn * 128 + row) * 1024 : h + (size_t)(tm * 256 + row) * D; },
        [&](int t, f32x16 (&acc)[4][2], char* stg) {
            int tm_, tn_; tile_decode(t, NTM, NTN, tm_, tn_);
            const int r0 = tm_ * 256, n0 = tn_ * 128;
            float bias[2];
#pragma unroll
            for (int j = 0; j < 2; ++j) bias[j] = bperm[n0 + wn * 64 + j * 32 + (lane & 31)];
            if (n0 < 1792 || (n0 >= 2304 && n0 < 2688)) {
                const int cdst = n0 < 1792 ? n0 : n0 - 512;
                epi256_bf16(acc, stg, tid, [&](float v, int, int col) { return v + bias[(col >> 5) & 1]; },
                            [&](int row, int c, u32x4 v) { *(u32x4*)(projb + (size_t)(r0 + row) * PBW + cdst + c * 8) = v; });
            } else if (n0 < 2304) {
#pragma unroll
                for (int i = 0; i < 4; ++i)
#pragma unroll
                    for (int j = 0; j < 2; ++j)
#pragma unroll
                        for (int r = 0; r < 16; ++r) acc[i][j][r] += bias[j];
                epi256_f32(acc, stg, tid, [&](int row, int c, f32x4 v) { *(f32x4*)(pref + (size_t)(r0 + row) * 512 + (n0 - 1792) + c * 4) = v; });
            } else {
#pragma unroll
                for (int i = 0; i < 4; ++i)
#pragma unroll
                    for (int j = 0; j < 2; ++j)
#pragma unroll
                        for (int r = 0; r < 16; ++r) acc[i][j][r] += bias[j];
                epi256_f32(acc, stg, tid, [&](int row, int c, f32x4 v) {
                    if (c < 8) { *(u32x2*)(projb + (size_t)(r0 + row) * PBW + PB_KR + c * 4) = (u32x2){pack2(v[0], v[1]), pack2(v[2], v[3])}; }
                    else if (c < 12) { *(f32x4*)(gates + (size_t)(r0 + row) * 16 + (c - 8) * 4) = v; } });
            }
        });
}

constexpr int SLD = 72;
DEV void mm64(f32x16& acc, const bf16_t* sA, const bf16_t* sBt, int wr, int wc, int lane) {
#pragma unroll
    for (int ks = 0; ks < 4; ++ks) {
        bf16x8 a = *(const bf16x8*)(sA + (wr * 32 + (lane & 31)) * SLD + ks * 16 + (lane >> 5) * 8);
        bf16x8 b = *(const bf16x8*)(sBt + (wc * 32 + (lane & 31)) * SLD + ks * 16 + (lane >> 5) * 8);
        acc = mfma32(a, b, acc);
    }
}
DEV int chunk_base(int dir, int c) { if (dir == 0) return c * 64; return (64 * c < CTXL) ? CTXL - 64 * (c + 1) : T + CTXL - 64 * (c + 1); }

DEV void mm64_nx(f32x16& acc, const bf16_t* sA, const bf16_t* X, int wr, int wc, int lane) {
#pragma unroll
    for (int ks = 0; ks < 4; ++ks) {
        bf16x8 a = *(const bf16x8*)(sA + (wr * 32 + (lane & 31)) * SLD + ks * 16 + (lane >> 5) * 8);
        bf16x8 b = tr_frag(X, SLD, ks, wc * 32, lane);
        acc = mfma32(a, b, acc);
    }
}
DEV int scan_tok(int dir, int j) { return dir ? 63 - j : j; }

template <bool NOOUT = false>
DEV void scan_ml(const Params& p, int layer, int b, int hd, int dir, char* smem) {
    const int tid = get_tid(), lane = tid & 63, wid = tid >> 6, wr = wid >> 1, wc = wid & 1;
    const bool need_ctx = layer == 0;
    const bf16_t* projb = (const bf16_t*)(p.ws + OFF_PB); const float* gates = (const float*)(p.ws + OFF_GT);
    bf16_t* outp = (bf16_t*)(p.ws + OFF_H) + (size_t)dir * R * 256;
    constexpr int RLD = 136;
    bf16_t* sRaw = (bf16_t*)smem;
    bf16_t* sQ = sRaw + 66 * RLD; bf16_t* sK = sQ + 64 * SLD; bf16_t* sV = sK + 64 * SLD; bf16_t* sP = sV + 64 * SLD; bf16_t* sCt = sP + 64 * SLD;
    float* fb = (float*)(sCt + 64 * SLD);
    float* s_rowf = fb, *s_wst = fb + 64, *s_emt = fb + 128, *s_e = fb + 192, *s_n = fb + 256, *s_sc = fb + 320, *s_cw = fb + 336;
    bf16_t* s_nh = (bf16_t*)(s_cw + 512); bf16_t* s_nl = s_nh + 64;
    float* s_wsv = s_cw + 512 + 64; float* s_fdv = s_wsv + 64;
    const bf16x8 ones = {0x3F80, 0x3F80, 0x3F80, 0x3F80, 0x3F80, 0x3F80, 0x3F80, 0x3F80};
    f32x16 cst;
#pragma unroll
    for (int r = 0; r < 16; ++r) cst[r] = 0.f;
    __syncthreads();
    for (int i = tid; i < 64 * SLD; i += NTHR) sCt[i] = 0;
    if (tid < 64) { s_n[tid] = 0.f; s_nh[tid] = 0; s_nl[tid] = 0; }
    if (tid < 128) {
        int col = (tid < 64 ? 0 : 256) + hd * 64 + (tid & 63);
        const float* cw = p.ml_conv_w + layer * 3 * 512;
        s_cw[tid] = cw[col]; s_cw[128 + tid] = cw[512 + col]; s_cw[256 + tid] = cw[1024 + col]; s_cw[384 + tid] = p.ml_conv_b[layer * 512 + col];
    }
    float mprev = 0.f;
    const size_t rb = (size_t)b * T;
    u32x4 praw[5], pv[2]; float pig = 0.f, pfg = 0.f;
    auto prefetch = [&](int c) {
        const int base = chunk_base(dir, c); const int seg_lo = base < CTXL ? 0 : CTXL, seg_hi = base < CTXL ? CTXL : T;
#pragma unroll
        for (int i = 0; i < 5; ++i) {
            int id = tid + NTHR * i; int row = id >> 4, cg = id & 15; int tok = base - 1 + row;
            praw[i] = (u32x4){0, 0, 0, 0};
            if (id < 66 * 16 && tok >= seg_lo && tok < seg_hi) praw[i] = *(const u32x4*)(projb + (rb + tok) * PBW + PB_MLQK + (cg < 8 ? 0 : 256) + hd * 64 + (cg & 7) * 8);
        }
#pragma unroll
        for (int i = 0; i < 2; ++i) { int id = tid + NTHR * i; int row = id >> 3, cg = id & 7; pv[i] = *(const u32x4*)(projb + (rb + base + row) * PBW + PB_MLV + hd * 64 + cg * 8); }
        if (tid < 64) { const float* g = gates + (rb + base + scan_tok(dir, tid)) * 16 + dir * 8 + hd; pig = g[0]; pfg = g[4]; }
    };
    prefetch(0);
    for (int c = 0; c < NC; ++c) {
        const int base = chunk_base(dir, c);
        const bool want_out = !NOOUT && (need_ctx || base >= CTXL);
#pragma unroll
        for (int i = 0; i < 5; ++i) { int id = tid + NTHR * i; if (id < 66 * 16) *(u32x4*)(sRaw + (id >> 4) * RLD + (id & 15) * 8) = praw[i]; }
#pragma unroll
        for (int i = 0; i < 2; ++i) { int id = tid + NTHR * i; *(u32x4*)(sV + (id >> 3) * SLD + (id & 7) * 8) = pv[i]; }
        if (tid < 64) {
            float ig = pig, lf = logsigmoidf_(pfg);
            float bc = wave_scan_add(lf, lane);
            float a = ig - bc, pm = wave_scan_max(a, lane);
            float mu = shfl_idx_f(pm, 63);
            float mm_ = fmaxf(mprev, pm);
            int u = scan_tok(dir, lane);
            s_rowf[u] = __expf(fminf(mu - mm_, 80.f)); s_wst[u] = __expf(mprev - mm_); s_emt[u] = __expf(-(bc + mm_)); s_e[u] = __expf(a - mu);
            float mx = fmaxf(mprev, mu);
            s_wsv[lane] = __expf(mprev - mx); s_fdv[lane] = __expf(mu - mx);
            mprev = shfl_idx_f(bc, 63) + mx;
        }
        if (c + 1 < NC) prefetch(c + 1);
        __syncthreads();
#pragma unroll
        for (int i = 0; i < 4; ++i) {
            int id = tid + NTHR * i; int u = id >> 4, cg = id & 15;
            const bf16_t* r1 = sRaw + (u + 1) * RLD + cg * 8;
            u32x4 c0 = *(const u32x4*)(r1 - RLD), c1 = *(const u32x4*)r1, c2 = *(const u32x4*)(r1 + RLD);
            float sc = cg < 8 ? 1.f : 0.125f * s_e[u];
            float o[8];
#pragma unroll
            for (int q = 0; q < 8; ++q) {
                unsigned w0 = c0[q >> 1], w1 = c1[q >> 1], w2 = c2[q >> 1];
                float a0 = bf2f((bf16_t)((q & 1) ? w0 >> 16 : w0 & 0xffff)), a1 = bf2f((bf16_t)((q & 1) ? w1 >> 16 : w1 & 0xffff)), a2 = bf2f((bf16_t)((q & 1) ? w2 >> 16 : w2 & 0xffff));
                int cc = cg * 8 + q;
                o[q] = siluf_(s_cw[cc] * a0 + s_cw[128 + cc] * a1 + s_cw[256 + cc] * a2 + s_cw[384 + cc]) * sc;
            }
            *(u32x4*)((cg < 8 ? sQ : sK) + u * SLD + (cg & 7) * 8) = (u32x4){pack2(o[0], o[1]), pack2(o[2], o[3]), pack2(o[4], o[5]), pack2(o[6], o[7])};
        }
        __syncthreads();
        f32x16 accn, accd;
#pragma unroll
        for (int r = 0; r < 16; ++r) { accn[r] = 0.f; accd[r] = 0.f; }
        if (want_out) {
            f32x16 acc;
#pragma unroll
            for (int r = 0; r < 16; ++r) acc[r] = 0.f;
            const bool skip = dir ? (wr == 1 && wc == 0) : (wr == 0 && wc == 1);
            if (!skip) mm64(acc, sQ, sK, wr, wc, lane);
            {
                int sidx = wc * 32 + (lane & 31);
#pragma unroll
                for (int r = 0; r < 16; ++r) {
                    int t = wr * 32 + crow(r, lane);
                    bool ok = dir ? (sidx >= t) : (sidx <= t);
                    sP[t * SLD + sidx] = f2bf(ok ? acc[r] * s_rowf[t] : 0.f);
                }
            }
            mm64(accn, sQ, sCt, wr, wc, lane);
#pragma unroll
            for (int ks = 0; ks < 4; ++ks) {
                bf16x8 a = *(const bf16x8*)(sQ + (wr * 32 + (lane & 31)) * SLD + ks * 16 + (lane >> 5) * 8);
                accd = mfma32(a, *(const bf16x8*)(s_nh + ks * 16 + (lane >> 5) * 8), accd);
                accd = mfma32(a, *(const bf16x8*)(s_nl + ks * 16 + (lane >> 5) * 8), accd);
            }
#pragma unroll
            for (int r = 0; r < 16; ++r) { float w = s_wst[wr * 32 + crow(r, lane)]; accn[r] *= w; accd[r] *= w; }
        }
        __syncthreads();
        if (want_out) {
#pragma unroll
            for (int ks = 0; ks < 4; ++ks) {
                bf16x8 a = *(const bf16x8*)(sP + (wr * 32 + (lane & 31)) * SLD + ks * 16 + (lane >> 5) * 8);
                accn = mfma32(a, tr_frag(sV, SLD, ks, wc * 32, lane), accn);
                accd = mfma32(a, ones, accd);
            }
            int v = wc * 32 + (lane & 31);
#pragma unroll
            for (int r = 0; r < 16; ++r) {
                int t = wr * 32 + crow(r, lane);
                float den = fmaxf(fabsf(accd[r]), s_emt[t]);
                outp[(rb + base + t) * 256 + hd * 64 + v] = f2bf(accn[r] * fast_rcp(den));
            }
        }
        {
            f32x16 x, nacc;
#pragma unroll
            for (int r = 0; r < 16; ++r) { x[r] = 0.f; nacc[r] = 0.f; }
#pragma unroll
            for (int ks = 0; ks < 4; ++ks) {
                bf16x8 a = tr_frag(sK, SLD, ks, wr * 32, lane);
                x = mfma32(a, tr_frag(sV, SLD, ks, wc * 32, lane), x);
                nacc = mfma32(a, ones, nacc);
            }
            const float ws = s_wsv[lane], fd = s_fdv[lane];
            int v = wc * 32 + (lane & 31);
#pragma unroll
            for (int r = 0; r < 16; ++r) { cst[r] = ws * cst[r] + fd * x[r]; sCt[v * SLD + wr * 32 + crow(r, lane)] = f2bf(cst[r]); }
            if (wc == 0 && (lane & 31) == 0) {
#pragma unroll
                for (int r = 0; r < 16; ++r) {
                    int k = wr * 32 + crow(r, lane); float nn = ws * s_n[k] + fd * nacc[r];
                    s_n[k] = nn; bf16_t hi = f2bf(nn); s_nh[k] = hi; s_nl[k] = f2bf(nn - bf2f(hi));
                }
            }
        }
        __syncthreads();
    }
}

template <bool NOOUT = false>
DEV void scan_hg(const Params& p, int layer, int b, int hd, int dir, char* smem) {
    const int tid = get_tid(), lane = tid & 63, wid = tid >> 6, wr = wid >> 1, wc = wid & 1;
    const bool need_ctx = layer == 0;
    const bf16_t* projb = (const bf16_t*)(p.ws + OFF_PB); const float* pref = (const float*)(p.ws + OFF_PF);
    bf16_t* outp = (bf16_t*)(p.ws + OFF_H) + (size_t)(2 + dir) * R * 256;
    const float* lbp = (const float*)(p.ws + OFF_LB) + layer * 512 + dir * 256 + hd * 64;
    bf16_t* sQs = (bf16_t*)smem; bf16_t* sKs = sQs + 64 * SLD; bf16_t* sV = sKs + 64 * SLD; bf16_t* sP = sV + 64 * SLD; bf16_t* sSt = sP + 64 * SLD;
    float* s_ps = (float*)(sSt + 64 * SLD);
    float* s_r = s_ps + 256; float* s_bend = s_r + 64;
    f32x16 st;
#pragma unroll
    for (int r = 0; r < 16; ++r) st[r] = 0.f;
    __syncthreads();
    const int k = tid & 63, part = tid >> 6;
    const float low = lbp[k];
    const size_t rb = (size_t)b * T;
    float ppre[16]; bf16_t pq[16]; u32x4 pv[2];
    auto prefetch = [&](int c) {
        const int base = chunk_base(dir, c);
#pragma unroll
        for (int i = 0; i < 16; ++i) {
            int tok = base + scan_tok(dir, part * 16 + i);
            ppre[i] = pref[(rb + tok) * 512 + dir * 256 + hd * 64 + k];
            pq[i] = projb[(rb + tok) * PBW + PB_HGQ + hd * 64 + k];
        }
#pragma unroll
        for (int i = 0; i < 2; ++i) { int id = tid + NTHR * i; int row = id >> 3, cg = id & 7; pv[i] = *(const u32x4*)(projb + (rb + base + row) * PBW + PB_HGV + hd * 64 + cg * 8); }
    };
    prefetch(0);
    for (int c = 0; c < NC; ++c) {
        const int base = chunk_base(dir, c);
        const bool want_out = !NOOUT && (need_ctx || base >= CTXL);
        float kk[16], lfc[16], qv[16]; float run = 0.f;
#pragma unroll
        for (int i = 0; i < 16; ++i) {
            float pre = ppre[i];
            float lf = (low == 0.f) ? logsigmoidf_(pre) : __logf(low + (1.f - low) * sigmoidf_(pre));
            kk[i] = (1.f - low) * sigmoidf_(-pre);
            run += lf; lfc[i] = run; qv[i] = siluf_(bf2f(pq[i]));
        }
        s_ps[part * 64 + k] = run;
#pragma unroll
        for (int i = 0; i < 2; ++i) { int id = tid + NTHR * i; *(u32x4*)(sV + (id >> 3) * SLD + (id & 7) * 8) = pv[i]; }
        if (c + 1 < NC) prefetch(c + 1);
        __syncthreads();
        float off = 0.f;
        for (int q = 0; q < part; ++q) off += s_ps[q * 64 + k];
#pragma unroll
        for (int i = 0; i < 16; ++i) lfc[i] += off;
        if (part == 1) s_r[k] = lfc[15];
        if (part == 3) s_bend[k] = lfc[15];
        __syncthreads();
        const float rref = s_r[k];
#pragma unroll
        for (int i = 0; i < 16; ++i) {
            int u = scan_tok(dir, part * 16 + i);
            sQs[u * SLD + k] = f2bf(qv[i] * __expf(lfc[i] - rref));
            sKs[u * SLD + k] = f2bf(kk[i] * __expf(rref - lfc[i]));
        }
        {
            int v = wc * 32 + (lane & 31);
#pragma unroll
            for (int r = 0; r < 16; ++r) { int kr = wr * 32 + crow(r, lane); sSt[v * SLD + kr] = f2bf(st[r] * __expf(s_r[kr])); }
        }
        __syncthreads();
        f32x16 acc;
#pragma unroll
        for (int r = 0; r < 16; ++r) acc[r] = 0.f;
        if (want_out) {
            f32x16 sacc;
#pragma unroll
            for (int r = 0; r < 16; ++r) sacc[r] = 0.f;
            const bool skip = dir ? (wr == 1 && wc == 0) : (wr == 0 && wc == 1);
            if (!skip) mm64(sacc, sQs, sKs, wr, wc, lane);
            int sidx = wc * 32 + (lane & 31);
#pragma unroll
            for (int r = 0; r < 16; ++r) { int t = wr * 32 + crow(r, lane); bool ok = dir ? (sidx >= t) : (sidx <= t); sP[t * SLD + sidx] = f2bf(ok ? sacc[r] : 0.f); }
            mm64(acc, sQs, sSt, wr, wc, lane);
        }
        __syncthreads();
        if (want_out) {
            mm64_nx(acc, sP, sV, wr, wc, lane);
            int v = wc * 32 + (lane & 31);
#pragma unroll
            for (int r = 0; r < 16; ++r) { int t = wr * 32 + crow(r, lane); outp[(rb + base + t) * 256 + hd * 64 + v] = f2bf(acc[r]); }
        }
        {
            f32x16 x;
#pragma unroll
            for (int r = 0; r < 16; ++r) x[r] = 0.f;
#pragma unroll
            for (int ks = 0; ks < 4; ++ks) x = mfma32(tr_frag(sKs, SLD, ks, wr * 32, lane), tr_frag(sV, SLD, ks, wc * 32, lane), x);
#pragma unroll
            for (int r = 0; r < 16; ++r) { int kr = wr * 32 + crow(r, lane); float be = s_bend[kr]; st[r] = __expf(be) * st[r] + __expf(be - s_r[kr]) * x[r]; }
        }
        __syncthreads();
    }
}
DEV void phase_scan(const Params& p, int layer, int bid, int nb, char* smem) {
    const int nchains = BATCH * 4 * 2 * 2;
    for (int it = bid; it < nchains; it += nb) {
        int type = it & 1, dir = (it >> 1) & 1, hd = (it >> 2) & 3, b = it >> 4;
        if (type == 0) scan_ml(p, layer, b, hd, dir, smem); else scan_hg(p, layer, b, hd, dir, smem);
    }
}
template <int WHICH>
DEV void phase_scan_probe(const Params& p, int layer, int bid, int nb, char* smem) {
    const int nchains = BATCH * 4 * 2 * 2;
    for (int it = bid; it < nchains; it += nb) {
        int type = it & 1, dir = (it >> 1) & 1, hd = (it >> 2) & 3, b = it >> 4;
        if (WHICH == 0) { if (type == 0) scan_ml<true>(p, layer, b, hd, dir, smem); else scan_hg<true>(p, layer, b, hd, dir, smem); }
        if (WHICH == 1 && type == 0) scan_ml(p, layer, b, hd, dir, smem);
        if (WHICH == 2 && type == 1) scan_hg(p, layer, b, hd, dir, smem);
    }
}

template <int TN, class ARows, class BRows, class Epi>
DEV void gemm_stream_w4(int first, int end, int stride, int nsub, int KT, char* smem, const bf16_t* zrow, ARows arows, BRows brows, Epi epi) {
    constexpr int STAGE = 32768, A_BYTES = 16384;
    const int tid = get_tid(), lane = tid & 63, wid = tid >> 6;
    if (first >= end) return;
    const int nt = (end - first + stride - 1) / stride; const int G = nt * nsub * KT;
    int lli = 0, lsub = 0, lkt = 0, lg = 0;
    auto issue = [&]() {
        const int t = first + lli * stride;
        bf16_t* sa = (bf16_t*)(smem + (lg & 1) * STAGE); bf16_t* sb = (bf16_t*)(smem + (lg & 1) * STAGE + A_BYTES);
#pragma unroll
        for (int i = 0; i < 4; ++i) { int row = (i * 4 + wid) * 8 + (lane >> 3); const bf16_t* pa = arows(t, row); glds16(pa ? pa + swz(row, lane & 7) * 8 + lkt * 64 : zrow, sa + (i * 4 + wid) * 512 + lane * 8); }
#pragma unroll
        for (int i = 0; i < TN; ++i) { int row = (i * 4 + wid) * 8 + (lane >> 3); glds16(brows(t, lsub, row) + swz(row, lane & 7) * 8 + lkt * 64, sb + (i * 4 + wid) * 512 + lane * 8); }
        ++lg; if (++lkt == KT) { lkt = 0; if (++lsub == nsub) { lsub = 0; ++lli; } }
    };
    __syncthreads();
    issue();
    glds_wait();
    __syncthreads();
    int g = 0;
    for (int li = 0; li < nt; ++li)
        for (int sub = 0; sub < nsub; ++sub) {
            f32x16 acc[TN];
#pragma unroll
            for (int j = 0; j < TN; ++j)
#pragma unroll
                for (int r = 0; r < 16; ++r) acc[j][r] = 0.f;
            for (int kt = 0; kt < KT; ++kt, ++g) {
                if (lg < G) issue();
                const bf16_t* sa = (const bf16_t*)(smem + (g & 1) * STAGE); const bf16_t* sb = (const bf16_t*)((const char*)sa + A_BYTES);
#pragma unroll
                for (int ks = 0; ks < 4; ++ks) {
                    const int c = ks * 2 + (lane >> 5);
                    int ra = wid * 32 + (lane & 31);
                    bf16x8 af = *(const bf16x8*)(sa + ra * 64 + swz(ra, c) * 8);
#pragma unroll
                    for (int j = 0; j < TN; ++j) { int rb = j * 32 + (lane & 31); acc[j] = mfma32(af, *(const bf16x8*)(sb + rb * 64 + swz(rb, c) * 8), acc[j]); }
                }
                glds_wait();
                __syncthreads();
            }
            epi(first + li * stride, sub, acc);
            __syncthreads();
        }
}

DEV void phase_mla(const Params& p, int layer, int bid, int nb, char* smem) {
    const int tid = get_tid(), lane = tid & 63, wid = tid >> 6, cl = lane & 31;
    const bool need_ctx = layer == 0;
    const bf16_t* projb = (const bf16_t*)(p.ws + OFF_PB);
    bf16_t* Qg = (bf16_t*)(p.ws + OFF_QKV); bf16_t* Kg = Qg + (size_t)BATCH * 8 * T * 96; bf16_t* Vt = Kg + (size_t)BATCH * 8 * T * 96;
    const float* rope = (const float*)(p.ws + OFF_ROPE);
    const bf16_t* WUQ = (const bf16_t*)(p.ws + OFF_WUQ); const bf16_t* WUKV = (const bf16_t*)(p.ws + OFF_WUKV);
    const bf16_t* zrow = (const bf16_t*)(p.ws + OFF_ZERO);
    bf16_t* stK = (bf16_t*)(smem + EPI_OFF);
    bf16_t* stV = (bf16_t*)(smem + EPI_OFF + 24576);
    float* s_rstd = (float*)(smem + EPI_OFF + 24576 + 17408);
    constexpr int NSUB = 2, NHG = 8 / NSUB;
    const int tpb = need_ctx ? T / 128 : SEQ / 128;
    auto row_rstd = [&](int r0, int col0, int ncol) {
        int row = tid >> 1, half = tid & 1; const bf16_t* src = projb + (size_t)(r0 + row) * PBW + col0 + half * (ncol / 2);
        float ss = 0.f;
        for (int i = 0; i < ncol / 2; i += 8) { u32x4 v = *(const u32x4*)(src + i);
#pragma unroll
            for (int q = 0; q < 4; ++q) { float lo = bf2f((bf16_t)(v[q] & 0xffff)), hi = bf2f((bf16_t)(v[q] >> 16)); ss += lo * lo + hi * hi; } }
        ss += shfl_xor_f(ss, 1);
        if (half == 0) s_rstd[row] = rsqrtf(ss / (float)ncol + EPS);
        __syncthreads();
    };
    {
        auto qrow0 = [&](int t) { int rt = t / NHG; int b = rt / tpb, j = rt % tpb; return b * T + (need_ctx ? 0 : CTXL) + j * 128; };
        const int nrt = BATCH * tpb; const bool xok = (nb % 8 == 0) && (nrt % 8 == 0);
        auto qmap = [&](int t) { if (!xok) return t; int idx = t >> 3, g = t & 7; int rtl = idx / NHG, hgp = idx % NHG; return (rtl * 8 + g) * NHG + hgp; };
        gemm_stream_w4<3>(xok ? (bid & 7) + 8 * (bid >> 3) : bid, nrt * NHG, nb, NSUB, 4, smem, zrow,
            [&](int t0_, int row) { int t = qmap(t0_); return projb + (size_t)(qrow0(t) + row) * PBW + PB_CQ; },
            [&](int t0_, int sub, int row) { int t = qmap(t0_); int hd = (t % NHG) * NSUB + sub; return WUQ + (size_t)(hd * 96 + row) * 256; },
            [&](int t0_, int sub, f32x16 (&acc)[3]) {
                const int t = qmap(t0_); const int r0 = qrow0(t), hd = (t % NHG) * NSUB + sub; const int b = r0 / T, t0 = r0 % T; const bool islat = t0 >= CTXL;
                if (sub == 0) row_rstd(r0, PB_CQ, 256);
                const float* gq = p.mla_q_qk_g + layer * 96;
                float ssq[16];
#pragma unroll
                for (int r = 0; r < 16; ++r) { float rs = s_rstd[wid * 32 + crow(r, lane)]; float sacc = 0.f;
#pragma unroll
                    for (int j = 0; j < 3; ++j) { acc[j][r] *= rs; sacc += acc[j][r] * acc[j][r]; }
                    ssq[r] = sacc; }
#pragma unroll
                for (int m = 1; m < 32; m <<= 1)
#pragma unroll
                    for (int r = 0; r < 16; ++r) ssq[r] += shfl_xor_f(ssq[r], m);
#pragma unroll
                for (int r = 0; r < 16; ++r) {
                    float rn = rsqrtf(ssq[r] * (1.f / 96.f) + EPS) * QSCL; int rl = wid * 32 + crow(r, lane); int tt = t0 + rl;
                    float v0 = acc[0][r] * rn * gq[cl], v1 = acc[1][r] * rn * gq[32 + cl], v2 = acc[2][r] * rn * gq[64 + cl];
                    float pv = shfl_xor_f(v2, 8);
                    if (islat) { const float* rt = rope + (size_t)(tt - CTXL) * 32 + (cl >> 4) * 16; int j = cl & 7; float cs = rt[j], sn = rt[8 + j]; v2 = v2 * cs + ((cl & 8) ? pv : -pv) * sn; }
                    stK[rl * 96 + cl] = f2bf(v0); stK[rl * 96 + 32 + cl] = f2bf(v1); stK[rl * 96 + 64 + cl] = f2bf(v2);
                    SCHED_FENCE();
                }
                __syncthreads();
                u32x4* dst = (u32x4*)(Qg + (((size_t)b * 8 + hd) * T + t0) * 96);
#pragma unroll
                for (int q = 0; q < 6; ++q) dst[tid + NTHR * q] = ((const u32x4*)stK)[tid + NTHR * q];
            });
    }
    {
        const int nrk = R / 128; const bool xk = (nb % 8 == 0) && (nrk % 8 == 0);
        auto kmap = [&](int t) { if (!xk) return t; int idx = t >> 3, g = t & 7; int rtl = idx / NHG, hgp = idx % NHG; return (rtl * 8 + g) * NHG + hgp; };
        gemm_stream_w4<4>(bid, nrk * NHG, nb, NSUB, 2, smem, zrow,
            [&](int t0_, int row) { int t = kmap(t0_); return projb + (size_t)((t / NHG) * 128 + row) * PBW + PB_CKV; },
            [&](int t0_, int sub, int row) { int t = kmap(t0_); int hd = (t % NHG) * NSUB + sub; return WUKV + (size_t)(hd * 128 + row) * 128; },
            [&](int t0_, int sub, f32x16 (&acc)[4]) {
                const int t = kmap(t0_); const int r0 = (t / NHG) * 128, hd = (t % NHG) * NSUB + sub; const int b = r0 / T, t0 = r0 % T; const bool islat = t0 >= CTXL;
                if (sub == 0) row_rstd(r0, PB_CKV, 128);
                bf16_t* sV = (bf16_t*)(smem + EPI_OFF);
#pragma unroll
                for (int j = 0; j < 2; ++j)
#pragma unroll
                    for (int g = 0; g < 4; ++g) {
                        int tl = wid * 32 + 8 * g + 4 * (lane >> 5); int dv = j * 32 + cl;
                        f32x4 rs4 = *(const f32x4*)(s_rstd + tl);
                        *(u32x2*)(sV + dv * CLD + tl) = (u32x2){pack2(acc[2 + j][4 * g] * rs4[0], acc[2 + j][4 * g + 1] * rs4[1]), pack2(acc[2 + j][4 * g + 2] * rs4[2], acc[2 + j][4 * g + 3] * rs4[3])};
                    }
                __syncthreads();
#pragma unroll
                for (int q = 0; q < 4; ++q) { int id = tid + NTHR * q; int dv = id >> 4, c = id & 15; *(u32x4*)(Vt + (((size_t)b * 8 + hd) * 64 + dv) * T + t0 + c * 8) = *(const u32x4*)(sV + dv * CLD + c * 8); }
                __syncthreads();
                constexpr int KFL = 68;
                float* sKf = (float*)(smem + EPI_OFF);
#pragma unroll
                for (int j = 0; j < 2; ++j)
#pragma unroll
                    for (int r = 0; r < 16; ++r) { int rl = wid * 32 + crow(r, lane); sKf[rl * KFL + j * 32 + cl] = acc[j][r] * s_rstd[rl]; }
                __syncthreads();
                {
                    const int row = tid >> 1, half = tid & 1; const int tt = t0 + row;
                    const float* gk = p.mla_k_qk_g + layer * 96;
                    float v[48];
                    if (half == 0) {
#pragma unroll
                        for (int c = 0; c < 48; c += 4) { f32x4 x = *(const f32x4*)(sKf + row * KFL + c); v[c] = x[0]; v[c + 1] = x[1]; v[c + 2] = x[2]; v[c + 3] = x[3]; }
                    } else {
#pragma unroll
                        for (int c = 0; c < 16; c += 4) { f32x4 x = *(const f32x4*)(sKf + row * KFL + 48 + c); v[c] = x[0]; v[c + 1] = x[1]; v[c + 2] = x[2]; v[c + 3] = x[3]; }
                        const u32x4* kp = (const u32x4*)(projb + (size_t)(r0 + row) * PBW + PB_KR);
#pragma unroll
                        for (int q = 0; q < 4; ++q) { u32x4 w = kp[q];
#pragma unroll
                            for (int e = 0; e < 4; ++e) { v[16 + q * 8 + 2 * e] = bf2f((bf16_t)(w[e] & 0xffff)); v[16 + q * 8 + 2 * e + 1] = bf2f((bf16_t)(w[e] >> 16)); } }
                    }
                    float ss = 0.f;
#pragma unroll
                    for (int c = 0; c < 48; ++c) ss += v[c] * v[c];
                    ss += shfl_xor_f(ss, 1);
                    const float rn = rsqrtf(ss * (1.f / 96.f) + EPS);
#pragma unroll
                    for (int c = 0; c < 48; ++c) v[c] *= rn * gk[half * 48 + c];
                    if (half == 1 && islat) {
                        const float* rt = rope + (size_t)(tt - CTXL) * 32;
#pragma unroll
                        for (int gph = 0; gph < 2; ++gph)
#pragma unroll
                            for (int j = 0; j < 8; ++j) {
                                float cs = rt[gph * 16 + j], sn = rt[gph * 16 + 8 + j]; float x1 = v[16 + gph * 16 + j], x2 = v[16 + gph * 16 + 8 + j];
                                v[16 + gph * 16 + j] = x1 * cs - x2 * sn; v[16 + gph * 16 + 8 + j] = x2 * cs + x1 * sn;
                            }
                    }
                    u32x4* dst = (u32x4*)(Kg + (((size_t)b * 8 + hd) * T + tt) * 96 + half * 48);
#pragma unroll
                    for (int q = 0; q < 6; ++q) dst[q] = (u32x4){pack2(v[q * 8], v[q * 8 + 1]), pack2(v[q * 8 + 2], v[q * 8 + 3]), pack2(v[q * 8 + 4], v[q * 8 + 5]), pack2(v[q * 8 + 6], v[q * 8 + 7])};
                }
            });
    }
}

DEV void phase_attn(const Params& p, int layer, int bid, int nb, char* smem) {
    const int tid = get_tid(), lane = tid & 63, wid = tid >> 6, cl = lane & 31, hh = lane >> 5;
    const bool need_ctx = layer == 0;
    const bf16_t* Qg = (const bf16_t*)(p.ws + OFF_QKV); const bf16_t* Kg = Qg + (size_t)BATCH * 8 * T * 96; const bf16_t* Vt = Kg + (size_t)BATCH * 8 * T * 96;
    bf16_t* yb = (bf16_t*)(p.ws + OFF_PF);
    constexpr int KA = 64 * 128, KB = 64 * 64, VB = 64 * 128, STG = KA + KB + VB;
    constexpr int NQT = T / 128;
    const int nlat = SEQ / 128, nctx = need_ctx ? CTXL / 128 : 0; const int per_bh = nlat + nctx;
    const int nlat_items = BATCH * 8 * nlat, nctx_items = BATCH * 8 * nctx;
    const bool xcd_ok = (nb % 8 == 0) && ((BATCH * 8) % 8 == 0);
    const int lat_first = xcd_ok ? (bid >> 3) : bid, lat_stride = xcd_ok ? (nb >> 3) : nb, lat_cnt = xcd_ok ? nlat_items / 8 : nlat_items;
    const int my_lat = lat_first < lat_cnt ? (lat_cnt - lat_first + lat_stride - 1) / lat_stride : 0;
    const int my_ctx = bid < nctx_items ? (nctx_items - bid + nb - 1) / nb : 0;
    for (int wi = 0; wi < my_lat + my_ctx; ++wi) {
        int bh, qt;
        if (wi < my_lat) { int idx = lat_first + wi * lat_stride; int bhl = idx / nlat; qt = CTXL / 128 + idx % nlat; bh = xcd_ok ? bhl * 8 + (bid & 7) : bhl; }
        else { int u = bid + (wi - my_lat) * nb; bh = u / nctx; qt = u % nctx; }
        int t0 = qt * 128; const bool islat = t0 >= CTXL;
        const int nkeys = islat ? T : CTXL; const int nkt = nkeys / 64;
        const bf16_t* Kb_ = Kg + (size_t)bh * T * 96; const bf16_t* Vb_ = Vt + (size_t)bh * 64 * T;
        bf16x8 qf[6];
        { const bf16_t* q = Qg + ((size_t)bh * T + t0 + wid * 32 + cl) * 96 + hh * 8;
#pragma unroll
          for (int s2 = 0; s2 < 6; ++s2) qf[s2] = *(const bf16x8*)(q + s2 * 16); }
        f32x16 o0, o1;
#pragma unroll
        for (int r = 0; r < 16; ++r) { o0[r] = 0.f; o1[r] = 0.f; }
        float mrun = -1e30f, lrun = 0.f;
        auto stage_load = [&](int buf, int kt) {
            bf16_t* ska = (bf16_t*)(smem + buf * STG); bf16_t* skb = (bf16_t*)(smem + buf * STG + KA); bf16_t* sv = (bf16_t*)(smem + buf * STG + KA + KB);
#pragma unroll
            for (int i = 0; i < 2; ++i) { int row = (i * 4 + wid) * 8 + (lane >> 3); glds16(Kb_ + (size_t)(kt * 64 + row) * 96 + swz(row, lane & 7) * 8, ska + (i * 4 + wid) * 512 + lane * 8); }
            { int row = wid * 16 + (lane >> 2); glds16(Kb_ + (size_t)(kt * 64 + row) * 96 + 64 + swz4(row, lane & 3) * 8, skb + wid * 512 + lane * 8); }
#pragma unroll
            for (int i = 0; i < 2; ++i) { int row = (i * 4 + wid) * 8 + (lane >> 3); glds16(Vb_ + (size_t)row * T + kt * 64 + swz(row, lane & 7) * 8, sv + (i * 4 + wid) * 512 + lane * 8); }
        };
        __syncthreads();
        stage_load(0, 0);
        glds_wait();
        __syncthreads();
        for (int kt = 0; kt < nkt; ++kt) {
            if (kt + 1 < nkt) stage_load((kt + 1) & 1, kt + 1);
            const bf16_t* ska = (const bf16_t*)(smem + (kt & 1) * STG); const bf16_t* skb = (const bf16_t*)(smem + (kt & 1) * STG + KA); const bf16_t* sv = (const bf16_t*)(smem + (kt & 1) * STG + KA + KB);
            f32x16 s0, s1;
#pragma unroll
            for (int r = 0; r < 16; ++r) { s0[r] = 0.f; s1[r] = 0.f; }
#pragma unroll
            for (int s2 = 0; s2 < 4; ++s2) {
                int c = s2 * 2 + hh;
                bf16x8 k0 = *(const bf16x8*)(ska + cl * 64 + swz(cl, c) * 8), k1 = *(const bf16x8*)(ska + (32 + cl) * 64 + swz(32 + cl, c) * 8);
                s0 = mfma32(k0, qf[s2], s0); s1 = mfma32(k1, qf[s2], s1);
            }
#pragma unroll
            for (int s2 = 4; s2 < 6; ++s2) {
                int c = (s2 - 4) * 2 + hh;
                bf16x8 k0 = *(const bf16x8*)(skb + cl * 32 + swz4(cl, c) * 8), k1 = *(const bf16x8*)(skb + (32 + cl) * 32 + swz4(32 + cl, c) * 8);
                s0 = mfma32(k0, qf[s2], s0); s1 = mfma32(k1, qf[s2], s1);
            }
            float mx = -1e30f;
#pragma unroll
            for (int r = 0; r < 16; ++r) mx = fmaxf(mx, fmaxf(s0[r], s1[r]));
            mx = fmaxf(mx, shfl_xor_f(mx, 32));
            if (!wave_all(mx <= mrun + 8.f)) {
                float mnew = fmaxf(mrun, mx), alpha = fast_exp2(mrun - mnew); mrun = mnew; lrun *= alpha;
#pragma unroll
                for (int r = 0; r < 16; ++r) { o0[r] *= alpha; o1[r] *= alpha; }
            }
            float ls = 0.f;
#pragma unroll
            for (int r = 0; r < 16; ++r) { s0[r] = fast_exp2(s0[r] - mrun); s1[r] = fast_exp2(s1[r] - mrun); ls += s0[r] + s1[r]; }
            lrun += ls;
#pragma unroll
            for (int s2 = 0; s2 < 4; ++s2) {
                const f32x16& sx = (s2 < 2) ? s0 : s1; int rbase = (s2 & 1) * 8;
                bf16x8 pb;
#pragma unroll
                for (int j = 0; j < 8; ++j) pb[j] = (short)f2bf(sx[rbase + j]);
#pragma unroll
                for (int i = 0; i < 2; ++i) {
                    int row = i * 32 + cl;
                    bf16x4 lo = *(const bf16x4*)(sv + row * 64 + swz(row, 2 * s2) * 8 + 4 * hh), hi = *(const bf16x4*)(sv + row * 64 + swz(row, 2 * s2 + 1) * 8 + 4 * hh);
                    bf16x8 va = {lo[0], lo[1], lo[2], lo[3], hi[0], hi[1], hi[2], hi[3]};
                    if (i == 0) o0 = mfma32(va, pb, o0); else o1 = mfma32(va, pb, o1);
                }
            }
            glds_wait();
            __syncthreads();
        }
        lrun += shfl_xor_f(lrun, 32);
        float inv = 1.f / lrun;
        int b = bh >> 3, hd = bh & 7; size_t row = (size_t)b * T + t0 + wid * 32 + cl;
#pragma unroll
        for (int i = 0; i < 2; ++i)
#pragma unroll
            for (int g = 0; g < 4; ++g) {
                const f32x16& ox = i ? o1 : o0; int dv = i * 32 + 8 * g + 4 * hh;
                *(u32x2*)(yb + row * 1024 + 512 + hd * 64 + dv) = (u32x2){pack2(ox[4 * g] * inv, ox[4 * g + 1] * inv), pack2(ox[4 * g + 2] * inv, ox[4 * g + 3] * inv)};
            }
    }
    (void)NQT;
}

template <int MODE>
DEV void phase_attn_probe(const Params& p, int layer, int bid, int nb, char* smem) {
    const int tid = get_tid(), lane = tid & 63, wid = tid >> 6, cl = lane & 31, hh = lane >> 5;
    const bool need_ctx = layer == 0;
    const bf16_t* Qg = (const bf16_t*)(p.ws + OFF_QKV); const bf16_t* Kg = Qg + (size_t)BATCH * 8 * T * 96; const bf16_t* Vt = Kg + (size_t)BATCH * 8 * T * 96;
    bf16_t* yb = (bf16_t*)(p.ws + OFF_H);
    constexpr int KA = 64 * 128, KB = 64 * 64, VB = 64 * 128, STG = KA + KB + VB;
    constexpr int NQT = T / 128;
    const int nlat = SEQ / 128, nctx = need_ctx ? CTXL / 128 : 0; const int per_bh = nlat + nctx;
    const int nlat_items = BATCH * 8 * nlat, nctx_items = BATCH * 8 * nctx;
    const bool xcd_ok = (nb % 8 == 0) && ((BATCH * 8) % 8 == 0);
    const int lat_first = xcd_ok ? (bid >> 3) : bid, lat_stride = xcd_ok ? (nb >> 3) : nb, lat_cnt = xcd_ok ? nlat_items / 8 : nlat_items;
    const int my_lat = lat_first < lat_cnt ? (lat_cnt - lat_first + lat_stride - 1) / lat_stride : 0;
    const int my_ctx = bid < nctx_items ? (nctx_items - bid + nb - 1) / nb : 0;
    for (int wi = 0; wi < my_lat + my_ctx; ++wi) {
        int bh, qt;
        if (wi < my_lat) { int idx = lat_first + wi * lat_stride; int bhl = idx / nlat; qt = CTXL / 128 + idx % nlat; bh = xcd_ok ? bhl * 8 + (bid & 7) : bhl; }
        else { int u = bid + (wi - my_lat) * nb; bh = u / nctx; qt = u % nctx; }
        int t0 = qt * 128; const bool islat = t0 >= CTXL;
        const int nkeys = islat ? T : CTXL; const int nkt = nkeys / 64;
        const bf16_t* Kb_ = Kg + (size_t)bh * T * 96; const bf16_t* Vb_ = Vt + (size_t)bh * 64 * T;
        bf16x8 qf[6];
        { const bf16_t* q = Qg + ((size_t)bh * T + t0 + wid * 32 + cl) * 96 + hh * 8;
#pragma unroll
          for (int s2 = 0; s2 < 6; ++s2) qf[s2] = *(const bf16x8*)(q + s2 * 16); }
        f32x16 o0, o1;
#pragma unroll
        for (int r = 0; r < 16; ++r) { o0[r] = 0.f; o1[r] = 0.f; }
        float mrun = -1e30f, lrun = 0.f;
        auto stage_load = [&](int buf, int kt) {
            bf16_t* ska = (bf16_t*)(smem + buf * STG); bf16_t* skb = (bf16_t*)(smem + buf * STG + KA); bf16_t* sv = (bf16_t*)(smem + buf * STG + KA + KB);
#pragma unroll
            for (int i = 0; i < 2; ++i) { int row = (i * 4 + wid) * 8 + (lane >> 3); glds16(Kb_ + (size_t)(kt * 64 + row) * 96 + swz(row, lane & 7) * 8, ska + (i * 4 + wid) * 512 + lane * 8); }
            { int row = wid * 16 + (lane >> 2); glds16(Kb_ + (size_t)(kt * 64 + row) * 96 + 64 + swz4(row, lane & 3) * 8, skb + wid * 512 + lane * 8); }
#pragma unroll
            for (int i = 0; i < 2; ++i) { int row = (i * 4 + wid) * 8 + (lane >> 3); glds16(Vb_ + (size_t)row * T + kt * 64 + swz(row, lane & 7) * 8, sv + (i * 4 + wid) * 512 + lane * 8); }
        };
        __syncthreads();
        stage_load(0, 0);
        glds_wait();
        __syncthreads();
        for (int kt = 0; kt < nkt; ++kt) {
            if (MODE != 2 && kt + 1 < nkt) stage_load((kt + 1) & 1, kt + 1);
            const bf16_t* ska = (const bf16_t*)(smem + (kt & 1) * STG); const bf16_t* skb = (const bf16_t*)(smem + (kt & 1) * STG + KA); const bf16_t* sv = (const bf16_t*)(smem + (kt & 1) * STG + KA + KB);
            f32x16 s0, s1;
#pragma unroll
            for (int r = 0; r < 16; ++r) { s0[r] = 0.f; s1[r] = 0.f; }
#pragma unroll
            for (int s2 = 0; s2 < 4; ++s2) {
                int c = s2 * 2 + hh;
                bf16x8 k0 = *(const bf16x8*)(ska + cl * 64 + swz(cl, c) * 8), k1 = *(const bf16x8*)(ska + (32 + cl) * 64 + swz(32 + cl, c) * 8);
                s0 = mfma32(k0, qf[s2], s0); s1 = mfma32(k1, qf[s2], s1);
            }
#pragma unroll
            for (int s2 = 4; s2 < 6; ++s2) {
                int c = (s2 - 4) * 2 + hh;
                bf16x8 k0 = *(const bf16x8*)(skb + cl * 32 + swz4(cl, c) * 8), k1 = *(const bf16x8*)(skb + (32 + cl) * 32 + swz4(32 + cl, c) * 8);
                s0 = mfma32(k0, qf[s2], s0); s1 = mfma32(k1, qf[s2], s1);
            }
            float mx = -1e30f;
            if (MODE != 1)
#pragma unroll
            for (int r = 0; r < 16; ++r) mx = fmaxf(mx, fmaxf(s0[r], s1[r]));
            mx = fmaxf(mx, shfl_xor_f(mx, 32));
            if (!wave_all(mx <= mrun + 8.f)) {
                float mnew = fmaxf(mrun, mx), alpha = fast_exp2(mrun - mnew); mrun = mnew; lrun *= alpha;
#pragma unroll
                for (int r = 0; r < 16; ++r) { o0[r] *= alpha; o1[r] *= alpha; }
            }
            float ls = 0.f;
            if (MODE != 1)
#pragma unroll
            for (int r = 0; r < 16; ++r) { s0[r] = fast_exp2(s0[r] - mrun); s1[r] = fast_exp2(s1[r] - mrun); ls += s0[r] + s1[r]; }
            lrun += ls;
#pragma unroll
            for (int s2 = 0; s2 < 4; ++s2) {
                const f32x16& sx = (s2 < 2) ? s0 : s1; int rbase = (s2 & 1) * 8;
                bf16x8 pb;
#pragma unroll
                for (int j = 0; j < 8; ++j) pb[j] = (short)f2bf(sx[rbase + j]);
#pragma unroll
                for (int i = 0; i < 2; ++i) {
                    int row = i * 32 + cl;
                    bf16x4 lo = *(const bf16x4*)(sv + row * 64 + swz(row, 2 * s2) * 8 + 4 * hh), hi = *(const bf16x4*)(sv + row * 64 + swz(row, 2 * s2 + 1) * 8 + 4 * hh);
                    bf16x8 va = {lo[0], lo[1], lo[2], lo[3], hi[0], hi[1], hi[2], hi[3]};
                    if (i == 0) o0 = mfma32(va, pb, o0); else o1 = mfma32(va, pb, o1);
                }
            }
            glds_wait();
            __syncthreads();
        }
        lrun += shfl_xor_f(lrun, 32);
        float inv = 1.f / lrun;
        int b = bh >> 3, hd = bh & 7; size_t row = (size_t)b * T + t0 + wid * 32 + cl;
#pragma unroll
        for (int i = 0; i < 2; ++i)
#pragma unroll
            for (int g = 0; g < 4; ++g) {
                const f32x16& ox = i ? o1 : o0; int dv = i * 32 + 8 * g + 4 * hh;
                *(u32x2*)(yb + row * 1024 + 512 + hd * 64 + dv) = (u32x2){pack2(ox[4 * g] * inv, ox[4 * g + 1] * inv), pack2(ox[4 * g + 2] * inv, ox[4 * g + 3] * inv)};
            }
    }
    (void)NQT;
}

DEV void phase_merge(const Params& p, int layer, int bid, int nb) {
    const int tid = get_tid(), lane = tid & 63, wid = tid >> 6, hl = lane & 31;
    const bool need_ctx = layer == 0;
    const bf16_t* so = (const bf16_t*)(p.ws + OFF_H); const bf16_t* projb = (const bf16_t*)(p.ws + OFF_PB);
    bf16_t* y = (bf16_t*)(p.ws + OFF_PF);
    for (int r2 = bid * 4 + wid; r2 < R / 2; r2 += nb * 4) {
        const int r = r2 * 2 + (lane >> 5);
        if (!need_ctx && (r % T) < CTXL) continue;
        const bool isml = hl < 16; const int cc = (hl * 16) & 255;
        const bf16_t* a0 = so + ((size_t)(isml ? 0 : 2) * R + r) * 256 + cc; const bf16_t* a1 = so + ((size_t)(isml ? 1 : 3) * R + r) * 256 + cc;
        u32x4 x0 = *(const u32x4*)a0, x1 = *(const u32x4*)(a0 + 8), y0 = *(const u32x4*)a1, y1 = *(const u32x4*)(a1 + 8);
        float v[16]; float ss = 0.f;
#pragma unroll
        for (int i = 0; i < 16; ++i) {
            unsigned wa = (i < 8 ? x0 : x1)[(i & 7) >> 1], wb = (i < 8 ? y0 : y1)[(i & 7) >> 1];
            v[i] = bf2f((bf16_t)((i & 1) ? wa >> 16 : wa & 0xffff)) + bf2f((bf16_t)((i & 1) ? wb >> 16 : wb & 0xffff)); ss += v[i] * v[i];
        }
        ss += shfl_xor_f(ss, 1); ss += shfl_xor_f(ss, 2);
        const bf16_t* gt = projb + (size_t)r * PBW + (isml ? PB_MLOG : PB_HGOG) + cc;
        const float* g = (isml ? p.ml_norm_g : p.hg_norm_g) + layer * 256 + cc;
        float rn = rsqrtf(ss * (1.f / 64.f) + EPS);
        u32x4 g0 = *(const u32x4*)gt, g1 = *(const u32x4*)(gt + 8);
        unsigned outw[8];
#pragma unroll
        for (int i = 0; i < 16; i += 2) {
            unsigned gw = (i < 8 ? g0 : g1)[(i & 7) >> 1];
            float ga = bf2f((bf16_t)(gw & 0xffff)), gb = bf2f((bf16_t)(gw >> 16));
            float a = v[i] * rn * g[i] * (isml ? sigmoidf_(ga) : siluf_(ga)), bb = v[i + 1] * rn * g[i + 1] * (isml ? sigmoidf_(gb) : siluf_(gb));
            outw[i >> 1] = pack2(a, bb);
        }
        u32x4* d = (u32x4*)(y + (size_t)r * D + hl * 16);
        d[0] = (u32x4){outw[0], outw[1], outw[2], outw[3]}; d[1] = (u32x4){outw[4], outw[5], outw[6], outw[7]};
    }
}

DEV void phase_outproj(const Params& p, int layer, int bid, int nb, char* smem) {
    const bool need_ctx = layer == 0;
    const bf16_t* y = (const bf16_t*)(p.ws + OFF_PF); const bf16_t* W = (const bf16_t*)(p.ws + OFF_WOUT);
    const float* mods = (const float*)(p.ws + OFF_MODS) + (size_t)layer * (BATCH + 1) * 6144;
    const int tid_ = get_tid();
    constexpr int NTN = 8; const int tpb = need_ctx ? T / 128 : SEQ / 128;
    auto row0 = [&](int tm) { int b = tm / tpb, j = tm % tpb; return b * T + (need_ctx ? 0 : CTXL) + j * 128; };
    int tf, te, tstr; xcd_range(bid, nb, BATCH * tpb * NTN, tf, te, tstr);
    gemm_tiles(tf, te, tstr, 1024, smem, (const bf16_t*)(p.ws + OFF_ZERO),
        [&](int t, int which, int row) { int tm, tn; tile_decode(t, BATCH * tpb, NTN, tm, tn); return which ? W + (size_t)(tn * 128 + row) * 1024 : y + (size_t)(row0(tm) + row) * D; },
        [&](int t, f32x16 (&acc)[2][2]) {
            int tm_, tn_; tile_decode(t, BATCH * tpb, NTN, tm_, tn_);
            const int r0 = row0(tm_), n0 = tn_ * 128; const int b = r0 / T, t0 = r0 % T; const bool islat = t0 >= CTXL;
            const float* g1 = mods + (size_t)(islat ? b : BATCH) * 6144 + 2 * 1024 + n0;
            epi_f32_halves(acc, smem, tid_, [&](int row, int c, f32x4 a) {
                int tt = t0 + row; f32x4 g = *(const f32x4*)(g1 + c * 4);
                if (islat) { bf16_t* w = lat_work_row(p, b, tt - CTXL) + n0 + c * 4; f32x4 xv = layer == 0 ? *(const f32x4*)(p.x + ((size_t)b * SEQ + (tt - CTXL)) * D + n0 + c * 4) : ld_bf4(w); st_bf4(w, xv + g * a); }
                else { size_t o = ((size_t)b * CTXL + tt) * D + n0 + c * 4; float* cx = (float*)(p.ws + OFF_CX); *(f32x4*)(cx + o) = *(const f32x4*)(p.ctx + o) + g * a; }
            });
        });
}

DEV void phase_router(const Params& p, int layer, int bid, int nb, char* smem) {
    const bool need_ctx = layer == 0;
    const bf16_t* h2 = (const bf16_t*)(p.ws + OFF_H); const bf16_t* WR = (const bf16_t*)(p.ws + OFF_WR);
    float* aff = (float*)(p.ws + OFF_AFF);
    const int tid_ = get_tid(); const int lane = tid_ & 63, wid = tid_ >> 6;
    constexpr int NTM = R / 128;
    for (int it = bid; it < NTM; it += nb) {
        int r0 = it * 128; if (!need_ctx && (r0 % T) < CTXL) continue;
        f32x16 acc[1][1];
        gemm_mainloop<4, 1, 1, 1>(acc, [&](int i) { return h2 + (size_t)(r0 + i) * D; }, [&](int j) { return WR + (size_t)j * 1024; }, 1024, smem, (const bf16_t*)(p.ws + OFF_ZERO));
        const int cl = lane & 31;
#pragma unroll
        for (int r = 0; r < 16; ++r) {
            float v = cl < 16 ? acc[0][0][r] : -1e30f; float mx = v;
#pragma unroll
            for (int m = 1; m < 16; m <<= 1) mx = fmaxf(mx, shfl_xor_f(mx, m));
            float e = cl < 16 ? __expf(v - mx) : 0.f; float s = e;
#pragma unroll
            for (int m = 1; m < 16; m <<= 1) s += shfl_xor_f(s, m);
            if (cl < 16) aff[(size_t)(r0 + wid * 32 + crow(r, lane)) * 16 + cl] = e / s;
        }
    }
}

#ifdef EMU
DEV unsigned shfl_up_u(unsigned v, int d) { int l = emu::cur->lane; return emu::shfl_u32(v, l >= d ? l - d : l); }
DEV unsigned shfl_idx_u(unsigned v, int src) { return emu::shfl_u32(v, src); }
#else
DEV unsigned shfl_up_u(unsigned v, int d) { return __shfl_up(v, d); }
DEV unsigned shfl_idx_u(unsigned v, int src) { return __shfl(v, src); }
#endif
DEV void phase_topk(const Params& p, int layer, int bid, int nb, char* smem) {
    const bool need_ctx = layer == 0; const int tid = get_tid(); const int lane = tid & 63, wid = tid >> 6;
    const float* aff = (const float*)(p.ws + OFF_AFF);
    int* selr = (int*)(p.ws + OFF_SELR); float* selg = (float*)(p.ws + OFF_SELG); int* inv = (int*)(p.ws + OFF_INV); float* invg = (float*)(p.ws + OFF_INVG);
    unsigned* keys = (unsigned*)smem;
    unsigned* hist = keys + 2048;
    unsigned* sh = hist + 256;
    const int capT = need_ctx ? CAP_L + CAP_C : CAP_L;
    const int nitems = BATCH * NEXP * 2;
    for (int it = bid; it < nitems; it += nb) {
        int seg = it & 1, e = (it >> 1) % NEXP, b = (it >> 1) / NEXP;
        if (seg == 1 && !need_ctx) continue;
        const int n = seg ? CTXL : SEQ, cap = seg ? CAP_C : CAP_L; const int rbase = b * T + (seg ? 0 : CTXL);
        __syncthreads();
        {
            static_assert(SEQ <= 8 * NTHR && CTXL <= 8 * NTHR, "key batch");
            float kv[8];
#pragma unroll
            for (int q = 0; q < 8; ++q) { int i = tid + q * NTHR; kv[q] = i < n ? aff[(size_t)(rbase + i) * 16 + e] : 0.f; }
#pragma unroll
            for (int q = 0; q < 8; ++q) { int i = tid + q * NTHR; if (i < n) keys[i] = __builtin_bit_cast(unsigned, kv[q]); }
        }
        if (tid == 0) { sh[0] = 0u; sh[1] = (unsigned)cap; }
        for (int pass = 0; pass < 4; ++pass) {
            const int shift = 24 - 8 * pass;
            hist[tid] = 0u;
            __syncthreads();
            const unsigned prefix = sh[0], kneed = sh[1];
            const unsigned hmask = pass == 0 ? 0u : (0xffffffffu << (shift + 8));
            for (int i = tid; i < n; i += NTHR) { unsigned k = keys[i]; if ((k & hmask) == prefix) atomicAdd(&hist[(k >> shift) & 255u], 1u); }
            __syncthreads();
            if (wid == 0) {
                unsigned h0 = hist[4 * lane], h1 = hist[4 * lane + 1], h2 = hist[4 * lane + 2], h3 = hist[4 * lane + 3];
                unsigned tot = h0 + h1 + h2 + h3;
                unsigned incl = tot;
#pragma unroll
                for (int d = 1; d < 64; d <<= 1) { unsigned o = shfl_idx_u(incl, lane + d < 64 ? lane + d : lane); if (lane + d < 64) incl += o; }
                unsigned above = incl - tot;
                unsigned c3 = above, c2 = c3 + h3, c1 = c2 + h2, c0 = c1 + h1;
                if (c3 < kneed && kneed <= c3 + h3) { sh[0] = prefix | ((unsigned)(4 * lane + 3) << shift); sh[1] = kneed - c3; }
                else if (c2 < kneed && kneed <= c2 + h2) { sh[0] = prefix | ((unsigned)(4 * lane + 2) << shift); sh[1] = kneed - c2; }
                else if (c1 < kneed && kneed <= c1 + h1) { sh[0] = prefix | ((unsigned)(4 * lane + 1) << shift); sh[1] = kneed - c1; }
                else if (c0 < kneed && kneed <= c0 + h0) { sh[0] = prefix | ((unsigned)(4 * lane) << shift); sh[1] = kneed - c0; }
            }
            __syncthreads();
        }
        const unsigned tau = sh[0], keq = sh[1];
        const int per = (n + NTHR - 1) / NTHR; const int i0 = tid * per;
        unsigned cg = 0, ce = 0;
        for (int q = 0; q < per && i0 + q < n; ++q) { unsigned k = keys[i0 + q]; cg += k > tau ? 1u : 0u; ce += k == tau ? 1u : 0u; }
        unsigned packed = cg | (ce << 16), incl = packed;
#pragma unroll
        for (int d = 1; d < 64; d <<= 1) { unsigned o = shfl_up_u(incl, d); if (lane >= d) incl += o; }
        if (lane == 63) sh[8 + wid] = incl;
        __syncthreads();
        unsigned base = 0;
        for (int w = 0; w < wid; ++w) base += sh[8 + w];
        unsigned excl = base + incl - packed; unsigned gb = excl & 0xffffu, eb = excl >> 16;
        for (int q = 0; q < per && i0 + q < n; ++q) {
            unsigned k = keys[i0 + q]; bool g = k > tau, eq = k == tau; int mslot = -1;
            if (g || (eq && eb < keq)) {
                mslot = b * capT + (seg ? CAP_L : 0) + (int)(gb + (eb < keq ? eb : keq));
                selr[e * ME_MAX + mslot] = rbase + i0 + q; selg[e * ME_MAX + mslot] = __builtin_bit_cast(float, k);
            }
            inv[(size_t)e * R + rbase + i0 + q] = mslot; invg[(size_t)e * R + rbase + i0 + q] = __builtin_bit_cast(float, k);
            gb += g ? 1u : 0u; eb += eq ? 1u : 0u;
        }
    }
}

DEV void phase_gateup(const Params& p, int layer, int bid, int nb, char* smem) {
    const bool need_ctx = layer == 0; const int Me = BATCH * (need_ctx ? CAP_L + CAP_C : CAP_L);
    const bf16_t* h2 = (const bf16_t*)(p.ws + OFF_H); const bf16_t* WGU = (const bf16_t*)(p.ws + OFF_WGU);
    const int* selr = (const int*)(p.ws + OFF_SELR);
    bf16_t* hid = (bf16_t*)(p.ws + OFF_PB);
    const int tid_ = get_tid(); const int lane = tid_ & 63, wid = tid_ >> 6, wm = wid >> 1, wn = wid & 1;
    const int ntm = (Me + 255) / 256; constexpr int NTN = 16;
    int tf, te, tstr; xcd_range(bid, nb, NEXP * ntm * NTN, tf, te, tstr);
    gemm_tiles256(tf, te, tstr, 1024, smem, (const bf16_t*)(p.ws + OFF_ZERO),
        [&](int t, int which, int row) -> const bf16_t* {
            int e = t / (NTN * ntm), tm_, tn_; tile_decode(t % (NTN * ntm), ntm, NTN, tm_, tn_);
            if (which) return WGU + ((size_t)e * 2048 + tn_ * 128 + row) * 1024;
            int m = tm_ * 256 + row; return m < Me ? h2 + (size_t)selr[e * ME_MAX + m] * D : (const bf16_t*)nullptr; },
        [&](int t, f32x16 (&acc)[4][2], char* stg) {
            int e = t / (NTN * ntm), tm_, tn_; tile_decode(t % (NTN * ntm), ntm, NTN, tm_, tn_); int m0 = tm_ * 256, n0 = tn_ * 128;
            bf16_t* st = (bf16_t*)stg;
#pragma unroll
            for (int q = 0; q < 2; ++q) {
                if (wm == q) {
#pragma unroll
                    for (int i = 0; i < 4; ++i)
#pragma unroll
                        for (int rq = 0; rq < 4; ++rq) {
#pragma unroll
                            for (int r = rq * 4; r < rq * 4 + 4; ++r) { int row = i * 32 + crow(r, lane); { float gx = acc[i][0][r]; st[row * 72 + wn * 32 + (lane & 31)] = f2bf(gx * fast_rcp(1.f + __expf(-gx)) * acc[i][1][r]); } }
                            SCHED_FENCE();
                        }
                }
                lds_barrier();
#pragma unroll
                for (int k = 0; k < 4; ++k) {
                    int id = tid_ + NTHR * k; int row = id >> 3, c = id & 7; int m = m0 + q * 128 + row;
                    if (m < Me) st_nt((u32x4*)(hid + ((size_t)e * Me + m) * 1024 + n0 / 2 + c * 8), *(const u32x4*)(st + row * 72 + c * 8));
                }
                lds_barrier();
            }
        });
}
template <int MODE>
DEV void phase_gateup_probe(const Params& p, int layer, int bid, int nb, char* smem) {
    const bool need_ctx = layer == 0; const int Me = BATCH * (need_ctx ? CAP_L + CAP_C : CAP_L);
    const bf16_t* h2 = (const bf16_t*)(p.ws + OFF_H); const bf16_t* WGU = (const bf16_t*)(p.ws + OFF_WGU);
    const int* selr = (const int*)(p.ws + OFF_SELR);
    const int ntm = (Me + 255) / 256; constexpr int NTN = 16;
    int tf, te, tstr; xcd_range(bid, nb, NEXP * ntm * NTN, tf, te, tstr);
    gemm_tiles256<MODE>(tf, te, tstr, 1024, smem, (const bf16_t*)(p.ws + OFF_ZERO),
        [&](int t, int which, int row) -> const bf16_t* {
            int e = t / (NTN * ntm), tm_, tn_; tile_decode(t % (NTN * ntm), ntm, NTN, tm_, tn_);
            if (which) return WGU + ((size_t)e * 2048 + tn_ * 128 + row) * 1024;
            int m = tm_ * 256 + row; return m < Me ? h2 + (size_t)selr[e * ME_MAX + m] * D : (const bf16_t*)nullptr; },
        [&](int, f32x16 (&acc)[4][2], char*) {
#ifndef EMU
#pragma unroll
            for (int i = 0; i < 4; ++i) asm volatile("" :: "v"(acc[i][0]), "v"(acc[i][1]));
#endif
        });
}
DEV void phase_down(const Params& p, int layer, int bid, int nb, char* smem) {
    const bool need_ctx = layer == 0; const int Me = BATCH * (need_ctx ? CAP_L + CAP_C : CAP_L);
    const bf16_t* hid = (const bf16_t*)(p.ws + OFF_PB); const bf16_t* WD = (const bf16_t*)(p.ws + OFF_WD);
    bf16_t* dres = (bf16_t*)(p.ws + OFF_QKV);
    const int tid_ = get_tid();
    const int ntm = (Me + 255) / 256; constexpr int NTN = 8;
    int tf, te, tstr; xcd_range(bid, nb, NEXP * ntm * NTN, tf, te, tstr);
    gemm_tiles256(tf, te, tstr, 1024, smem, (const bf16_t*)(p.ws + OFF_ZERO),
        [&](int t, int which, int row) -> const bf16_t* {
            int e = t / (NTN * ntm), tm_, tn_; tile_decode(t % (NTN * ntm), ntm, NTN, tm_, tn_);
            if (which) return WD + ((size_t)e * 1024 + tn_ * 128 + row) * 1024;
            int m = tm_ * 256 + row; return m < Me ? hid + ((size_t)e * Me + m) * 1024 : (const bf16_t*)nullptr; },
        [&](int t, f32x16 (&acc)[4][2], char* stg) {
            int e = t / (NTN * ntm), tm_, tn_; tile_decode(t % (NTN * ntm), ntm, NTN, tm_, tn_); int m0 = tm_ * 256, n0 = tn_ * 128;
            epi256_bf16(acc, stg, tid_, [&](float v, int, int) { return v; },
                        [&](int row, int c, u32x4 v) { if (m0 + row < Me) st_nt((u32x4*)(dres + ((size_t)e * Me + m0 + row) * 1024 + n0 + c * 8), v); });
        });
}
#ifdef EMU
DEV unsigned ballot16(bool pred) { unsigned m = 0; for (int e = 0; e < 16; ++e) m |= (emu::shfl_u32(pred ? 1u : 0u, e) & 1u) << e; return m; }
DEV unsigned rdlane_u(unsigned v, int idx) { return emu::shfl_u32(v, idx); }
#else
DEV unsigned ballot16(bool pred) { return (unsigned)(__ballot(pred) & 0xffffull); }
DEV unsigned rdlane_u(unsigned v, int idx) { return (unsigned)__builtin_amdgcn_readlane((int)v, idx); }
#endif
DEV void ffn_sum(const Params& p, int clayer, int r, int lane, f32x4 (&s)[4]) {
    const int Me = BATCH * (clayer == 0 ? CAP_L + CAP_C : CAP_L);
    const bf16_t* dres = (const bf16_t*)(p.ws + OFF_QKV); const int* inv = (const int*)(p.ws + OFF_INV) + r; const float* invg = (const float*)(p.ws + OFF_INVG) + r;
#pragma unroll
    for (int i = 0; i < 4; ++i) s[i] = (f32x4){0.f, 0.f, 0.f, 0.f};
    const int mi = lane < NEXP ? inv[(size_t)lane * R] : -1;
    const float gi = lane < NEXP ? invg[(size_t)lane * R] : 0.f;
    unsigned gu; memcpy(&gu, &gi, 4);
    unsigned mask = ballot16(mi >= 0);
    while (mask) {
        const int e0 = __builtin_ctz(mask); mask &= mask - 1;
        const bool two = mask != 0u; const int e1 = two ? __builtin_ctz(mask) : e0; if (two) mask &= mask - 1;
        const int m0 = (int)rdlane_u((unsigned)mi, e0), m1 = (int)rdlane_u((unsigned)mi, e1);
        unsigned g0u = rdlane_u(gu, e0), g1u = rdlane_u(gu, e1);
        float g0, g1; memcpy(&g0, &g0u, 4); memcpy(&g1, &g1u, 4); if (!two) g1 = 0.f;
        const bf16_t* row0 = dres + ((size_t)e0 * Me + m0) * 1024; const bf16_t* row1 = dres + ((size_t)e1 * Me + m1) * 1024;
        u32x2 w0[4], w1[4];
#pragma unroll
        for (int i = 0; i < 4; ++i) w0[i] = *(const u32x2*)(row0 + i * 256 + lane * 4);
#pragma unroll
        for (int i = 0; i < 4; ++i) w1[i] = *(const u32x2*)(row1 + i * 256 + lane * 4);
#pragma unroll
        for (int i = 0; i < 4; ++i) {
            s[i][0] += g0 * bf2f((bf16_t)(w0[i][0] & 0xffff)); s[i][1] += g0 * bf2f((bf16_t)(w0[i][0] >> 16)); s[i][2] += g0 * bf2f((bf16_t)(w0[i][1] & 0xffff)); s[i][3] += g0 * bf2f((bf16_t)(w0[i][1] >> 16));
            s[i][0] += g1 * bf2f((bf16_t)(w1[i][0] & 0xffff)); s[i][1] += g1 * bf2f((bf16_t)(w1[i][0] >> 16)); s[i][2] += g1 * bf2f((bf16_t)(w1[i][1] & 0xffff)); s[i][3] += g1 * bf2f((bf16_t)(w1[i][1] >> 16));
        }
    }
}
DEV void phase_final(const Params& p, int bid, int nb) {
    const int tid = get_tid(), lane = tid & 63, wid = tid >> 6;
    const float* mods = (const float*)(p.ws + OFF_MODS) + (size_t)1 * (BATCH + 1) * 6144;
    for (int r = bid * 4 + wid; r < R; r += nb * 4) {
        int b = r / T, t = r % T; if (t < CTXL) continue;
        float* xr = p.out + ((size_t)b * SEQ + (t - CTXL)) * D; const float* g2 = mods + (size_t)b * 6144 + 5 * 1024;
        const bf16_t* wr_ = lat_work_row(p, b, t - CTXL);
        f32x4 xv[4];
#pragma unroll
        for (int i = 0; i < 4; ++i) xv[i] = ld_bf4(wr_ + i * 256 + lane * 4);
        f32x4 sacc[4]; ffn_sum(p, 1, r, lane, sacc);
#ifndef EMU
        asm volatile("s_waitcnt vmcnt(0)" ::: "memory");
#else
        (void)emu::shfl_u32(0u, 0);
#endif
#pragma unroll
        for (int i = 0; i < 4; ++i) { int c = i * 256 + lane * 4; *(f32x4*)(xr + c) = xv[i] + *(const f32x4*)(g2 + c) * sacc[i]; }
    }
}

constexpr int SMEM_BYTES = 75 * 1024;
__global__ void __launch_bounds__(NTHR, 2) k_prep(Params p) { SMEM_DECL; phase_prep(p, blockIdx.x, gridDim.x, smem); }
__global__ void __launch_bounds__(NTHR, 2) k_convert(Params p, int layer) { SMEM_DECL; phase_convert(p, layer, blockIdx.x, gridDim.x, smem); }
__global__ void __launch_bounds__(NTHR, 2) k_norm(Params p, int layer, int which, int clayer) { phase_norm(p, layer, which, blockIdx.x, gridDim.x, clayer); }
__global__ void __launch_bounds__(NTHR, 2) k_final(Params p) { phase_final(p, blockIdx.x, gridDim.x); }
__global__ void __launch_bounds__(NTHR, 2) k_proj(Params p, int layer) { SMEM_DECL; phase_proj(p, layer, blockIdx.x, gridDim.x, smem); }
__global__ void __launch_bounds__(NTHR, 2) k_scan(Params p, int layer) { SMEM_DECL; phase_scan(p, layer, blockIdx.x, gridDim.x, smem); }
__global__ void __launch_bounds__(NTHR, 2) k_mla(Params p, int layer) { SMEM_DECL; phase_mla(p, layer, blockIdx.x, gridDim.x, smem); }
__global__ void __launch_bounds__(NTHR, 2) k_attn(Params p, int layer) { SMEM_DECL; phase_attn(p, layer, blockIdx.x, gridDim.x, smem); }
__global__ void __launch_bounds__(NTHR, 2) k_merge(Params p, int layer) { phase_merge(p, layer, blockIdx.x, gridDim.x); }
__global__ void __launch_bounds__(NTHR, 2) k_outproj(Params p, int layer) { SMEM_DECL; phase_outproj(p, layer, blockIdx.x, gridDim.x, smem); }
__global__ void __launch_bounds__(NTHR, 2) k_router(Params p, int layer) { SMEM_DECL; phase_router(p, layer, blockIdx.x, gridDim.x, smem); }
__global__ void __launch_bounds__(NTHR, 2) k_topk(Params p, int layer) { SMEM_DECL; phase_topk(p, layer, blockIdx.x, gridDim.x, smem); }
__global__ void __launch_bounds__(NTHR, 2) k_gateup(Params p, int layer) { SMEM_DECL; phase_gateup(p, layer, blockIdx.x, gridDim.x, smem); }
__global__ void __launch_bounds__(NTHR, 2) k_down(Params p, int layer) { SMEM_DECL; phase_down(p, layer, blockIdx.x, gridDim.x, smem); }

#ifdef EMU
#define GRID_SYNC() emu::grid_sync()
#define GRID_SYNC_CG() emu::grid_sync()
#else
#define GRID_SYNC_CG() cooperative_groups::this_grid().sync()
#define XB_TMO      128
#define XB_XCNT(j)  (256  + 64 * (j))
#define XB_XSUB(j)  (1280 + 64 * (j))
#define XB_XGEN(j)  (2304 + 64 * (j))
#define XB_TOP      3328
#define XB_TOPGEN   3392
#define XCD_BAR_WORDS 3456
#define XB_SPIN_CAP (1u << 22)
DEV unsigned xb_ld(unsigned* p) { return __hip_atomic_load(p, __ATOMIC_RELAXED, __HIP_MEMORY_SCOPE_AGENT); }
DEV unsigned xb_add(unsigned* p, unsigned v) { return __hip_atomic_fetch_add(p, v, __ATOMIC_RELAXED, __HIP_MEMORY_SCOPE_AGENT); }
DEV unsigned xb_xcc_id() { return (unsigned)__builtin_amdgcn_s_getreg((3 << 11) | 20) & 0xFu; }
#define XB_SPIN(cond, bar) do { unsigned _sp = 0; while (cond) { __builtin_amdgcn_s_sleep(1); \
    if ((++_sp & 255u) == 0u) { if (xb_ld(&(bar)[XB_TMO])) break; if (_sp > XB_SPIN_CAP) { atomicAdd(&(bar)[XB_TMO], 1u); break; } } } } while (0)
struct XcdBarrier { unsigned* bar; unsigned x; volatile unsigned* st; };
DEV XcdBarrier xcd_barrier_post(unsigned* bar, volatile unsigned* st) {
    XcdBarrier b; b.bar = bar; b.x = xb_xcc_id(); b.st = st;
    if (threadIdx.x == 0) (void)xb_add(&bar[XB_XCNT(b.x)], 1u);
    return b;
}
DEV void xcd_barrier_complete(unsigned* bar, unsigned x, unsigned& nloc, unsigned& nx) {
    const unsigned G = gridDim.x;
    unsigned sum, cnt, mine, sp = 0u;
    for (;;) {
        sum = 0u; cnt = 0u; mine = 0u;
#pragma unroll
        for (unsigned j = 0; j < 16; ++j) { const unsigned c = xb_ld(&bar[XB_XCNT(j)]); sum += c; cnt += (c > 0u) ? 1u : 0u; mine = (j == x) ? c : mine; }
        if (sum == G) break;
        __builtin_amdgcn_s_sleep(1);
        if ((++sp & 255u) == 0u) { if (xb_ld(&bar[XB_TMO])) break; if (sp > XB_SPIN_CAP) { atomicAdd(&bar[XB_TMO], 1u); break; } }
    }
    nloc = mine > 0u ? mine : 1u; nx = cnt > 0u ? cnt : 1u;
}
DEV void xcd_barrier(const XcdBarrier& b) {
    asm volatile("s_waitcnt vmcnt(0)" ::: "memory");
    __syncthreads();
    if (threadIdx.x == 0) {
        unsigned* bar = b.bar;
        __builtin_amdgcn_s_waitcnt(0);
        unsigned nloc = b.st[0], nx = b.st[1];
        if (nloc == 0u) { xcd_barrier_complete(bar, b.x, nloc, nx); b.st[0] = nloc; b.st[1] = nx; }
        const unsigned old = xb_add(&bar[XB_XSUB(b.x)], 1u);
        const unsigned gen = old / nloc;
        if (old + 1u == (gen + 1u) * nloc) {
            __builtin_amdgcn_fence(__ATOMIC_RELEASE, "agent");
            asm volatile("s_waitcnt vmcnt(0)" ::: "memory");
            const unsigned og = xb_add(&bar[XB_TOP], 1u);
            const unsigned tg = og / nx;
            if (og + 1u == (tg + 1u) * nx) xb_add(&bar[XB_TOPGEN], 1u);
            else XB_SPIN(xb_ld(&bar[XB_TOPGEN]) == tg, bar);
            __builtin_amdgcn_fence(__ATOMIC_ACQUIRE, "agent");
            xb_add(&bar[XB_XGEN(b.x)], 1u);
            asm volatile("s_waitcnt vmcnt(0)" ::: "memory");
        } else {
            XB_SPIN(xb_ld(&bar[XB_XGEN(b.x)]) == gen, bar);
            __builtin_amdgcn_fence(__ATOMIC_ACQUIRE, "agent");
            asm volatile("s_waitcnt vmcnt(0)" ::: "memory");
        }
    }
    __syncthreads();
}
#define GRID_SYNC() xcd_barrier(xb)
#endif
DEV void phase_scan_mla(const Params& p, int layer, int bid, int nb, char* smem) {
    const int nchains = BATCH * 4 * 2 * 2;
    int nscan = nb / 2 < nchains ? nb / 2 : nchains; if (nscan < 1) nscan = 1;
    if (nb - nscan < 1) { phase_scan(p, layer, bid, nb, smem); phase_mla(p, layer, bid, nb, smem); return; }
    if (bid < nscan) phase_scan(p, layer, bid, nscan, smem); else phase_mla(p, layer, bid - nscan, nb - nscan, smem);
}
__global__ void __launch_bounds__(NTHR, 2) k_mega(Params p) {
    SMEM_DECL;
    const int bid = blockIdx.x, nb = gridDim.x;
#ifndef EMU
    volatile unsigned* xb_st = (volatile unsigned*)(smem + SMEM_BYTES - 16);
    if (threadIdx.x == 0) { xb_st[0] = 0u; xb_st[1] = 0u; }
    __syncthreads();
    XcdBarrier xb = xcd_barrier_post((unsigned*)(p.ws + OFF_BAR), xb_st);
#endif
    phase_prep(p, bid, nb, smem);
    if (PROBE == 30) { __syncthreads(); phase_prep(p, bid, nb, smem); __syncthreads(); phase_prep(p, bid, nb, smem); }
#pragma nounroll
    for (int l = 0; l < 2; ++l) {
        if (l == 0) { phase_convert(p, l, bid, nb, smem, 1); GRID_SYNC_CG(); }
        phase_norm(p, l, 0, bid, nb, l - 1);
        GRID_SYNC();
        if (PROBE == 1) { phase_convert(p, l, bid, nb, smem); phase_norm(p, l, 0, bid, nb); GRID_SYNC(); }
        phase_proj(p, l, bid, nb, smem);
        phase_convert(p, l, bid, nb, smem, 2, (unsigned*)(p.ws + OFF_QCTR) + 16 * l);
        GRID_SYNC();
        if (PROBE == 2) { phase_proj(p, l, bid, nb, smem); GRID_SYNC(); }
        {
            const int nchains = BATCH * 4 * 2 * 2;
            if (nb >= 2 * nchains) {
                if (bid < nchains) phase_scan(p, l, bid, nchains, smem); else phase_mla(p, l, bid - nchains, nb - nchains, smem);
                phase_convert(p, l, bid, nb, smem, 2, (unsigned*)(p.ws + OFF_QCTR) + 16 * l);
            } else {
                phase_scan(p, l, bid, nb, smem); phase_convert(p, l, bid, nb, smem, 2, (unsigned*)(p.ws + OFF_QCTR) + 16 * l);
                GRID_SYNC();
                phase_mla(p, l, bid, nb, smem);
            }
        }
        GRID_SYNC();
        if (PROBE == 3) { phase_scan(p, l, bid, nb, smem); GRID_SYNC(); }
        if (PROBE == 17) { const int nchains = BATCH * 4 * 2 * 2; if (bid < nchains) phase_scan(p, l, bid, nchains, smem); else phase_convert(p, l, bid - nchains, nb - nchains, smem, 2); GRID_SYNC(); }
        if (PROBE == 18) { const int nchains = BATCH * 4 * 2 * 2; if (bid >= nchains) phase_convert(p, l, bid - nchains, nb - nchains, smem, 2); GRID_SYNC(); }
        if (PROBE == 14) { phase_scan_probe<0>(p, l, bid, nb, smem); GRID_SYNC(); }
        if (PROBE == 15) { phase_scan_probe<1>(p, l, bid, nb, smem); GRID_SYNC(); }
        if (PROBE == 16) { phase_scan_probe<2>(p, l, bid, nb, smem); GRID_SYNC(); }
        if (PROBE == 8) { phase_mla(p, l, bid, nb, smem); GRID_SYNC(); }
        {
            if (blockIdx.x >= gridDim.x / 2) phase_merge(p, l, bid, nb);
            phase_attn(p, l, bid, nb, smem);
            if (blockIdx.x < gridDim.x / 2) phase_merge(p, l, bid, nb);
        }
        GRID_SYNC();
        if (PROBE == 4) { phase_attn(p, l, bid, nb, smem); GRID_SYNC(); }
        if (PROBE == 19) { phase_attn_probe<0>(p, l, bid, nb, smem); GRID_SYNC(); }
        if (PROBE == 20) { phase_attn_probe<1>(p, l, bid, nb, smem); GRID_SYNC(); }
        if (PROBE == 21) { phase_attn_probe<2>(p, l, bid, nb, smem); GRID_SYNC(); }
        phase_outproj(p, l, bid, nb, smem);
        GRID_SYNC();
        phase_norm(p, l, 1, bid, nb);
        GRID_SYNC();
        phase_router(p, l, bid, nb, smem);
        GRID_SYNC();
        phase_topk(p, l, bid, nb, smem);
        GRID_SYNC();
        if (PROBE == 5) { phase_norm(p, l, 1, bid, nb); GRID_SYNC(); phase_router(p, l, bid, nb, smem); GRID_SYNC(); phase_topk(p, l, bid, nb, smem); GRID_SYNC(); }
        phase_gateup(p, l, bid, nb, smem);
        GRID_SYNC();
        if (PROBE == 6) { phase_gateup(p, l, bid, nb, smem); GRID_SYNC(); }
        if (PROBE == 11) { phase_gateup_probe<1>(p, l, bid, nb, smem); GRID_SYNC(); }
        if (PROBE == 12) { phase_gateup_probe<2>(p, l, bid, nb, smem); GRID_SYNC(); }
        if (PROBE == 13) { phase_gateup_probe<0>(p, l, bid, nb, smem); GRID_SYNC(); }
        if (PROBE == 7) { for (int q = 0; q < 10; ++q) GRID_SYNC(); }
        phase_down(p, l, bid, nb, smem);
        if (l == 0) phase_convert(p, 1, bid, nb, smem, 1, (unsigned*)(p.ws + OFF_QCTR) + 32);
        GRID_SYNC();
        if (PROBE == 10) { phase_down(p, l, bid, nb, smem); GRID_SYNC(); }
    }
    phase_final(p, bid, nb);
}

#ifdef EMU
void emu_dump(const char* name, const void* ptr, size_t bytes);
#define DUMP(name, off, bytes) emu_dump(name, p.ws + (off), bytes)
#else
#define DUMP(name, off, bytes)
#endif

extern "C" void kernel_launch(void* const* d_in, const int* in_sizes, int n_in, void* d_out, int out_size, void* d_ws, size_t ws_size, hipStream_t stream) {
    Params p{};
    const float** f = (const float**)&p;
    for (int i = 0; i < 26; ++i) f[i] = (const float*)d_in[i];
    p.out = (float*)d_out; p.ws = (char*)d_ws;
    if (ws_size < WS_TOTAL) { fprintf(stderr, "workspace too small: %zu < %zu\n", ws_size, (size_t)WS_TOTAL); return; }
#ifdef EMU
    if (getenv("EMU_MEGA")) { memset(p.ws + OFF_BAR, 0, 16384 + 256); emu::launch(dim3(getenv("EMU_NB") ? atoi(getenv("EMU_NB")) : 16), dim3(NTHR), SMEM_BYTES, true, [=]() { k_mega(p); }); return; }
#endif
#if !defined(MULTI_LAUNCH) && !defined(EMU)
    static int grid_blocks = 0;
    if (!grid_blocks) {
        int dev = 0, cus = 0, per_cu = 0;
        (void)hipGetDevice(&dev);
        (void)hipDeviceGetAttribute(&cus, hipDeviceAttributeMultiprocessorCount, dev);
        (void)hipFuncSetAttribute((const void*)k_mega, hipFuncAttributeMaxDynamicSharedMemorySize, SMEM_BYTES);
        (void)hipOccupancyMaxActiveBlocksPerMultiprocessor(&per_cu, k_mega, NTHR, SMEM_BYTES);
        if (per_cu > 2) per_cu = 2;
        if (per_cu < 1) per_cu = 1;
        grid_blocks = cus * per_cu;
    }
    (void)hipMemsetAsync(p.ws + OFF_BAR, 0, 16384 + 256, stream);
    void* args[] = {(void*)&p};
    hipError_t e = hipLaunchCooperativeKernel((const void*)k_mega, dim3(grid_blocks), dim3(NTHR), args, SMEM_BYTES, stream);
    if (e != hipSuccess) fprintf(stderr, "cooperative launch failed: %s (grid %d)\n", hipGetErrorString(e), grid_blocks);
#else
    const int G = 512;
#ifndef EMU
    static bool attr_done = false;
    if (!attr_done) {
        attr_done = true;
        const void* ks[] = {(const void*)k_prep, (const void*)k_convert, (const void*)k_proj, (const void*)k_scan, (const void*)k_mla, (const void*)k_attn,
                            (const void*)k_outproj, (const void*)k_router, (const void*)k_topk, (const void*)k_gateup, (const void*)k_down};
        for (const void* k : ks) (void)hipFuncSetAttribute(k, hipFuncAttributeMaxDynamicSharedMemorySize, SMEM_BYTES);
    }
#endif
    LAUNCH(k_prep, 384, SMEM_BYTES, stream, p);
    for (int l = 0; l < 2; ++l) {
        char nm[64];
        LAUNCH(k_convert, G * 2, SMEM_BYTES, stream, p, l);
        LAUNCH(k_norm, G * 2, 0, stream, p, l, 0, l - 1);
        snprintf(nm, 64, "L%d_h", l); DUMP(nm, OFF_H, (size_t)R * 1024 * 2);
        LAUNCH(k_proj, G * 2, SMEM_BYTES, stream, p, l);
        snprintf(nm, 64, "L%d_projb", l); DUMP(nm, OFF_PB, (size_t)R * PBW * 2);
        snprintf(nm, 64, "L%d_pref", l); DUMP(nm, OFF_PF, (size_t)R * 512 * 4);
        snprintf(nm, 64, "L%d_gates", l); DUMP(nm, OFF_GT, (size_t)R * 16 * 4);
        LAUNCH(k_scan, BATCH * 16, SMEM_BYTES, stream, p, l);
        snprintf(nm, 64, "L%d_scan", l); DUMP(nm, OFF_H, (size_t)4 * R * 256 * 2);
        LAUNCH(k_mla, G * 2, SMEM_BYTES, stream, p, l);
        snprintf(nm, 64, "L%d_qkv", l); DUMP(nm, OFF_QKV, 2 * SZ_Q + SZ_V);
        LAUNCH(k_attn, G * 2, SMEM_BYTES, stream, p, l);
        LAUNCH(k_merge, G * 2, 0, stream, p, l);
        snprintf(nm, 64, "L%d_y", l); DUMP(nm, OFF_PF, (size_t)R * 1024 * 2);
        LAUNCH(k_outproj, G * 2, SMEM_BYTES, stream, p, l);
        LAUNCH(k_norm, G * 2, 0, stream, p, l, 1, -1);
        snprintf(nm, 64, "L%d_h2", l); DUMP(nm, OFF_H, (size_t)R * 1024 * 2);
        LAUNCH(k_router, G, SMEM_BYTES, stream, p, l);
        snprintf(nm, 64, "L%d_aff", l); DUMP(nm, OFF_AFF, (size_t)R * 16 * 4);
        LAUNCH(k_topk, BATCH * NEXP * 2, SMEM_BYTES, stream, p, l);
        LAUNCH(k_gateup, G * 2, SMEM_BYTES, stream, p, l);
        LAUNCH(k_down, G * 2, SMEM_BYTES, stream, p, l);
    }
    LAUNCH(k_final, G * 2, 0, stream, p);
#endif
}
```

```cpp
#ifndef EMU
#include <hip/hip_runtime.h>
#include <hip/hip_cooperative_groups.h>
#endif
#include <cstdio>
#include <cstdint>
#include <cmath>

#ifndef PROBE
#define PROBE 0
#endif
#ifndef BATCH
#define BATCH 16
#endif
#ifndef SEQ
#define SEQ 2048
#endif
#ifndef CTXL
#define CTXL 256
#endif

#define DEV __device__ __forceinline__
typedef unsigned short bf16_t;
typedef short bf16x8 __attribute__((ext_vector_type(8)));
typedef short bf16x4 __attribute__((ext_vector_type(4)));
typedef float f32x16 __attribute__((ext_vector_type(16)));
typedef float f32x4 __attribute__((ext_vector_type(4)));
typedef unsigned int u32x4 __attribute__((ext_vector_type(4)));
typedef unsigned int u32x2 __attribute__((ext_vector_type(2)));

constexpr int D = 1024;
constexpr int T = CTXL + SEQ;
constexpr int R = BATCH * T;
constexpr int NTHR = 256;
constexpr int DIN_P = 2816;
constexpr int PBW = 2208;
constexpr int NEXP = 16;
constexpr int CAP_L = SEQ / 8, CAP_C = CTXL / 8;
constexpr int NC = T / 64;
constexpr float EPS = 1e-6f;
constexpr float QSCL = 0.10206207261596577f * 1.4426950408889634f;
constexpr int PB_MLQK = 0, PB_MLV = 512, PB_MLOG = 768, PB_HGQ = 1024, PB_HGV = 1280, PB_HGOG = 1536, PB_CQ = 1792, PB_CKV = 2048, PB_KR = 2176;

constexpr size_t al256(size_t x) { return (x + 255) & ~(size_t)255; }
constexpr size_t SZ_WIN = (size_t)DIN_P * 1024 * 2, SZ_WUQ = 768 * 256 * 2, SZ_WUKV = 1024 * 128 * 2, SZ_WOUT = 1024 * 1024 * 2;
constexpr size_t SZ_WGU = (size_t)NEXP * 2048 * 1024 * 2, SZ_WD = (size_t)NEXP * 1024 * 1024 * 2, SZ_WR = 32 * 1024 * 2;
constexpr size_t OFF_WIN = 0;
constexpr size_t OFF_WUQ = OFF_WIN + SZ_WIN;
constexpr size_t OFF_WUKV = OFF_WUQ + SZ_WUQ;
constexpr size_t OFF_WOUT = OFF_WUKV + SZ_WUKV;
constexpr size_t OFF_WGU = OFF_WOUT + SZ_WOUT;
constexpr size_t OFF_WD = OFF_WGU + SZ_WGU;
constexpr size_t OFF_WR = OFF_WD + SZ_WD;
constexpr size_t OFF_BPERM = OFF_WR + SZ_WR;
constexpr size_t OFF_PB = al256(OFF_BPERM + DIN_P * 4);
constexpr int ME_MAX = BATCH * (CAP_L + CAP_C);
constexpr size_t SZ_PB = ((size_t)R * PBW * 2 > (size_t)NEXP * ME_MAX * 1024 * 2) ? (size_t)R * PBW * 2 : (size_t)NEXP * ME_MAX * 1024 * 2;
constexpr size_t OFF_PF = al256(OFF_PB + SZ_PB);
constexpr size_t OFF_GT = al256(OFF_PF + (size_t)R * 512 * 4);
constexpr size_t OFF_CX = al256(OFF_GT + (size_t)R * 16 * 4);
constexpr size_t OFF_QKV = al256(OFF_CX + (size_t)BATCH * CTXL * D * 4);
constexpr size_t SZ_Q = (size_t)BATCH * 8 * T * 96 * 2, SZ_V = (size_t)BATCH * 8 * T * 64 * 2;
constexpr size_t SZ_QKV = (2 * SZ_Q + SZ_V > (size_t)R * 1024 * 2) ? 2 * SZ_Q + SZ_V : (size_t)R * 1024 * 2;
constexpr size_t OFF_H = al256(OFF_QKV + SZ_QKV);
constexpr size_t OFF_MODS = al256(OFF_H + (size_t)R * 1024 * 2);
constexpr size_t OFF_LB = al256(OFF_MODS + (size_t)2 * (BATCH + 1) * 6144 * 4);
constexpr size_t OFF_ROPE = al256(OFF_LB + 2 * 512 * 4);
constexpr size_t OFF_AFF = al256(OFF_ROPE + (size_t)SEQ * 32 * 4);
constexpr size_t OFF_SELR = al256(OFF_AFF + (size_t)R * 16 * 4);
constexpr size_t OFF_SELG = al256(OFF_SELR + (size_t)NEXP * ME_MAX * 4);
constexpr size_t OFF_INV = al256(OFF_SELG + (size_t)NEXP * ME_MAX * 4);
constexpr size_t OFF_INVG = al256(OFF_INV + (size_t)R * 16 * 4);
constexpr size_t OFF_BAR = al256(OFF_INVG + (size_t)R * 16 * 4);
constexpr size_t OFF_QCTR = OFF_BAR + 16384;
constexpr size_t OFF_ZERO = OFF_BAR + 32768;
constexpr size_t WS_TOTAL = OFF_BAR + 65536;

struct Params {
    const float *x, *c, *ctx, *c_ctx, *ada_w, *ada_b, *norm1_g, *norm2_g, *w_in, *b_in, *ml_conv_w, *ml_conv_b, *ml_norm_g,
        *hg_lb, *hg_norm_g, *mla_q_norm_g, *mla_w_uq, *mla_kv_norm_g, *mla_w_ukv, *mla_q_qk_g, *mla_k_qk_g, *w_out, *router_w,
        *ex_w_gate, *ex_w_up, *ex_w_down;
    float* out;
    char* ws;
};

#ifdef EMU
DEV float bf2f(bf16_t v) { unsigned u = (unsigned)v << 16; float f; memcpy(&f, &u, 4); return f; }
DEV bf16_t f2bf(float x) { unsigned u; memcpy(&u, &x, 4); if ((u & 0x7fffffffu) > 0x7f800000u) return 0x7fc0; u += 0x7fffu + ((u >> 16) & 1u); return (bf16_t)(u >> 16); }
DEV f32x16 mfma32(bf16x8 a, bf16x8 b, f32x16 c) {
    emu::Wave* w = emu::cur->wave; int p = emu::wave_arrive_begin(); int lane = emu::cur->lane;
    for (int j = 0; j < 8; ++j) { w->fa[p][lane][j] = bf2f((bf16_t)a[j]); w->fb[p][lane][j] = bf2f((bf16_t)b[j]); }
    emu::wave_arrive_wait();
    int col = lane & 31, h = lane >> 5;
    for (int r = 0; r < 16; ++r) {
        int row = (r & 3) + 8 * (r >> 2) + 4 * h; float s = c[r];
        for (int k = 0; k < 16; ++k) s += w->fa[p][row + 32 * (k >> 3)][k & 7] * w->fb[p][col + 32 * (k >> 3)][k & 7];
        c[r] = s;
    }
    return c;
}
DEV float shfl_xor_f(float v, int m) { unsigned u; memcpy(&u, &v, 4); u = emu::shfl_u32(u, emu::cur->lane ^ m); float f; memcpy(&f, &u, 4); return f; }
DEV float shfl_idx_f(float v, int src) { unsigned u; memcpy(&u, &v, 4); u = emu::shfl_u32(u, src); float f; memcpy(&f, &u, 4); return f; }
DEV float shfl_up_f(float v, int d) { unsigned u; memcpy(&u, &v, 4); int l = emu::cur->lane; u = emu::shfl_u32(u, l >= d ? l - d : l); float f; memcpy(&f, &u, 4); return f; }
#define LAUNCH(kern, grid, smem, stream, ...) emu::launch(dim3(grid), dim3(NTHR), smem, false, [=]() { kern(__VA_ARGS__); })
#else
DEV float bf2f(bf16_t v) { return __builtin_bit_cast(float, (unsigned)v << 16); }
DEV bf16_t f2bf(float x) { return __builtin_bit_cast(unsigned short, (__bf16)x); }
DEV f32x16 mfma32(bf16x8 a, bf16x8 b, f32x16 c) { return __builtin_amdgcn_mfma_f32_32x32x16_bf16(a, b, c, 0, 0, 0); }
DEV float shfl_xor_f(float v, int m) { return __shfl_xor(v, m); }
DEV float shfl_up_f(float v, int d) { return __shfl_up(v, d); }
DEV float shfl_idx_f(float v, int src) { return __shfl(v, src); }
#define LAUNCH(kern, grid, smem, stream, ...) hipLaunchKernelGGL(kern, dim3(grid), dim3(NTHR), smem, stream, __VA_ARGS__)
#endif
#ifdef EMU
DEV int get_tid() { return threadIdx.x; }
#else
DEV int get_tid() { int t = threadIdx.x; asm volatile("" : "+v"(t)); return t; }
#endif
#ifdef EMU
DEV bf16x4 ds_tr(const bf16_t* a) {
    emu::Wave* w = emu::cur->wave; int p = emu::wave_arrive_begin(); int lane = emu::cur->lane;
    w->pv[p][lane] = a;
    emu::wave_arrive_wait();
    int g = lane & ~15, i = lane & 15; bf16x4 r;
    for (int q = 0; q < 4; ++q) r[q] = (short)((const bf16_t*)w->pv[p][g + 4 * q + (i >> 2)])[i & 3];
    return r;
}
#else
DEV bf16x4 ds_tr(const bf16_t* a) { return __builtin_amdgcn_ds_read_tr16_b64_v4i16((__attribute__((address_space(3))) bf16x4*)a); }
#endif
#ifdef EMU
DEV void glds16(const bf16_t* g, bf16_t* l) {
    emu::Wave* w = emu::cur->wave; int p = emu::wave_arrive_begin(); int lane = emu::cur->lane;
    w->pv[p][lane] = l;
    emu::wave_arrive_wait();
    if ((const char*)l - (const char*)w->pv[p][0] != lane * 16) { fprintf(stderr, "glds16: LDS destination not wave-linear (lane %d)\n", lane); abort(); }
    memcpy(l, g, 16);
}
DEV void glds_wait() {}
#else
DEV void glds16(const bf16_t* g, bf16_t* l) {
    __builtin_amdgcn_global_load_lds((const __attribute__((address_space(1))) void*)g, (__attribute__((address_space(3))) void*)l, 16, 0, 0);
}
DEV void glds_wait() { asm volatile("s_waitcnt vmcnt(0)" ::: "memory"); }
#endif
#ifdef NO_TR
DEV bf16x8 tr_frag(const bf16_t* X, int ldx, int ks, int c0, int lane) {
    const bf16_t* a = X + (16 * ks + 8 * (lane >> 5)) * ldx + c0 + (lane & 31);
    bf16x8 r;
#pragma unroll
    for (int j = 0; j < 8; ++j) r[j] = (short)a[j * ldx];
    return r;
}
#else
DEV bf16x8 tr_frag(const bf16_t* X, int ldx, int ks, int c0, int lane) {
    const bf16_t* a = X + (16 * ks + 8 * (lane >> 5) + ((lane & 15) >> 2)) * ldx + c0 + 16 * ((lane >> 4) & 1) + 4 * (lane & 3);
    bf16x4 lo = ds_tr(a), hi = ds_tr(a + 4 * ldx);
    return (bf16x8){lo[0], lo[1], lo[2], lo[3], hi[0], hi[1], hi[2], hi[3]};
}
#endif
#ifdef EMU
DEV float fast_exp2(float x) { return exp2f(x); }
DEV bool wave_all(bool pred) { unsigned v = pred ? 1u : 0u; for (int m = 1; m < 64; m <<= 1) v &= emu::shfl_u32(v, emu::cur->lane ^ m); return v != 0; }
#else
DEV float fast_exp2(float x) { return __builtin_amdgcn_exp2f(x); }
DEV bool wave_all(bool pred) { return __all(pred); }
#endif
#ifdef EMU
DEV int launder(int v) { return v; }
#else
DEV int launder(int v) { asm volatile("" : "+v"(v)); return v; }
#endif
#ifdef EMU
#define SCHED_FENCE()
#else
#define SCHED_FENCE() __builtin_amdgcn_sched_barrier(0)
#endif
#ifdef EMU
DEV float wave_scan_add(float v, int lane) { for (int d = 1; d < 64; d <<= 1) { float o = shfl_up_f(v, d); if (lane >= d) v += o; } return v; }
DEV float wave_scan_max(float v, int lane) { for (int d = 1; d < 64; d <<= 1) { float o = shfl_up_f(v, d); if (lane >= d) v = fmaxf(v, o); } return v; }
#else
template <int CTRL, int ROWMASK> DEV float dpp_f(float ident, float v) {
    return __builtin_bit_cast(float, __builtin_amdgcn_update_dpp(__builtin_bit_cast(int, ident), __builtin_bit_cast(int, v), CTRL, ROWMASK, 0xf, false));
}
DEV float wave_scan_add(float v, int) {
    v += dpp_f<0x111, 0xf>(0.f, v); v += dpp_f<0x112, 0xf>(0.f, v); v += dpp_f<0x114, 0xf>(0.f, v); v += dpp_f<0x118, 0xf>(0.f, v);
    v += dpp_f<0x142, 0xa>(0.f, v); v += dpp_f<0x143, 0xc>(0.f, v);
    return v;
}
DEV float wave_scan_max(float v, int) {
    const float NI = -3.0e38f;
    v = fmaxf(v, dpp_f<0x111, 0xf>(NI, v)); v = fmaxf(v, dpp_f<0x112, 0xf>(NI, v)); v = fmaxf(v, dpp_f<0x114, 0xf>(NI, v)); v = fmaxf(v, dpp_f<0x118, 0xf>(NI, v));
    v = fmaxf(v, dpp_f<0x142, 0xa>(NI, v)); v = fmaxf(v, dpp_f<0x143, 0xc>(NI, v));
    return v;
}
#endif
#ifdef EMU
DEV void st_nt(u32x4* p, u32x4 v) { *p = v; }
DEV float ld_nt(const float* p) { return *p; }
#else
DEV void st_nt(u32x4* p, u32x4 v) { __builtin_nontemporal_store(v, p); }
DEV float ld_nt(const float* p) { return __builtin_nontemporal_load(p); }
#endif
DEV unsigned pack2(float lo, float hi) { return (unsigned)f2bf(lo) | ((unsigned)f2bf(hi) << 16); }
#ifdef EMU
DEV float fast_rcp(float x) { return 1.f / x; }
#else
DEV float fast_rcp(float x) { return __builtin_amdgcn_rcpf(x); }
#endif
DEV float sigmoidf_(float x) { return fast_rcp(1.f + __expf(-x)); }
DEV float siluf_(float x) { return x * sigmoidf_(x); }
DEV float logsigmoidf_(float x) { return fminf(x, 0.f) - __logf(1.f + __expf(-fabsf(x))); }
#ifdef EMU
#define SMEM_DECL char* smem = emu::cur->blk->smem
#else
#define SMEM_DECL extern __shared__ __attribute__((aligned(16))) char smem[]
#endif

DEV int crow(int r, int lane) { return (r & 3) + 8 * (r >> 2) + 4 * (lane >> 5); }

template <int WGM, int WGN, int TM, int TN> struct GemmCfg {
    static constexpr int BM = WGM * TM * 32, BN = WGN * TN * 32;
    static constexpr int A_BYTES = BM * 128, B_BYTES = BN * 128, STAGE = A_BYTES + B_BYTES, LDS = 2 * STAGE;
};
DEV int swz(int row, int c) { return c ^ ((row >> 1) & 7); }
DEV int swz4(int row, int c) { return c ^ ((row >> 2) & 3); }
template <int WGM, int WGN, int TM, int TN, class ARow, class BRow>
DEV void gemm_mainloop(f32x16 (&acc)[TM][TN], ARow arow, BRow brow, int K, char* smem, const bf16_t* zrow) {
    typedef GemmCfg<WGM, WGN, TM, TN> C;
    constexpr int NA = C::BM / 32, NB = C::BN / 32;
    const int tid = get_tid(), lane = tid & 63, wid = tid >> 6, wm = wid / WGN, wn = wid % WGN;
    const bf16_t* ap[NA]; const bf16_t* bp[NB];
#pragma unroll
    for (int i = 0; i < NA; ++i) { int row = (i * 4 + wid) * 8 + (lane >> 3); const bf16_t* p = arow(row); ap[i] = p ? p + swz(row, lane & 7) * 8 : nullptr; }
#pragma unroll
    for (int i = 0; i < NB; ++i) { int row = (i * 4 + wid) * 8 + (lane >> 3); const bf16_t* p = brow(row); bp[i] = p ? p + swz(row, lane & 7) * 8 : nullptr; }
    auto stage_load = [&](int buf, int k0) {
        bf16_t* sa = (bf16_t*)(smem + buf * C::STAGE); bf16_t* sb = (bf16_t*)(smem + buf * C::STAGE + C::A_BYTES);
#pragma unroll
        for (int i = 0; i < NA; ++i) glds16(ap[i] ? ap[i] + k0 : zrow, sa + (i * 4 + wid) * 512 + lane * 8);
#pragma unroll
        for (int i = 0; i < NB; ++i) glds16(bp[i] ? bp[i] + k0 : zrow, sb + (i * 4 + wid) * 512 + lane * 8);
    };
#pragma unroll
    for (int i = 0; i < TM; ++i)
#pragma unroll
        for (int j = 0; j < TN; ++j)
#pragma unroll
            for (int r = 0; r < 16; ++r) acc[i][j][r] = 0.f;
    const int KT = K / 64;
    __syncthreads();
    stage_load(0, 0);
    glds_wait();
    __syncthreads();
    for (int kt = 0; kt < KT; ++kt) {
        if (kt + 1 < KT) stage_load((kt + 1) & 1, (kt + 1) * 64);
        const bf16_t* sa = (const bf16_t*)(smem + (kt & 1) * C::STAGE); const bf16_t* sb = (const bf16_t*)((const char*)sa + C::A_BYTES);
#pragma unroll
        for (int ks = 0; ks < 4; ++ks) {
            bf16x8 af[TM], bfr[TN];
            const int c = ks * 2 + (lane >> 5);
#pragma unroll
            for (int i = 0; i < TM; ++i) { int r = (wm * TM + i) * 32 + (lane & 31); af[i] = *(const bf16x8*)(sa + r * 64 + swz(r, c) * 8); }
#pragma unroll
            for (int j = 0; j < TN; ++j) { int r = (wn * TN + j) * 32 + (lane & 31); bfr[j] = *(const bf16x8*)(sb + r * 64 + swz(r, c) * 8); }
#pragma unroll
            for (int i = 0; i < TM; ++i)
#pragma unroll
                for (int j = 0; j < TN; ++j) acc[i][j] = mfma32(af[i], bfr[j], acc[i][j]);
        }
        glds_wait();
        __syncthreads();
    }
}

constexpr int CLD = 136;
template <class F>
DEV void stage_tile_bf16(const f32x16 (&acc)[2][2], char* smem, int lane, int wm, int wn, F f) {
    bf16_t* st = (bf16_t*)smem;
#pragma unroll
    for (int i = 0; i < 2; ++i)
#pragma unroll
        for (int j = 0; j < 2; ++j) {
            int col = (wn * 2 + j) * 32 + (lane & 31);
#pragma unroll
            for (int r = 0; r < 16; ++r) { int row = (wm * 2 + i) * 32 + crow(r, lane); st[row * CLD + col] = f2bf(f(acc[i][j][r], row, col)); }
        }
}
DEV void stage_tile_f32(const f32x16 (&acc)[2][2], char* smem, int lane, int wm, int wn) {
    float* st = (float*)smem;
#pragma unroll
    for (int i = 0; i < 2; ++i)
#pragma unroll
        for (int j = 0; j < 2; ++j) {
            int col = (wn * 2 + j) * 32 + (lane & 31);
#pragma unroll
            for (int r = 0; r < 16; ++r) { int row = (wm * 2 + i) * 32 + crow(r, lane); st[row * 128 + col] = acc[i][j][r]; }
        }
}

DEV void xcd_range(int bid, int nb, int N, int& first, int& end, int& stride) {
    if (nb % 8 != 0) { first = bid; end = N; stride = nb; return; }
    int g = bid & 7, j = bid >> 3; stride = nb >> 3;
    int s0 = (int)(((long long)g * N) / 8); end = (int)(((long long)(g + 1) * N) / 8); first = s0 + j;
}
DEV void tile_decode(int L, int NTM, int NTN, int& tm, int& tn) {
    constexpr int GM = 8; const int full = NTM / GM, rem = NTM % GM; const int nf = full * GM * NTN;
    if (L < nf) { int grp = L / (GM * NTN), r = L % (GM * NTN); tn = r / GM; tm = grp * GM + r % GM; }
    else { int r = L - nf; tn = r / rem; tm = full * GM + r % rem; }
}
constexpr int EPI_OFF = 32768;
template <class Rows, class Epi>
DEV void gemm_tiles(int first, int ntiles, int stride, int K, char* smem, const bf16_t* zrow, Rows rows, Epi epi) {
    typedef GemmCfg<2, 2, 2, 2> C;
    const int tid = get_tid(), lane = tid & 63, wid = tid >> 6, wm = wid >> 1, wn = wid & 1;
    if (first >= ntiles) return;
    const bf16_t* ap[4]; const bf16_t* bp[4];
    auto setptrs = [&](int t) {
#pragma unroll
        for (int i = 0; i < 4; ++i) {
            int row = (i * 4 + wid) * 8 + (lane >> 3);
            const bf16_t* pa = rows(t, 0, row); ap[i] = pa ? pa + swz(row, lane & 7) * 8 : nullptr;
            const bf16_t* pb = rows(t, 1, row); bp[i] = pb ? pb + swz(row, lane & 7) * 8 : nullptr;
        }
    };
    auto stage_load = [&](int buf, int k0) {
        bf16_t* sa = (bf16_t*)(smem + buf * C::STAGE); bf16_t* sb = (bf16_t*)(smem + buf * C::STAGE + C::A_BYTES);
#pragma unroll
        for (int i = 0; i < 4; ++i) glds16(ap[i] ? ap[i] + k0 : zrow, sa + (i * 4 + wid) * 512 + lane * 8);
#pragma unroll
        for (int i = 0; i < 4; ++i) glds16(bp[i] ? bp[i] + k0 : zrow, sb + (i * 4 + wid) * 512 + lane * 8);
    };
    const int KT = K / 64;
    __syncthreads();
    setptrs(first); stage_load(0, 0);
    glds_wait();
    __syncthreads();
    for (int t = first; t < ntiles; t += stride) {
        f32x16 acc[2][2];
#pragma unroll
        for (int i = 0; i < 2; ++i)
#pragma unroll
            for (int j = 0; j < 2; ++j)
#pragma unroll
                for (int r = 0; r < 16; ++r) acc[i][j][r] = 0.f;
        for (int kt = 0; kt < KT; ++kt) {
            if (kt + 1 < KT) stage_load((kt + 1) & 1, (kt + 1) * 64);
            else if (t + stride < ntiles) { setptrs(t + stride); stage_load(0, 0); }
            const bf16_t* sa = (const bf16_t*)(smem + (kt & 1) * C::STAGE); const bf16_t* sb = (const bf16_t*)((const char*)sa + C::A_BYTES);
#pragma unroll
            for (int ks = 0; ks < 4; ++ks) {
                bf16x8 af[2], bfr[2];
                const int c = ks * 2 + (lane >> 5);
#pragma unroll
                for (int i = 0; i < 2; ++i) { int r = (wm * 2 + i) * 32 + (lane & 31); af[i] = *(const bf16x8*)(sa + r * 64 + swz(r, c) * 8); }
#pragma unroll
                for (int j = 0; j < 2; ++j) { int r = (wn * 2 + j) * 32 + (lane & 31); bfr[j] = *(const bf16x8*)(sb + r * 64 + swz(r, c) * 8); }
#pragma unroll
                for (int i = 0; i < 2; ++i)
#pragma unroll
                    for (int j = 0; j < 2; ++j) acc[i][j] = mfma32(af[i], bfr[j], acc[i][j]);
            }
            glds_wait();
            __syncthreads();
        }
        epi(t, acc);
        __syncthreads();
    }
}
constexpr int G2_STAGE = (256 + 128) * 64;
#ifdef EMU
DEV void lds_barrier() { __syncthreads(); }
template <int N> DEV void vm_wait() {}
#else
DEV void lds_barrier() { asm volatile("s_waitcnt lgkmcnt(0)" ::: "memory"); __builtin_amdgcn_s_barrier(); asm volatile("" ::: "memory"); }
template <int N> DEV void vm_wait() { asm volatile("s_waitcnt vmcnt(%0)" :: "n"(N) : "memory"); }
#endif
template <int MODE = 0, class Rows, class Epi>
DEV void gemm_tiles256(int first, int end, int stride, int K, char* smem, const bf16_t* zrow, Rows rows, Epi epi) {
    const int tid = get_tid(), lane = tid & 63, wid = tid >> 6, wm = wid >> 1, wn = wid & 1;
    if (first >= end) return;
    const int nt = (end - first + stride - 1) / stride; const int KT = K / 32; const int G = nt * KT;
    unsigned ap[4], bp[2];
    auto setptrs = [&](int t) {
#pragma unroll
        for (int i = 0; i < 4; ++i) { int row = (i * 4 + wid) * 16 + (lane >> 2); const bf16_t* pa = rows(t, 0, row); ap[i] = pa ? (unsigned)(pa + swz4(row, lane & 3) * 8 - zrow) : 0u; }
#pragma unroll
        for (int i = 0; i < 2; ++i) { int row = (i * 4 + wid) * 16 + (lane >> 2); const bf16_t* pb = rows(t, 1, row); bp[i] = pb ? (unsigned)(pb + swz4(row, lane & 3) * 8 - zrow) : 0u; }
    };
    int lg = 0, lkt = 0, lli = 0, lst = 0;
    auto issue = [&]() {
        if (lkt == 0) setptrs(first + lli * stride);
        bf16_t* sa = (bf16_t*)(smem + lst * G2_STAGE); bf16_t* sb = (bf16_t*)(smem + lst * G2_STAGE + 256 * 64);
        if (MODE != 2) {
#pragma unroll
        for (int i = 0; i < 4; ++i) glds16(ap[i] ? zrow + (int)(ap[i] + lkt * 32) : zrow, sa + (i * 4 + wid) * 512 + lane * 8);
#pragma unroll
        for (int i = 0; i < 2; ++i) glds16(bp[i] ? zrow + (int)(bp[i] + lkt * 32) : zrow, sb + (i * 4 + wid) * 512 + lane * 8);
        }
        ++lg; if (++lkt == KT) { lkt = 0; ++lli; } if (++lst == 3) lst = 0;
    };
    __syncthreads();
    issue(); if (G > 1) issue();
    int g = 0, cst = 0;
    for (int li = 0; li < nt; ++li) {
        f32x16 acc[4][2];
#pragma unroll
        for (int i = 0; i < 4; ++i)
#pragma unroll
            for (int j = 0; j < 2; ++j)
#pragma unroll
                for (int r = 0; r < 16; ++r) acc[i][j][r] = 0.f;
        for (int kt = 0; kt < KT; ++kt, ++g) {
            if (g + 1 < G) vm_wait<6>(); else vm_wait<0>();
            lds_barrier();
            if (lg < G) issue();
            const bf16_t* sa = (const bf16_t*)(smem + cst * G2_STAGE); const bf16_t* sb = sa + 256 * 32;
            if (MODE != 1)
#pragma unroll
            for (int ks = 0; ks < 2; ++ks) {
                bf16x8 bfr[2];
                const int c = ks * 2 + (lane >> 5);
#pragma unroll
                for (int j = 0; j < 2; ++j) { int r = wn * 64 + j * 32 + (lane & 31); bfr[j] = *(const bf16x8*)(sb + r * 32 + swz4(r, c) * 8); }
#pragma unroll
                for (int ip = 0; ip < 2; ++ip) {
                    bf16x8 af[2];
#pragma unroll
                    for (int i = 0; i < 2; ++i) { int r = wm * 128 + (ip * 2 + i) * 32 + (lane & 31); af[i] = *(const bf16x8*)(sa + r * 32 + swz4(r, c) * 8); }
#pragma unroll
                    for (int i = 0; i < 2; ++i)
#pragma unroll
                        for (int j = 0; j < 2; ++j) acc[ip * 2 + i][j] = mfma32(af[i], bfr[j], acc[ip * 2 + i][j]);
                }
            }
            if (kt + 1 < KT) { if (++cst == 3) cst = 0; }
        }
        lds_barrier();
        epi(first + li * stride, acc, smem + cst * G2_STAGE);
        vm_wait<0>();
        if (++cst == 3) cst = 0;
    }
    __syncthreads();
}
template <class F, class S>
DEV void epi256_bf16(const f32x16 (&acc)[4][2], char* stg, int tid, F f, S store) {
    const int lane = tid & 63, wid = tid >> 6, wm = wid >> 1, wn = wid & 1;
    bf16_t* st = (bf16_t*)stg;
#pragma unroll
    for (int q = 0; q < 4; ++q) {
        if (wm == (q >> 1)) {
#pragma unroll
            for (int ii = 0; ii < 2; ++ii)
#pragma unroll
                for (int j = 0; j < 2; ++j) {
                    int col = wn * 64 + j * 32 + (lane & 31);
#pragma unroll
                    for (int r = 0; r < 16; ++r) { int row = ii * 32 + crow(r, lane); st[row * CLD + col] = f2bf(f(acc[(q & 1) * 2 + ii][j][r], q * 64 + row, col)); }
                }
        }
        lds_barrier();
        { const int t2 = launder(tid);
#pragma unroll
        for (int k = 0; k < 4; ++k) { int id = t2 + NTHR * k; int row = id >> 4, c = id & 15; store(q * 64 + row, c, *(const u32x4*)(st + row * CLD + c * 8)); } }
        lds_barrier();
    }
}
template <class S>
DEV void epi256_f32(const f32x16 (&acc)[4][2], char* stg, int tid, S store) {
    const int lane = tid & 63, wid = tid >> 6, wm = wid >> 1, wn = wid & 1;
    float* st = (float*)stg;
#pragma unroll
    for (int q = 0; q < 8; ++q) {
        if (wm == (q >> 2)) {
#pragma unroll
            for (int j = 0; j < 2; ++j) {
                int col = wn * 64 + j * 32 + (lane & 31);
#pragma unroll
                for (int r = 0; r < 16; ++r) st[crow(r, lane) * 128 + col] = acc[q & 3][j][r];
            }
        }
        lds_barrier();
        { const int t2 = launder(tid);
#pragma unroll
        for (int k = 0; k < 4; ++k) { int id = t2 + NTHR * k; int row = id >> 5, c = id & 31; store(q * 32 + row, c, *(const f32x4*)(st + row * 128 + c * 4)); } }
        lds_barrier();
    }
}

template <class St>
DEV void epi_f32_halves(const f32x16 (&acc)[2][2], char* smem, int tid, St store) {
    const int lane = tid & 63, wid = tid >> 6, wm = wid >> 1, wn = wid & 1;
    float* st = (float*)(smem + EPI_OFF);
#pragma unroll
    for (int half = 0; half < 2; ++half) {
        if (wm == half) {
#pragma unroll
            for (int i = 0; i < 2; ++i)
#pragma unroll
                for (int j = 0; j < 2; ++j) {
                    int col = (wn * 2 + j) * 32 + (lane & 31);
#pragma unroll
                    for (int r = 0; r < 16; ++r) st[(i * 32 + crow(r, lane)) * 128 + col] = acc[i][j][r];
                }
        }
        __syncthreads();
#pragma unroll
        for (int q = 0; q < 8; ++q) { int id = tid + NTHR * q; int row = id >> 5, c = id & 31; store(half * 64 + row, c, *(const f32x4*)(st + row * 128 + c * 4)); }
        __syncthreads();
    }
}

DEV void phase_prep(const Params& p, int bid, int nb, char* smem) {
    const int tid = get_tid();
    float* mods = (float*)(p.ws + OFF_MODS);
    float* sc = (float*)smem;
    for (int i0 = tid; i0 < (BATCH + 1) * 1024; i0 += NTHR * 4) {
        float cv[4];
#pragma unroll
        for (int q = 0; q < 4; ++q) { int i = i0 + q * NTHR; int m = i >> 10, k = i & 1023; cv[q] = i < (BATCH + 1) * 1024 ? (m < BATCH ? p.c[m * 1024 + k] : p.c_ctx[k]) : 0.f; }
#pragma unroll
        for (int q = 0; q < 4; ++q) { int i = i0 + q * NTHR; if (i < (BATCH + 1) * 1024) sc[i] = siluf_(cv[q]); }
    }
    __syncthreads();
    float* red = sc + (BATCH + 1) * 1024;
    const int nitems = 2 * 192;
    for (int it = bid; it < nitems; it += nb) {
        int l = it / 192, n = (it % 192) * 32 + (tid & 31), kg = tid >> 5;
        float a[BATCH + 1];
#pragma unroll
        for (int m = 0; m <= BATCH; ++m) a[m] = 0.f;
        const float* w = p.ada_w + (size_t)l * 1024 * 6144 + n;
        for (int k = kg * 128; k < kg * 128 + 128; k += 16) {
            float wv[16];
#pragma unroll
            for (int j = 0; j < 16; ++j) wv[j] = w[(size_t)(k + j) * 6144];
#pragma unroll
            for (int j = 0; j < 16; ++j)
#pragma unroll
                for (int m = 0; m <= BATCH; ++m) a[m] += sc[m * 1024 + k + j] * wv[j];
        }
        for (int q = 0; q < 8; ++q) {
            if (kg == q) {
#pragma unroll
                for (int m = 0; m <= BATCH; ++m) red[m * 32 + (tid & 31)] = (q ? red[m * 32 + (tid & 31)] : 0.f) + a[m];
            }
            __syncthreads();
        }
        for (int i = tid; i < (BATCH + 1) * 32; i += NTHR) {
            int m = i >> 5, nn = i & 31; int col = (it % 192) * 32 + nn;
            mods[((size_t)l * (BATCH + 1) + m) * 6144 + col] = red[i] + p.ada_b[l * 6144 + col];
        }
        __syncthreads();
    }
    if (bid == 0 && tid < 64) ((unsigned*)(p.ws + OFF_ZERO))[tid] = 0u;
    float* lb = (float*)(p.ws + OFF_LB);
    for (int i = bid * NTHR + tid; i < 512; i += nb * NTHR) {
        float l0 = p.hg_lb[i], l1 = p.hg_lb[512 + i]; float mx = fmaxf(l0, l1); float e0 = expf(l0 - mx), e1 = expf(l1 - mx);
        lb[i] = 0.f; lb[512 + i] = e1 / (e0 + e1);
    }
    float* rope = (float*)(p.ws + OFF_ROPE);
    for (int i = bid * NTHR + tid; i < SEQ * 16; i += nb * NTHR) {
        int n = i >> 4, j = i & 7, isc = (i >> 3) & 1;
        float pos = isc ? (float)(n & 63) : (float)(n >> 6);
        float inv = powf(10000.f, -(float)(2 * j) / 16.f); float ang = pos * inv;
        rope[n * 32 + isc * 16 + j] = cosf(ang); rope[n * 32 + isc * 16 + 8 + j] = sinf(ang);
    }
}

DEV int win_src_col(int n) { return n < 1024 ? n : (n < 2720 ? n + 16 : (n < 2736 ? n - 2720 + 1024 : -1)); }
DEV void phase_convert(const Params& p, int layer, int bid, int nb, char* smem, int part = 0, unsigned* queue = nullptr) {
    float* tile = (float*)smem;
    const int tid = get_tid();
    const int n_win = 4 * 44, n_wuq = 1 * 12, n_wukv = 1 * 16, n_wout = 4 * 16, n_wgu = NEXP * 4 * 32, n_wd = NEXP * 4 * 16, n_wr = 4;
    const int total = n_win + n_wuq + n_wukv + n_wout + n_wgu + n_wd + n_wr;
    const int n_small = n_win + n_wuq + n_wukv + n_wout;
    const int it_lo = part == 2 ? n_small : 0, it_hi = part == 1 ? n_small : total;
    int* s_next = (int*)(smem + 256 * 65 * 4);
    for (int it = it_lo + bid;; it += nb) {
        if (queue) {
            __syncthreads();
            if (tid == 0) *s_next = it_lo + (int)atomicAdd(queue, 1u);
            __syncthreads();
            it = *s_next;
        }
        if (it >= it_hi) break;
        int t = it, mat, K, ntn;
        const float* src = nullptr; const float* src2 = nullptr; const float* kscale = nullptr; bf16_t* dst; int ldsrc;
        if (t < n_win) { mat = 0; K = 1024; ntn = 44; src = p.w_in + (size_t)layer * 1024 * 2736; ldsrc = 2736; dst = (bf16_t*)(p.ws + OFF_WIN); }
        else if ((t -= n_win) < n_wuq) { mat = 1; K = 256; ntn = 12; src = p.mla_w_uq + (size_t)layer * 256 * 768; ldsrc = 768; kscale = p.mla_q_norm_g + layer * 256; dst = (bf16_t*)(p.ws + OFF_WUQ); }
        else if ((t -= n_wuq) < n_wukv) { mat = 2; K = 128; ntn = 16; src = p.mla_w_ukv + (size_t)layer * 128 * 1024; ldsrc = 1024; kscale = p.mla_kv_norm_g + layer * 128; dst = (bf16_t*)(p.ws + OFF_WUKV); }
        else if ((t -= n_wukv) < n_wout) { mat = 3; K = 1024; ntn = 16; src = p.w_out + (size_t)layer * 1024 * 1024; ldsrc = 1024; dst = (bf16_t*)(p.ws + OFF_WOUT); }
        else if ((t -= n_wout) < n_wgu) { mat = 4; K = 1024; ntn = 32; int e = t / 128; t -= e * 128; src = p.ex_w_gate + ((size_t)layer * NEXP + e) * 1024 * 1024; src2 = p.ex_w_up + ((size_t)layer * NEXP + e) * 1024 * 1024; ldsrc = 1024; dst = (bf16_t*)(p.ws + OFF_WGU) + (size_t)e * 2048 * 1024; }
        else if ((t -= n_wgu) < n_wd) { mat = 5; K = 1024; ntn = 16; int e = t / 64; t -= e * 64; src = p.ex_w_down + ((size_t)layer * NEXP + e) * 1024 * 1024; ldsrc = 1024; dst = (bf16_t*)(p.ws + OFF_WD) + (size_t)e * 1024 * 1024; }
        else { t -= n_wd; mat = 6; K = 1024; ntn = 1; src = p.router_w + (size_t)layer * 1024 * 16; ldsrc = 16; dst = (bf16_t*)(p.ws + OFF_WR); }
        int kt = t / ntn, nt = t % ntn; int k0 = kt * 256, n0 = nt * 64; const int kn = K - k0 < 256 ? K - k0 : 256;
        {
            int tx = tid & 63, ty = tid >> 6; int n = n0 + tx; const float* sp = src; int sc;
            if (mat == 0) sc = win_src_col(n);
            else if (mat == 4) { sc = (n >> 6) * 32 + (n & 31); if (n & 32) sp = src2; }
            else if (mat == 6) sc = (n < 16) ? n : -1;
            else sc = n;
            float v[64];
#pragma unroll
            for (int q = 0; q < 64; ++q) { int kk = ty + 4 * q; v[q] = (sc >= 0 && kk < kn) ? ld_nt(sp + (size_t)(k0 + kk) * ldsrc + sc) : 0.f; }
            if (kscale) {
#pragma unroll
                for (int q = 0; q < 64; ++q) { int kk = ty + 4 * q; if (kk < kn) v[q] *= kscale[k0 + kk]; }
            }
#pragma unroll
            for (int q = 0; q < 64; ++q) tile[(ty + 4 * q) * 65 + tx] = v[q];
        }
        __syncthreads();
        {
            int nn = tid >> 2, part = tid & 3; int n = n0 + nn;
            if (!(mat == 6 && n >= 32) && part * 64 < kn) {
#pragma unroll
                for (int g = 0; g < 8; ++g) {
                    unsigned w[4];
#pragma unroll
                    for (int j = 0; j < 4; ++j) w[j] = pack2(tile[(part * 64 + g * 8 + 2 * j) * 65 + nn], tile[(part * 64 + g * 8 + 2 * j + 1) * 65 + nn]);
                    *(u32x4*)(dst + (size_t)n * K + k0 + part * 64 + g * 8) = (u32x4){w[0], w[1], w[2], w[3]};
                }
            }
        }
        __syncthreads();
    }
    float* bperm = (float*)(p.ws + OFF_BPERM);
    if (part != 2) for (int i = bid * NTHR + tid; i < DIN_P; i += nb * NTHR) { int sc = win_src_col(i); bperm[i] = sc >= 0 ? p.b_in[layer * 2736 + sc] : 0.f; }
}

DEV const float* xrow_ptr(const Params& p, int layer, int r, bool post) {
    int b = r / T, t = r % T;
    if (t < CTXL) return ((layer == 0 && !post) ? p.ctx : (const float*)(p.ws + OFF_CX)) + ((size_t)b * CTXL + t) * D;
    return ((layer == 0 && !post) ? p.x : (const float*)p.out) + ((size_t)b * SEQ + (t - CTXL)) * D;
}
DEV void ffn_sum(const Params& p, int clayer, int r, int lane, f32x4 (&s)[4]);
DEV void phase_norm(const Params& p, int layer, int which, int bid, int nb, int clayer = -1) {
    const int tid = get_tid(), lane = tid & 63, wid = tid >> 6;
    const float* g = (which ? p.norm2_g : p.norm1_g) + layer * D;
    const float* mods = (const float*)(p.ws + OFF_MODS) + (size_t)layer * (BATCH + 1) * 6144;
    bf16_t* h = (bf16_t*)(p.ws + OFF_H);
    const bool need_ctx = layer == 0;
    const int W = nb * 4, w = bid * 4 + wid; const bool smaj = W % BATCH == 0;
    const int tstep = smaj ? W / BATCH : 1;
    f32x4 gsc[4], shv[4], g2v[4]; int cur_id = -1;
    for (int it = smaj ? w / BATCH : w; it < (smaj ? T : R); it += smaj ? tstep : W) {
        const int r = smaj ? (w % BATCH) * T + it : it;
        int b = r / T, t = r % T;
        if (which == 1 && t < CTXL && !need_ctx) continue;
        const float* xr = xrow_ptr(p, layer, r, which == 1);
        const int mod_id = t < CTXL ? BATCH : b;
        if (mod_id != cur_id) {
            cur_id = mod_id;
            const float* mrow = mods + (size_t)mod_id * 6144 + (which ? 3 * 1024 : 0);
#pragma unroll
            for (int i = 0; i < 4; ++i) { int c = i * 256 + lane * 4; f32x4 gg = *(const f32x4*)(g + c), sc = *(const f32x4*)(mrow + 1024 + c); shv[i] = *(const f32x4*)(mrow + c);
                gsc[i] = (f32x4){gg[0] * (1.f + sc[0]), gg[1] * (1.f + sc[1]), gg[2] * (1.f + sc[2]), gg[3] * (1.f + sc[3])}; }
            if (clayer >= 0) {
                const float* g2 = (const float*)(p.ws + OFF_MODS) + ((size_t)clayer * (BATCH + 1) + mod_id) * 6144 + 5 * 1024;
#pragma unroll
                for (int i = 0; i < 4; ++i) g2v[i] = *(const f32x4*)(g2 + i * 256 + lane * 4);
            }
        }
        f32x4 v[4]; float ss = 0.f;
#pragma unroll
        for (int i = 0; i < 4; ++i) v[i] = *(const f32x4*)(xr + i * 256 + lane * 4);
        if (clayer >= 0) {
            f32x4 sacc[4]; ffn_sum(p, clayer, r, lane, sacc);
#pragma unroll
            for (int i = 0; i < 4; ++i) { int c = i * 256 + lane * 4; v[i] = v[i] + g2v[i] * sacc[i]; *(f32x4*)((float*)xr + c) = v[i]; }
        }
#pragma unroll
        for (int i = 0; i < 4; ++i) ss += v[i][0] * v[i][0] + v[i][1] * v[i][1] + v[i][2] * v[i][2] + v[i][3] * v[i][3];
#pragma unroll
        for (int m = 1; m < 64; m <<= 1) ss += shfl_xor_f(ss, m);
        float rstd = rsqrtf(ss * (1.f / 1024.f) + EPS);
#pragma unroll
        for (int i = 0; i < 4; ++i) {
            int c = i * 256 + lane * 4;
            float o0 = v[i][0] * rstd * gsc[i][0] + shv[i][0], o1 = v[i][1] * rstd * gsc[i][1] + shv[i][1];
            float o2 = v[i][2] * rstd * gsc[i][2] + shv[i][2], o3 = v[i][3] * rstd * gsc[i][3] + shv[i][3];
            *(u32x2*)(h + (size_t)r * D + c) = (u32x2){pack2(o0, o1), pack2(o2, o3)};
        }
    }
}

DEV void phase_proj(const Params& p, int layer, int bid, int nb, char* smem) {
    const bf16_t* h = (const bf16_t*)(p.ws + OFF_H); const bf16_t* W = (const bf16_t*)(p.ws + OFF_WIN);
    const float* bperm = (const float*)(p.ws + OFF_BPERM);
    bf16_t* projb = (bf16_t*)(p.ws + OFF_PB); float* pref = (float*)(p.ws + OFF_PF); float* gates = (float*)(p.ws + OFF_GT);
    const int tid = get_tid(); const int lane = tid & 63, wid = tid >> 6, wm = wid >> 1, wn = wid & 1;
    constexpr int NTN = DIN_P / 128, NTM = R / 256;
    int tf, te, tstr; xcd_range(bid, nb, NTM * NTN, tf, te, tstr);
    gemm_tiles256(tf, te, tstr, 1024, smem, (const bf16_t*)(p.ws + OFF_ZERO),
        [&](int t, int which, int row) { int tm, tn; tile_decode(t, NTM, NTN, tm, tn); return which ? W + (size_t)(tn * 128 + row) * 1024 : h + (size_t)(tm * 256 + row) * D; },
        [&](int t, f32x16 (&acc)[4][2], char* stg) {
            int tm_, tn_; tile_decode(t, NTM, NTN, tm_, tn_);
            const int r0 = tm_ * 256, n0 = tn_ * 128;
            float bias[2];
#pragma unroll
            for (int j = 0; j < 2; ++j) bias[j] = bperm[n0 + wn * 64 + j * 32 + (lane & 31)];
            if (n0 < 1792 || (n0 >= 2304 && n0 < 2688)) {
                const int cdst = n0 < 1792 ? n0 : n0 - 512;
                epi256_bf16(acc, stg, tid, [&](float v, int, int col) { return v + bias[(col >> 5) & 1]; },
                            [&](int row, int c, u32x4 v) { *(u32x4*)(projb + (size_t)(r0 + row) * PBW + cdst + c * 8) = v; });
            } else if (n0 < 2304) {
#pragma unroll
                for (int i = 0; i < 4; ++i)
#pragma unroll
                    for (int j = 0; j < 2; ++j)
#pragma unroll
                        for (int r = 0; r < 16; ++r) acc[i][j][r] += bias[j];
                epi256_f32(acc, stg, tid, [&](int row, int c, f32x4 v) { *(f32x4*)(pref + (size_t)(r0 + row) * 512 + (n0 - 1792) + c * 4) = v; });
            } else {
#pragma unroll
                for (int i = 0; i < 4; ++i)
#pragma unroll
                    for (int j = 0; j < 2; ++j)
#pragma unroll
                        for (int r = 0; r < 16; ++r) acc[i][j][r] += bias[j];
                epi256_f32(acc, stg, tid, [&](int row, int c, f32x4 v) {
                    if (c < 8) { *(u32x2*)(projb + (size_t)(r0 + row) * PBW + PB_KR + c * 4) = (u32x2){pack2(v[0], v[1]), pack2(v[2], v[3])}; }
                    else if (c < 12) { *(f32x4*)(gates + (size_t)(r0 + row) * 16 + (c - 8) * 4) = v; } });
            }
        });
}

constexpr int SLD = 72;
DEV void mm64(f32x16& acc, const bf16_t* sA, const bf16_t* sBt, int wr, int wc, int lane) {
#pragma unroll
    for (int ks = 0; ks < 4; ++ks) {
        bf16x8 a = *(const bf16x8*)(sA + (wr * 32 + (lane & 31)) * SLD + ks * 16 + (lane >> 5) * 8);
        bf16x8 b = *(const bf16x8*)(sBt + (wc * 32 + (lane & 31)) * SLD + ks * 16 + (lane >> 5) * 8);
        acc = mfma32(a, b, acc);
    }
}
DEV int chunk_base(int dir, int c) { if (dir == 0) return c * 64; return (64 * c < CTXL) ? CTXL - 64 * (c + 1) : T + CTXL - 64 * (c + 1); }

DEV void mm64_nx(f32x16& acc, const bf16_t* sA, const bf16_t* X, int wr, int wc, int lane) {
#pragma unroll
    for (int ks = 0; ks < 4; ++ks) {
        bf16x8 a = *(const bf16x8*)(sA + (wr * 32 + (lane & 31)) * SLD + ks * 16 + (lane >> 5) * 8);
        bf16x8 b = tr_frag(X, SLD, ks, wc * 32, lane);
        acc = mfma32(a, b, acc);
    }
}
DEV int scan_tok(int dir, int j) { return dir ? 63 - j : j; }

template <bool NOOUT = false>
DEV void scan_ml(const Params& p, int layer, int b, int hd, int dir, char* smem) {
    const int tid = get_tid(), lane = tid & 63, wid = tid >> 6, wr = wid >> 1, wc = wid & 1;
    const bool need_ctx = layer == 0;
    const bf16_t* projb = (const bf16_t*)(p.ws + OFF_PB); const float* gates = (const float*)(p.ws + OFF_GT);
    bf16_t* outp = (bf16_t*)(p.ws + OFF_H) + (size_t)dir * R * 256;
    constexpr int RLD = 136;
    bf16_t* sRaw = (bf16_t*)smem;
    bf16_t* sQ = sRaw + 66 * RLD; bf16_t* sK = sQ + 64 * SLD; bf16_t* sV = sK + 64 * SLD; bf16_t* sP = sV + 64 * SLD; bf16_t* sCt = sP + 64 * SLD;
    float* fb = (float*)(sCt + 64 * SLD);
    float* s_rowf = fb, *s_wst = fb + 64, *s_emt = fb + 128, *s_e = fb + 192, *s_n = fb + 256, *s_sc = fb + 320, *s_cw = fb + 336;
    bf16_t* s_nh = (bf16_t*)(s_cw + 512); bf16_t* s_nl = s_nh + 64;
    float* s_wsv = s_cw + 512 + 64; float* s_fdv = s_wsv + 64;
    const bf16x8 ones = {0x3F80, 0x3F80, 0x3F80, 0x3F80, 0x3F80, 0x3F80, 0x3F80, 0x3F80};
    f32x16 cst;
#pragma unroll
    for (int r = 0; r < 16; ++r) cst[r] = 0.f;
    __syncthreads();
    for (int i = tid; i < 64 * SLD; i += NTHR) sCt[i] = 0;
    if (tid < 64) { s_n[tid] = 0.f; s_nh[tid] = 0; s_nl[tid] = 0; }
    if (tid < 128) {
        int col = (tid < 64 ? 0 : 256) + hd * 64 + (tid & 63);
        const float* cw = p.ml_conv_w + layer * 3 * 512;
        s_cw[tid] = cw[col]; s_cw[128 + tid] = cw[512 + col]; s_cw[256 + tid] = cw[1024 + col]; s_cw[384 + tid] = p.ml_conv_b[layer * 512 + col];
    }
    float mprev = 0.f;
    const size_t rb = (size_t)b * T;
    u32x4 praw[5], pv[2]; float pig = 0.f, pfg = 0.f;
    auto prefetch = [&](int c) {
        const int base = chunk_base(dir, c); const int seg_lo = base < CTXL ? 0 : CTXL, seg_hi = base < CTXL ? CTXL : T;
#pragma unroll
        for (int i = 0; i < 5; ++i) {
            int id = tid + NTHR * i; int row = id >> 4, cg = id & 15; int tok = base - 1 + row;
            praw[i] = (u32x4){0, 0, 0, 0};
            if (id < 66 * 16 && tok >= seg_lo && tok < seg_hi) praw[i] = *(const u32x4*)(projb + (rb + tok) * PBW + PB_MLQK + (cg < 8 ? 0 : 256) + hd * 64 + (cg & 7) * 8);
        }
#pragma unroll
        for (int i = 0; i < 2; ++i) { int id = tid + NTHR * i; int row = id >> 3, cg = id & 7; pv[i] = *(const u32x4*)(projb + (rb + base + row) * PBW + PB_MLV + hd * 64 + cg * 8); }
        if (tid < 64) { const float* g = gates + (rb + base + scan_tok(dir, tid)) * 16 + dir * 8 + hd; pig = g[0]; pfg = g[4]; }
    };
    prefetch(0);
    for (int c = 0; c < NC; ++c) {
        const int base = chunk_base(dir, c);
        const bool want_out = !NOOUT && (need_ctx || base >= CTXL);
#pragma unroll
        for (int i = 0; i < 5; ++i) { int id = tid + NTHR * i; if (id < 66 * 16) *(u32x4*)(sRaw + (id >> 4) * RLD + (id & 15) * 8) = praw[i]; }
#pragma unroll
        for (int i = 0; i < 2; ++i) { int id = tid + NTHR * i; *(u32x4*)(sV + (id >> 3) * SLD + (id & 7) * 8) = pv[i]; }
        if (tid < 64) {
            float ig = pig, lf = logsigmoidf_(pfg);
            float bc = wave_scan_add(lf, lane);
            float a = ig - bc, pm = wave_scan_max(a, lane);
            float mu = shfl_idx_f(pm, 63);
            float mm_ = fmaxf(mprev, pm);
            int u = scan_tok(dir, lane);
            s_rowf[u] = __expf(fminf(mu - mm_, 80.f)); s_wst[u] = __expf(mprev - mm_); s_emt[u] = __expf(-(bc + mm_)); s_e[u] = __expf(a - mu);
            float mx = fmaxf(mprev, mu);
            s_wsv[lane] = __expf(mprev - mx); s_fdv[lane] = __expf(mu - mx);
            mprev = shfl_idx_f(bc, 63) + mx;
        }
        if (c + 1 < NC) prefetch(c + 1);
        __syncthreads();
#pragma unroll
        for (int i = 0; i < 4; ++i) {
            int id = tid + NTHR * i; int u = id >> 4, cg = id & 15;
            const bf16_t* r1 = sRaw + (u + 1) * RLD + cg * 8;
            u32x4 c0 = *(const u32x4*)(r1 - RLD), c1 = *(const u32x4*)r1, c2 = *(const u32x4*)(r1 + RLD);
            float sc = cg < 8 ? 1.f : 0.125f * s_e[u];
            float o[8];
#pragma unroll
            for (int q = 0; q < 8; ++q) {
                unsigned w0 = c0[q >> 1], w1 = c1[q >> 1], w2 = c2[q >> 1];
                float a0 = bf2f((bf16_t)((q & 1) ? w0 >> 16 : w0 & 0xffff)), a1 = bf2f((bf16_t)((q & 1) ? w1 >> 16 : w1 & 0xffff)), a2 = bf2f((bf16_t)((q & 1) ? w2 >> 16 : w2 & 0xffff));
                int cc = cg * 8 + q;
                o[q] = siluf_(s_cw[cc] * a0 + s_cw[128 + cc] * a1 + s_cw[256 + cc] * a2 + s_cw[384 + cc]) * sc;
            }
            *(u32x4*)((cg < 8 ? sQ : sK) + u * SLD + (cg & 7) * 8) = (u32x4){pack2(o[0], o[1]), pack2(o[2], o[3]), pack2(o[4], o[5]), pack2(o[6], o[7])};
        }
        __syncthreads();
        f32x16 accn, accd;
#pragma unroll
        for (int r = 0; r < 16; ++r) { accn[r] = 0.f; accd[r] = 0.f; }
        if (want_out) {
            f32x16 acc;
#pragma unroll
            for (int r = 0; r < 16; ++r) acc[r] = 0.f;
            const bool skip = dir ? (wr == 1 && wc == 0) : (wr == 0 && wc == 1);
            if (!skip) mm64(acc, sQ, sK, wr, wc, lane);
            {
                int sidx = wc * 32 + (lane & 31);
#pragma unroll
                for (int r = 0; r < 16; ++r) {
                    int t = wr * 32 + crow(r, lane);
                    bool ok = dir ? (sidx >= t) : (sidx <= t);
                    sP[t * SLD + sidx] = f2bf(ok ? acc[r] * s_rowf[t] : 0.f);
                }
            }
            mm64(accn, sQ, sCt, wr, wc, lane);
#pragma unroll
            for (int ks = 0; ks < 4; ++ks) {
                bf16x8 a = *(const bf16x8*)(sQ + (wr * 32 + (lane & 31)) * SLD + ks * 16 + (lane >> 5) * 8);
                accd = mfma32(a, *(const bf16x8*)(s_nh + ks * 16 + (lane >> 5) * 8), accd);
                accd = mfma32(a, *(const bf16x8*)(s_nl + ks * 16 + (lane >> 5) * 8), accd);
            }
#pragma unroll
            for (int r = 0; r < 16; ++r) { float w = s_wst[wr * 32 + crow(r, lane)]; accn[r] *= w; accd[r] *= w; }
        }
        __syncthreads();
        if (want_out) {
#pragma unroll
            for (int ks = 0; ks < 4; ++ks) {
                bf16x8 a = *(const bf16x8*)(sP + (wr * 32 + (lane & 31)) * SLD + ks * 16 + (lane >> 5) * 8);
                accn = mfma32(a, tr_frag(sV, SLD, ks, wc * 32, lane), accn);
                accd = mfma32(a, ones, accd);
            }
            int v = wc * 32 + (lane & 31);
#pragma unroll
            for (int r = 0; r < 16; ++r) {
                int t = wr * 32 + crow(r, lane);
                float den = fmaxf(fabsf(accd[r]), s_emt[t]);
                outp[(rb + base + t) * 256 + hd * 64 + v] = f2bf(accn[r] * fast_rcp(den));
            }
        }
        {
            f32x16 x, nacc;
#pragma unroll
            for (int r = 0; r < 16; ++r) { x[r] = 0.f; nacc[r] = 0.f; }
#pragma unroll
            for (int ks = 0; ks < 4; ++ks) {
                bf16x8 a = tr_frag(sK, SLD, ks, wr * 32, lane);
                x = mfma32(a, tr_frag(sV, SLD, ks, wc * 32, lane), x);
                nacc = mfma32(a, ones, nacc);
            }
            const float ws = s_wsv[lane], fd = s_fdv[lane];
            int v = wc * 32 + (lane & 31);
#pragma unroll
            for (int r = 0; r < 16; ++r) { cst[r] = ws * cst[r] + fd * x[r]; sCt[v * SLD + wr * 32 + crow(r, lane)] = f2bf(cst[r]); }
            if (wc == 0 && (lane & 31) == 0) {
#pragma unroll
                for (int r = 0; r < 16; ++r) {
                    int k = wr * 32 + crow(r, lane); float nn = ws * s_n[k] + fd * nacc[r];
                    s_n[k] = nn; bf16_t hi = f2bf(nn); s_nh[k] = hi; s_nl[k] = f2bf(nn - bf2f(hi));
                }
            }
        }
        __syncthreads();
    }
}

template <bool NOOUT = false>
DEV void scan_hg(const Params& p, int layer, int b, int hd, int dir, char* smem) {
    const int tid = get_tid(), lane = tid & 63, wid = tid >> 6, wr = wid >> 1, wc = wid & 1;
    const bool need_ctx = layer == 0;
    const bf16_t* projb = (const bf16_t*)(p.ws + OFF_PB); const float* pref = (const float*)(p.ws + OFF_PF);
    bf16_t* outp = (bf16_t*)(p.ws + OFF_H) + (size_t)(2 + dir) * R * 256;
    const float* lbp = (const float*)(p.ws + OFF_LB) + layer * 512 + dir * 256 + hd * 64;
    bf16_t* sQs = (bf16_t*)smem; bf16_t* sKs = sQs + 64 * SLD; bf16_t* sV = sKs + 64 * SLD; bf16_t* sP = sV + 64 * SLD; bf16_t* sSt = sP + 64 * SLD;
    float* s_ps = (float*)(sSt + 64 * SLD);
    float* s_r = s_ps + 256; float* s_bend = s_r + 64;
    f32x16 st;
#pragma unroll
    for (int r = 0; r < 16; ++r) st[r] = 0.f;
    __syncthreads();
    const int k = tid & 63, part = tid >> 6;
    const float low = lbp[k];
    const size_t rb = (size_t)b * T;
    float ppre[16]; bf16_t pq[16]; u32x4 pv[2];
    auto prefetch = [&](int c) {
        const int base = chunk_base(dir, c);
#pragma unroll
        for (int i = 0; i < 16; ++i) {
            int tok = base + scan_tok(dir, part * 16 + i);
            ppre[i] = pref[(rb + tok) * 512 + dir * 256 + hd * 64 + k];
            pq[i] = projb[(rb + tok) * PBW + PB_HGQ + hd * 64 + k];
        }
#pragma unroll
        for (int i = 0; i < 2; ++i) { int id = tid + NTHR * i; int row = id >> 3, cg = id & 7; pv[i] = *(const u32x4*)(projb + (rb + base + row) * PBW + PB_HGV + hd * 64 + cg * 8); }
    };
    prefetch(0);
    for (int c = 0; c < NC; ++c) {
        const int base = chunk_base(dir, c);
        const bool want_out = !NOOUT && (need_ctx || base >= CTXL);
        float kk[16], lfc[16], qv[16]; float run = 0.f;
#pragma unroll
        for (int i = 0; i < 16; ++i) {
            float pre = ppre[i];
            float lf = (low == 0.f) ? logsigmoidf_(pre) : __logf(low + (1.f - low) * sigmoidf_(pre));
            kk[i] = (1.f - low) * sigmoidf_(-pre);
            run += lf; lfc[i] = run; qv[i] = siluf_(bf2f(pq[i]));
        }
        s_ps[part * 64 + k] = run;
#pragma unroll
        for (int i = 0; i < 2; ++i) { int id = tid + NTHR * i; *(u32x4*)(sV + (id >> 3) * SLD + (id & 7) * 8) = pv[i]; }
        if (c + 1 < NC) prefetch(c + 1);
        __syncthreads();
        float off = 0.f;
        for (int q = 0; q < part; ++q) off += s_ps[q * 64 + k];
#pragma unroll
        for (int i = 0; i < 16; ++i) lfc[i] += off;
        if (part == 1) s_r[k] = lfc[15];
        if (part == 3) s_bend[k] = lfc[15];
        __syncthreads();
        const float rref = s_r[k];
#pragma unroll
        for (int i = 0; i < 16; ++i) {
            int u = scan_tok(dir, part * 16 + i);
            sQs[u * SLD + k] = f2bf(qv[i] * __expf(lfc[i] - rref));
            sKs[u * SLD + k] = f2bf(kk[i] * __expf(rref - lfc[i]));
        }
        {
            int v = wc * 32 + (lane & 31);
#pragma unroll
            for (int r = 0; r < 16; ++r) { int kr = wr * 32 + crow(r, lane); sSt[v * SLD + kr] = f2bf(st[r] * __expf(s_r[kr])); }
        }
        __syncthreads();
        f32x16 acc;
#pragma unroll
        for (int r = 0; r < 16; ++r) acc[r] = 0.f;
        if (want_out) {
            f32x16 sacc;
#pragma unroll
            for (int r = 0; r < 16; ++r) sacc[r] = 0.f;
            const bool skip = dir ? (wr == 1 && wc == 0) : (wr == 0 && wc == 1);
            if (!skip) mm64(sacc, sQs, sKs, wr, wc, lane);
            int sidx = wc * 32 + (lane & 31);
#pragma unroll
            for (int r = 0; r < 16; ++r) { int t = wr * 32 + crow(r, lane); bool ok = dir ? (sidx >= t) : (sidx <= t); sP[t * SLD + sidx] = f2bf(ok ? sacc[r] : 0.f); }
            mm64(acc, sQs, sSt, wr, wc, lane);
        }
        __syncthreads();
        if (want_out) {
            mm64_nx(acc, sP, sV, wr, wc, lane);
            int v = wc * 32 + (lane & 31);
#pragma unroll
            for (int r = 0; r < 16; ++r) { int t = wr * 32 + crow(r, lane); outp[(rb + base + t) * 256 + hd * 64 + v] = f2bf(acc[r]); }
        }
        {
            f32x16 x;
#pragma unroll
            for (int r = 0; r < 16; ++r) x[r] = 0.f;
#pragma unroll
            for (int ks = 0; ks < 4; ++ks) x = mfma32(tr_frag(sKs, SLD, ks, wr * 32, lane), tr_frag(sV, SLD, ks, wc * 32, lane), x);
#pragma unroll
            for (int r = 0; r < 16; ++r) { int kr = wr * 32 + crow(r, lane); float be = s_bend[kr]; st[r] = __expf(be) * st[r] + __expf(be - s_r[kr]) * x[r]; }
        }
        __syncthreads();
    }
}
DEV void phase_scan(const Params& p, int layer, int bid, int nb, char* smem) {
    const int nchains = BATCH * 4 * 2 * 2;
    for (int it = bid; it < nchains; it += nb) {
        int type = it & 1, dir = (it >> 1) & 1, hd = (it >> 2) & 3, b = it >> 4;
        if (type == 0) scan_ml(p, layer, b, hd, dir, smem); else scan_hg(p, layer, b, hd, dir, smem);
    }
}
template <int WHICH>
DEV void phase_scan_probe(const Params& p, int layer, int bid, int nb, char* smem) {
    const int nchains = BATCH * 4 * 2 * 2;
    for (int it = bid; it < nchains; it += nb) {
        int type = it & 1, dir = (it >> 1) & 1, hd = (it >> 2) & 3, b = it >> 4;
        if (WHICH == 0) { if (type == 0) scan_ml<true>(p, layer, b, hd, dir, smem); else scan_hg<true>(p, layer, b, hd, dir, smem); }
        if (WHICH == 1 && type == 0) scan_ml(p, layer, b, hd, dir, smem);
        if (WHICH == 2 && type == 1) scan_hg(p, layer, b, hd, dir, smem);
    }
}

template <int TN, class ARows, class BRows, class Epi>
DEV void gemm_stream_w4(int first, int end, int stride, int nsub, int KT, char* smem, const bf16_t* zrow, ARows arows, BRows brows, Epi epi) {
    constexpr int STAGE = 32768, A_BYTES = 16384;
    const int tid = get_tid(), lane = tid & 63, wid = tid >> 6;
    if (first >= end) return;
    const int nt = (end - first + stride - 1) / stride; const int G = nt * nsub * KT;
    int lli = 0, lsub = 0, lkt = 0, lg = 0;
    auto issue = [&]() {
        const int t = first + lli * stride;
        bf16_t* sa = (bf16_t*)(smem + (lg & 1) * STAGE); bf16_t* sb = (bf16_t*)(smem + (lg & 1) * STAGE + A_BYTES);
#pragma unroll
        for (int i = 0; i < 4; ++i) { int row = (i * 4 + wid) * 8 + (lane >> 3); const bf16_t* pa = arows(t, row); glds16(pa ? pa + swz(row, lane & 7) * 8 + lkt * 64 : zrow, sa + (i * 4 + wid) * 512 + lane * 8); }
#pragma unroll
        for (int i = 0; i < TN; ++i) { int row = (i * 4 + wid) * 8 + (lane >> 3); glds16(brows(t, lsub, row) + swz(row, lane & 7) * 8 + lkt * 64, sb + (i * 4 + wid) * 512 + lane * 8); }
        ++lg; if (++lkt == KT) { lkt = 0; if (++lsub == nsub) { lsub = 0; ++lli; } }
    };
    __syncthreads();
    issue();
    glds_wait();
    __syncthreads();
    int g = 0;
    for (int li = 0; li < nt; ++li)
        for (int sub = 0; sub < nsub; ++sub) {
            f32x16 acc[TN];
#pragma unroll
            for (int j = 0; j < TN; ++j)
#pragma unroll
                for (int r = 0; r < 16; ++r) acc[j][r] = 0.f;
            for (int kt = 0; kt < KT; ++kt, ++g) {
                if (lg < G) issue();
                const bf16_t* sa = (const bf16_t*)(smem + (g & 1) * STAGE); const bf16_t* sb = (const bf16_t*)((const char*)sa + A_BYTES);
#pragma unroll
                for (int ks = 0; ks < 4; ++ks) {
                    const int c = ks * 2 + (lane >> 5);
                    int ra = wid * 32 + (lane & 31);
                    bf16x8 af = *(const bf16x8*)(sa + ra * 64 + swz(ra, c) * 8);
#pragma unroll
                    for (int j = 0; j < TN; ++j) { int rb = j * 32 + (lane & 31); acc[j] = mfma32(af, *(const bf16x8*)(sb + rb * 64 + swz(rb, c) * 8), acc[j]); }
                }
                glds_wait();
                __syncthreads();
            }
            epi(first + li * stride, sub, acc);
            __syncthreads();
        }
}

DEV void phase_mla(const Params& p, int layer, int bid, int nb, char* smem) {
    const int tid = get_tid(), lane = tid & 63, wid = tid >> 6, cl = lane & 31;
    const bool need_ctx = layer == 0;
    const bf16_t* projb = (const bf16_t*)(p.ws + OFF_PB);
    bf16_t* Qg = (bf16_t*)(p.ws + OFF_QKV); bf16_t* Kg = Qg + (size_t)BATCH * 8 * T * 96; bf16_t* Vt = Kg + (size_t)BATCH * 8 * T * 96;
    const float* rope = (const float*)(p.ws + OFF_ROPE);
    const bf16_t* WUQ = (const bf16_t*)(p.ws + OFF_WUQ); const bf16_t* WUKV = (const bf16_t*)(p.ws + OFF_WUKV);
    const bf16_t* zrow = (const bf16_t*)(p.ws + OFF_ZERO);
    bf16_t* stK = (bf16_t*)(smem + EPI_OFF);
    bf16_t* stV = (bf16_t*)(smem + EPI_OFF + 24576);
    float* s_rstd = (float*)(smem + EPI_OFF + 24576 + 17408);
    constexpr int NSUB = 2, NHG = 8 / NSUB;
    const int tpb = need_ctx ? T / 128 : SEQ / 128;
    auto row_rstd = [&](int r0, int col0, int ncol) {
        int row = tid >> 1, half = tid & 1; const bf16_t* src = projb + (size_t)(r0 + row) * PBW + col0 + half * (ncol / 2);
        float ss = 0.f;
        for (int i = 0; i < ncol / 2; i += 8) { u32x4 v = *(const u32x4*)(src + i);
#pragma unroll
            for (int q = 0; q < 4; ++q) { float lo = bf2f((bf16_t)(v[q] & 0xffff)), hi = bf2f((bf16_t)(v[q] >> 16)); ss += lo * lo + hi * hi; } }
        ss += shfl_xor_f(ss, 1);
        if (half == 0) s_rstd[row] = rsqrtf(ss / (float)ncol + EPS);
        __syncthreads();
    };
    {
        auto qrow0 = [&](int t) { int rt = t / NHG; int b = rt / tpb, j = rt % tpb; return b * T + (need_ctx ? 0 : CTXL) + j * 128; };
        const int nrt = BATCH * tpb; const bool xok = (nb % 8 == 0) && (nrt % 8 == 0);
        auto qmap = [&](int t) { if (!xok) return t; int idx = t >> 3, g = t & 7; int rtl = idx / NHG, hgp = idx % NHG; return (rtl * 8 + g) * NHG + hgp; };
        gemm_stream_w4<3>(xok ? (bid & 7) + 8 * (bid >> 3) : bid, nrt * NHG, nb, NSUB, 4, smem, zrow,
            [&](int t0_, int row) { int t = qmap(t0_); return projb + (size_t)(qrow0(t) + row) * PBW + PB_CQ; },
            [&](int t0_, int sub, int row) { int t = qmap(t0_); int hd = (t % NHG) * NSUB + sub; return WUQ + (size_t)(hd * 96 + row) * 256; },
            [&](int t0_, int sub, f32x16 (&acc)[3]) {
                const int t = qmap(t0_); const int r0 = qrow0(t), hd = (t % NHG) * NSUB + sub; const int b = r0 / T, t0 = r0 % T; const bool islat = t0 >= CTXL;
                if (sub == 0) row_rstd(r0, PB_CQ, 256);
                const float* gq = p.mla_q_qk_g + layer * 96;
                float ssq[16];
#pragma unroll
                for (int r = 0; r < 16; ++r) { float rs = s_rstd[wid * 32 + crow(r, lane)]; float sacc = 0.f;
#pragma unroll
                    for (int j = 0; j < 3; ++j) { acc[j][r] *= rs; sacc += acc[j][r] * acc[j][r]; }
                    ssq[r] = sacc; }
#pragma unroll
                for (int m = 1; m < 32; m <<= 1)
#pragma unroll
                    for (int r = 0; r < 16; ++r) ssq[r] += shfl_xor_f(ssq[r], m);
#pragma unroll
                for (int r = 0; r < 16; ++r) {
                    float rn = rsqrtf(ssq[r] * (1.f / 96.f) + EPS) * QSCL; int rl = wid * 32 + crow(r, lane); int tt = t0 + rl;
                    float v0 = acc[0][r] * rn * gq[cl], v1 = acc[1][r] * rn * gq[32 + cl], v2 = acc[2][r] * rn * gq[64 + cl];
                    float pv = shfl_xor_f(v2, 8);
                    if (islat) { const float* rt = rope + (size_t)(tt - CTXL) * 32 + (cl >> 4) * 16; int j = cl & 7; float cs = rt[j], sn = rt[8 + j]; v2 = v2 * cs + ((cl & 8) ? pv : -pv) * sn; }
                    stK[rl * 96 + cl] = f2bf(v0); stK[rl * 96 + 32 + cl] = f2bf(v1); stK[rl * 96 + 64 + cl] = f2bf(v2);
                    SCHED_FENCE();
                }
                __syncthreads();
                u32x4* dst = (u32x4*)(Qg + (((size_t)b * 8 + hd) * T + t0) * 96);
#pragma unroll
                for (int q = 0; q < 6; ++q) dst[tid + NTHR * q] = ((const u32x4*)stK)[tid + NTHR * q];
            });
    }
    {
        const int nrk = R / 128; const bool xk = (nb % 8 == 0) && (nrk % 8 == 0);
        auto kmap = [&](int t) { if (!xk) return t; int idx = t >> 3, g = t & 7; int rtl = idx / NHG, hgp = idx % NHG; return (rtl * 8 + g) * NHG + hgp; };
        gemm_stream_w4<4>(bid, nrk * NHG, nb, NSUB, 2, smem, zrow,
            [&](int t0_, int row) { int t = kmap(t0_); return projb + (size_t)((t / NHG) * 128 + row) * PBW + PB_CKV; },
            [&](int t0_, int sub, int row) { int t = kmap(t0_); int hd = (t % NHG) * NSUB + sub; return WUKV + (size_t)(hd * 128 + row) * 128; },
            [&](int t0_, int sub, f32x16 (&acc)[4]) {
                const int t = kmap(t0_); const int r0 = (t / NHG) * 128, hd = (t % NHG) * NSUB + sub; const int b = r0 / T, t0 = r0 % T; const bool islat = t0 >= CTXL;
                if (sub == 0) row_rstd(r0, PB_CKV, 128);
                bf16_t* sV = (bf16_t*)(smem + EPI_OFF);
#pragma unroll
                for (int j = 0; j < 2; ++j)
#pragma unroll
                    for (int g = 0; g < 4; ++g) {
                        int tl = wid * 32 + 8 * g + 4 * (lane >> 5); int dv = j * 32 + cl;
                        f32x4 rs4 = *(const f32x4*)(s_rstd + tl);
                        *(u32x2*)(sV + dv * CLD + tl) = (u32x2){pack2(acc[2 + j][4 * g] * rs4[0], acc[2 + j][4 * g + 1] * rs4[1]), pack2(acc[2 + j][4 * g + 2] * rs4[2], acc[2 + j][4 * g + 3] * rs4[3])};
                    }
                __syncthreads();
#pragma unroll
                for (int q = 0; q < 4; ++q) { int id = tid + NTHR * q; int dv = id >> 4, c = id & 15; *(u32x4*)(Vt + (((size_t)b * 8 + hd) * 64 + dv) * T + t0 + c * 8) = *(const u32x4*)(sV + dv * CLD + c * 8); }
                __syncthreads();
                constexpr int KFL = 68;
                float* sKf = (float*)(smem + EPI_OFF);
#pragma unroll
                for (int j = 0; j < 2; ++j)
#pragma unroll
                    for (int r = 0; r < 16; ++r) { int rl = wid * 32 + crow(r, lane); sKf[rl * KFL + j * 32 + cl] = acc[j][r] * s_rstd[rl]; }
                __syncthreads();
                {
                    const int row = tid >> 1, half = tid & 1; const int tt = t0 + row;
                    const float* gk = p.mla_k_qk_g + layer * 96;
                    float v[48];
                    if (half == 0) {
#pragma unroll
                        for (int c = 0; c < 48; c += 4) { f32x4 x = *(const f32x4*)(sKf + row * KFL + c); v[c] = x[0]; v[c + 1] = x[1]; v[c + 2] = x[2]; v[c + 3] = x[3]; }
                    } else {
#pragma unroll
                        for (int c = 0; c < 16; c += 4) { f32x4 x = *(const f32x4*)(sKf + row * KFL + 48 + c); v[c] = x[0]; v[c + 1] = x[1]; v[c + 2] = x[2]; v[c + 3] = x[3]; }
                        const u32x4* kp = (const u32x4*)(projb + (size_t)(r0 + row) * PBW + PB_KR);
#pragma unroll
                        for (int q = 0; q < 4; ++q) { u32x4 w = kp[q];
#pragma unroll
                            for (int e = 0; e < 4; ++e) { v[16 + q * 8 + 2 * e] = bf2f((bf16_t)(w[e] & 0xffff)); v[16 + q * 8 + 2 * e + 1] = bf2f((bf16_t)(w[e] >> 16)); } }
                    }
                    float ss = 0.f;
#pragma unroll
                    for (int c = 0; c < 48; ++c) ss += v[c] * v[c];
                    ss += shfl_xor_f(ss, 1);
                    const float rn = rsqrtf(ss * (1.f / 96.f) + EPS);
#pragma unroll
                    for (int c = 0; c < 48; ++c) v[c] *= rn * gk[half * 48 + c];
                    if (half == 1 && islat) {
                        const float* rt = rope + (size_t)(tt - CTXL) * 32;
#pragma unroll
                        for (int gph = 0; gph < 2; ++gph)
#pragma unroll
                            for (int j = 0; j < 8; ++j) {
                                float cs = rt[gph * 16 + j], sn = rt[gph * 16 + 8 + j]; float x1 = v[16 + gph * 16 + j], x2 = v[16 + gph * 16 + 8 + j];
                                v[16 + gph * 16 + j] = x1 * cs - x2 * sn; v[16 + gph * 16 + 8 + j] = x2 * cs + x1 * sn;
                            }
                    }
                    u32x4* dst = (u32x4*)(Kg + (((size_t)b * 8 + hd) * T + tt) * 96 + half * 48);
#pragma unroll
                    for (int q = 0; q < 6; ++q) dst[q] = (u32x4){pack2(v[q * 8], v[q * 8 + 1]), pack2(v[q * 8 + 2], v[q * 8 + 3]), pack2(v[q * 8 + 4], v[q * 8 + 5]), pack2(v[q * 8 + 6], v[q * 8 + 7])};
                }
            });
    }
}

DEV void phase_attn(const Params& p, int layer, int bid, int nb, char* smem) {
    const int tid = get_tid(), lane = tid & 63, wid = tid >> 6, cl = lane & 31, hh = lane >> 5;
    const bool need_ctx = layer == 0;
    const bf16_t* Qg = (const bf16_t*)(p.ws + OFF_QKV); const bf16_t* Kg = Qg + (size_t)BATCH * 8 * T * 96; const bf16_t* Vt = Kg + (size_t)BATCH * 8 * T * 96;
    bf16_t* yb = (bf16_t*)(p.ws + OFF_PF);
    constexpr int KA = 64 * 128, KB = 64 * 64, VB = 64 * 128, STG = KA + KB + VB;
    constexpr int NQT = T / 128;
    const int nlat = SEQ / 128, nctx = need_ctx ? CTXL / 128 : 0; const int per_bh = nlat + nctx;
    const int nlat_items = BATCH * 8 * nlat, nctx_items = BATCH * 8 * nctx;
    const bool xcd_ok = (nb % 8 == 0) && ((BATCH * 8) % 8 == 0);
    const int lat_first = xcd_ok ? (bid >> 3) : bid, lat_stride = xcd_ok ? (nb >> 3) : nb, lat_cnt = xcd_ok ? nlat_items / 8 : nlat_items;
    const int my_lat = lat_first < lat_cnt ? (lat_cnt - lat_first + lat_stride - 1) / lat_stride : 0;
    const int my_ctx = bid < nctx_items ? (nctx_items - bid + nb - 1) / nb : 0;
    for (int wi = 0; wi < my_lat + my_ctx; ++wi) {
        int bh, qt;
        if (wi < my_lat) { int idx = lat_first + wi * lat_stride; int bhl = idx / nlat; qt = CTXL / 128 + idx % nlat; bh = xcd_ok ? bhl * 8 + (bid & 7) : bhl; }
        else { int u = bid + (wi - my_lat) * nb; bh = u / nctx; qt = u % nctx; }
        int t0 = qt * 128; const bool islat = t0 >= CTXL;
        const int nkeys = islat ? T : CTXL; const int nkt = nkeys / 64;
        const bf16_t* Kb_ = Kg + (size_t)bh * T * 96; const bf16_t* Vb_ = Vt + (size_t)bh * 64 * T;
        bf16x8 qf[6];
        { const bf16_t* q = Qg + ((size_t)bh * T + t0 + wid * 32 + cl) * 96 + hh * 8;
#pragma unroll
          for (int s2 = 0; s2 < 6; ++s2) qf[s2] = *(const bf16x8*)(q + s2 * 16); }
        f32x16 o0, o1;
#pragma unroll
        for (int r = 0; r < 16; ++r) { o0[r] = 0.f; o1[r] = 0.f; }
        float mrun = -1e30f, lrun = 0.f;
        auto stage_load = [&](int buf, int kt) {
            bf16_t* ska = (bf16_t*)(smem + buf * STG); bf16_t* skb = (bf16_t*)(smem + buf * STG + KA); bf16_t* sv = (bf16_t*)(smem + buf * STG + KA + KB);
#pragma unroll
            for (int i = 0; i < 2; ++i) { int row = (i * 4 + wid) * 8 + (lane >> 3); glds16(Kb_ + (size_t)(kt * 64 + row) * 96 + swz(row, lane & 7) * 8, ska + (i * 4 + wid) * 512 + lane * 8); }
            { int row = wid * 16 + (lane >> 2); glds16(Kb_ + (size_t)(kt * 64 + row) * 96 + 64 + swz4(row, lane & 3) * 8, skb + wid * 512 + lane * 8); }
#pragma unroll
            for (int i = 0; i < 2; ++i) { int row = (i * 4 + wid) * 8 + (lane >> 3); glds16(Vb_ + (size_t)row * T + kt * 64 + swz(row, lane & 7) * 8, sv + (i * 4 + wid) * 512 + lane * 8); }
        };
        __syncthreads();
        stage_load(0, 0);
        glds_wait();
        __syncthreads();
        for (int kt = 0; kt < nkt; ++kt) {
            if (kt + 1 < nkt) stage_load((kt + 1) & 1, kt + 1);
            const bf16_t* ska = (const bf16_t*)(smem + (kt & 1) * STG); const bf16_t* skb = (const bf16_t*)(smem + (kt & 1) * STG + KA); const bf16_t* sv = (const bf16_t*)(smem + (kt & 1) * STG + KA + KB);
            f32x16 s0, s1;
#pragma unroll
            for (int r = 0; r < 16; ++r) { s0[r] = 0.f; s1[r] = 0.f; }
#pragma unroll
            for (int s2 = 0; s2 < 4; ++s2) {
                int c = s2 * 2 + hh;
                bf16x8 k0 = *(const bf16x8*)(ska + cl * 64 + swz(cl, c) * 8), k1 = *(const bf16x8*)(ska + (32 + cl) * 64 + swz(32 + cl, c) * 8);
                s0 = mfma32(k0, qf[s2], s0); s1 = mfma32(k1, qf[s2], s1);
            }
#pragma unroll
            for (int s2 = 4; s2 < 6; ++s2) {
                int c = (s2 - 4) * 2 + hh;
                bf16x8 k0 = *(const bf16x8*)(skb + cl * 32 + swz4(cl, c) * 8), k1 = *(const bf16x8*)(skb + (32 + cl) * 32 + swz4(32 + cl, c) * 8);
                s0 = mfma32(k0, qf[s2], s0); s1 = mfma32(k1, qf[s2], s1);
            }
            float mx = -1e30f;
#pragma unroll
            for (int r = 0; r < 16; ++r) mx = fmaxf(mx, fmaxf(s0[r], s1[r]));
            mx = fmaxf(mx, shfl_xor_f(mx, 32));
            if (!wave_all(mx <= mrun + 8.f)) {
                float mnew = fmaxf(mrun, mx), alpha = fast_exp2(mrun - mnew); mrun = mnew; lrun *= alpha;
#pragma unroll
                for (int r = 0; r < 16; ++r) { o0[r] *= alpha; o1[r] *= alpha; }
            }
            float ls = 0.f;
#pragma unroll
            for (int r = 0; r < 16; ++r) { s0[r] = fast_exp2(s0[r] - mrun); s1[r] = fast_exp2(s1[r] - mrun); ls += s0[r] + s1[r]; }
            lrun += ls;
#pragma unroll
            for (int s2 = 0; s2 < 4; ++s2) {
                const f32x16& sx = (s2 < 2) ? s0 : s1; int rbase = (s2 & 1) * 8;
                bf16x8 pb;
#pragma unroll
                for (int j = 0; j < 8; ++j) pb[j] = (short)f2bf(sx[rbase + j]);
#pragma unroll
                for (int i = 0; i < 2; ++i) {
                    int row = i * 32 + cl;
                    bf16x4 lo = *(const bf16x4*)(sv + row * 64 + swz(row, 2 * s2) * 8 + 4 * hh), hi = *(const bf16x4*)(sv + row * 64 + swz(row, 2 * s2 + 1) * 8 + 4 * hh);
                    bf16x8 va = {lo[0], lo[1], lo[2], lo[3], hi[0], hi[1], hi[2], hi[3]};
                    if (i == 0) o0 = mfma32(va, pb, o0); else o1 = mfma32(va, pb, o1);
                }
            }
            glds_wait();
            __syncthreads();
        }
        lrun += shfl_xor_f(lrun, 32);
        float inv = 1.f / lrun;
        int b = bh >> 3, hd = bh & 7; size_t row = (size_t)b * T + t0 + wid * 32 + cl;
#pragma unroll
        for (int i = 0; i < 2; ++i)
#pragma unroll
            for (int g = 0; g < 4; ++g) {
                const f32x16& ox = i ? o1 : o0; int dv = i * 32 + 8 * g + 4 * hh;
                *(u32x2*)(yb + row * 1024 + 512 + hd * 64 + dv) = (u32x2){pack2(ox[4 * g] * inv, ox[4 * g + 1] * inv), pack2(ox[4 * g + 2] * inv, ox[4 * g + 3] * inv)};
            }
    }
    (void)NQT;
}

template <int MODE>
DEV void phase_attn_probe(const Params& p, int layer, int bid, int nb, char* smem) {
    const int tid = get_tid(), lane = tid & 63, wid = tid >> 6, cl = lane & 31, hh = lane >> 5;
    const bool need_ctx = layer == 0;
    const bf16_t* Qg = (const bf16_t*)(p.ws + OFF_QKV); const bf16_t* Kg = Qg + (size_t)BATCH * 8 * T * 96; const bf16_t* Vt = Kg + (size_t)BATCH * 8 * T * 96;
    bf16_t* yb = (bf16_t*)(p.ws + OFF_H);
    constexpr int KA = 64 * 128, KB = 64 * 64, VB = 64 * 128, STG = KA + KB + VB;
    constexpr int NQT = T / 128;
    const int nlat = SEQ / 128, nctx = need_ctx ? CTXL / 128 : 0; const int per_bh = nlat + nctx;
    const int nlat_items = BATCH * 8 * nlat, nctx_items = BATCH * 8 * nctx;
    const bool xcd_ok = (nb % 8 == 0) && ((BATCH * 8) % 8 == 0);
    const int lat_first = xcd_ok ? (bid >> 3) : bid, lat_stride = xcd_ok ? (nb >> 3) : nb, lat_cnt = xcd_ok ? nlat_items / 8 : nlat_items;
    const int my_lat = lat_first < lat_cnt ? (lat_cnt - lat_first + lat_stride - 1) / lat_stride : 0;
    const int my_ctx = bid < nctx_items ? (nctx_items - bid + nb - 1) / nb : 0;
    for (int wi = 0; wi < my_lat + my_ctx; ++wi) {
        int bh, qt;
        if (wi < my_lat) { int idx = lat_first + wi * lat_stride; int bhl = idx / nlat; qt = CTXL / 128 + idx % nlat; bh = xcd_ok ? bhl * 8 + (bid & 7) : bhl; }
        else { int u = bid + (wi - my_lat) * nb; bh = u / nctx; qt = u % nctx; }
        int t0 = qt * 128; const bool islat = t0 >= CTXL;
        const int nkeys = islat ? T : CTXL; const int nkt = nkeys / 64;
        const bf16_t* Kb_ = Kg + (size_t)bh * T * 96; const bf16_t* Vb_ = Vt + (size_t)bh * 64 * T;
        bf16x8 qf[6];
        { const bf16_t* q = Qg + ((size_t)bh * T + t0 + wid * 32 + cl) * 96 + hh * 8;
#pragma unroll
          for (int s2 = 0; s2 < 6; ++s2) qf[s2] = *(const bf16x8*)(q + s2 * 16); }
        f32x16 o0, o1;
#pragma unroll
        for (int r = 0; r < 16; ++r) { o0[r] = 0.f; o1[r] = 0.f; }
        float mrun = -1e30f, lrun = 0.f;
        auto stage_load = [&](int buf, int kt) {
            bf16_t* ska = (bf16_t*)(smem + buf * STG); bf16_t* skb = (bf16_t*)(smem + buf * STG + KA); bf16_t* sv = (bf16_t*)(smem + buf * STG + KA + KB);
#pragma unroll
            for (int i = 0; i < 2; ++i) { int row = (i * 4 + wid) * 8 + (lane >> 3); glds16(Kb_ + (size_t)(kt * 64 + row) * 96 + swz(row, lane & 7) * 8, ska + (i * 4 + wid) * 512 + lane * 8); }
            { int row = wid * 16 + (lane >> 2); glds16(Kb_ + (size_t)(kt * 64 + row) * 96 + 64 + swz4(row, lane & 3) * 8, skb + wid * 512 + lane * 8); }
#pragma unroll
            for (int i = 0; i < 2; ++i) { int row = (i * 4 + wid) * 8 + (lane >> 3); glds16(Vb_ + (size_t)row * T + kt * 64 + swz(row, lane & 7) * 8, sv + (i * 4 + wid) * 512 + lane * 8); }
        };
        __syncthreads();
        stage_load(0, 0);
        glds_wait();
        __syncthreads();
        for (int kt = 0; kt < nkt; ++kt) {
            if (MODE != 2 && kt + 1 < nkt) stage_load((kt + 1) & 1, kt + 1);
            const bf16_t* ska = (const bf16_t*)(smem + (kt & 1) * STG); const bf16_t* skb = (const bf16_t*)(smem + (kt & 1) * STG + KA); const bf16_t* sv = (const bf16_t*)(smem + (kt & 1) * STG + KA + KB);
            f32x16 s0, s1;
#pragma unroll
            for (int r = 0; r < 16; ++r) { s0[r] = 0.f; s1[r] = 0.f; }
#pragma unroll
            for (int s2 = 0; s2 < 4; ++s2) {
                int c = s2 * 2 + hh;
                bf16x8 k0 = *(const bf16x8*)(ska + cl * 64 + swz(cl, c) * 8), k1 = *(const bf16x8*)(ska + (32 + cl) * 64 + swz(32 + cl, c) * 8);
                s0 = mfma32(k0, qf[s2], s0); s1 = mfma32(k1, qf[s2], s1);
            }
#pragma unroll
            for (int s2 = 4; s2 < 6; ++s2) {
                int c = (s2 - 4) * 2 + hh;
                bf16x8 k0 = *(const bf16x8*)(skb + cl * 32 + swz4(cl, c) * 8), k1 = *(const bf16x8*)(skb + (32 + cl) * 32 + swz4(32 + cl, c) * 8);
                s0 = mfma32(k0, qf[s2], s0); s1 = mfma32(k1, qf[s2], s1);
            }
            float mx = -1e30f;
            if (MODE != 1)
#pragma unroll
            for (int r = 0; r < 16; ++r) mx = fmaxf(mx, fmaxf(s0[r], s1[r]));
            mx = fmaxf(mx, shfl_xor_f(mx, 32));
            if (!wave_all(mx <= mrun + 8.f)) {
                float mnew = fmaxf(mrun, mx), alpha = fast_exp2(mrun - mnew); mrun = mnew; lrun *= alpha;
#pragma unroll
                for (int r = 0; r < 16; ++r) { o0[r] *= alpha; o1[r] *= alpha; }
            }
            float ls = 0.f;
            if (MODE != 1)
#pragma unroll
            for (int r = 0; r < 16; ++r) { s0[r] = fast_exp2(s0[r] - mrun); s1[r] = fast_exp2(s1[r] - mrun); ls += s0[r] + s1[r]; }
            lrun += ls;
#pragma unroll
            for (int s2 = 0; s2 < 4; ++s2) {
                const f32x16& sx = (s2 < 2) ? s0 : s1; int rbase = (s2 & 1) * 8;
                bf16x8 pb;
#pragma unroll
                for (int j = 0; j < 8; ++j) pb[j] = (short)f2bf(sx[rbase + j]);
#pragma unroll
                for (int i = 0; i < 2; ++i) {
                    int row = i * 32 + cl;
                    bf16x4 lo = *(const bf16x4*)(sv + row * 64 + swz(row, 2 * s2) * 8 + 4 * hh), hi = *(const bf16x4*)(sv + row * 64 + swz(row, 2 * s2 + 1) * 8 + 4 * hh);
                    bf16x8 va = {lo[0], lo[1], lo[2], lo[3], hi[0], hi[1], hi[2], hi[3]};
                    if (i == 0) o0 = mfma32(va, pb, o0); else o1 = mfma32(va, pb, o1);
                }
            }
            glds_wait();
            __syncthreads();
        }
        lrun += shfl_xor_f(lrun, 32);
        float inv = 1.f / lrun;
        int b = bh >> 3, hd = bh & 7; size_t row = (size_t)b * T + t0 + wid * 32 + cl;
#pragma unroll
        for (int i = 0; i < 2; ++i)
#pragma unroll
            for (int g = 0; g < 4; ++g) {
                const f32x16& ox = i ? o1 : o0; int dv = i * 32 + 8 * g + 4 * hh;
                *(u32x2*)(yb + row * 1024 + 512 + hd * 64 + dv) = (u32x2){pack2(ox[4 * g] * inv, ox[4 * g + 1] * inv), pack2(ox[4 * g + 2] * inv, ox[4 * g + 3] * inv)};
            }
    }
    (void)NQT;
}

DEV void phase_merge(const Params& p, int layer, int bid, int nb) {
    const int tid = get_tid(), lane = tid & 63, wid = tid >> 6, hl = lane & 31;
    const bool need_ctx = layer == 0;
    const bf16_t* so = (const bf16_t*)(p.ws + OFF_H); const bf16_t* projb = (const bf16_t*)(p.ws + OFF_PB);
    bf16_t* y = (bf16_t*)(p.ws + OFF_PF);
    for (int r2 = bid * 4 + wid; r2 < R / 2; r2 += nb * 4) {
        const int r = r2 * 2 + (lane >> 5);
        if (!need_ctx && (r % T) < CTXL) continue;
        const bool isml = hl < 16; const int cc = (hl * 16) & 255;
        const bf16_t* a0 = so + ((size_t)(isml ? 0 : 2) * R + r) * 256 + cc; const bf16_t* a1 = so + ((size_t)(isml ? 1 : 3) * R + r) * 256 + cc;
        u32x4 x0 = *(const u32x4*)a0, x1 = *(const u32x4*)(a0 + 8), y0 = *(const u32x4*)a1, y1 = *(const u32x4*)(a1 + 8);
        float v[16]; float ss = 0.f;
#pragma unroll
        for (int i = 0; i < 16; ++i) {
            unsigned wa = (i < 8 ? x0 : x1)[(i & 7) >> 1], wb = (i < 8 ? y0 : y1)[(i & 7) >> 1];
            v[i] = bf2f((bf16_t)((i & 1) ? wa >> 16 : wa & 0xffff)) + bf2f((bf16_t)((i & 1) ? wb >> 16 : wb & 0xffff)); ss += v[i] * v[i];
        }
        ss += shfl_xor_f(ss, 1); ss += shfl_xor_f(ss, 2);
        const bf16_t* gt = projb + (size_t)r * PBW + (isml ? PB_MLOG : PB_HGOG) + cc;
        const float* g = (isml ? p.ml_norm_g : p.hg_norm_g) + layer * 256 + cc;
        float rn = rsqrtf(ss * (1.f / 64.f) + EPS);
        u32x4 g0 = *(const u32x4*)gt, g1 = *(const u32x4*)(gt + 8);
        unsigned outw[8];
#pragma unroll
        for (int i = 0; i < 16; i += 2) {
            unsigned gw = (i < 8 ? g0 : g1)[(i & 7) >> 1];
            float ga = bf2f((bf16_t)(gw & 0xffff)), gb = bf2f((bf16_t)(gw >> 16));
            float a = v[i] * rn * g[i] * (isml ? sigmoidf_(ga) : siluf_(ga)), bb = v[i + 1] * rn * g[i + 1] * (isml ? sigmoidf_(gb) : siluf_(gb));
            outw[i >> 1] = pack2(a, bb);
        }
        u32x4* d = (u32x4*)(y + (size_t)r * D + hl * 16);
        d[0] = (u32x4){outw[0], outw[1], outw[2], outw[3]}; d[1] = (u32x4){outw[4], outw[5], outw[6], outw[7]};
    }
}

DEV void phase_outproj(const Params& p, int layer, int bid, int nb, char* smem) {
    const bool need_ctx = layer == 0;
    const bf16_t* y = (const bf16_t*)(p.ws + OFF_PF); const bf16_t* W = (const bf16_t*)(p.ws + OFF_WOUT);
    const float* mods = (const float*)(p.ws + OFF_MODS) + (size_t)layer * (BATCH + 1) * 6144;
    const int tid_ = get_tid();
    constexpr int NTN = 8; const int tpb = need_ctx ? T / 128 : SEQ / 128;
    auto row0 = [&](int tm) { int b = tm / tpb, j = tm % tpb; return b * T + (need_ctx ? 0 : CTXL) + j * 128; };
    int tf, te, tstr; xcd_range(bid, nb, BATCH * tpb * NTN, tf, te, tstr);
    gemm_tiles(tf, te, tstr, 1024, smem, (const bf16_t*)(p.ws + OFF_ZERO),
        [&](int t, int which, int row) { int tm, tn; tile_decode(t, BATCH * tpb, NTN, tm, tn); return which ? W + (size_t)(tn * 128 + row) * 1024 : y + (size_t)(row0(tm) + row) * D; },
        [&](int t, f32x16 (&acc)[2][2]) {
            int tm_, tn_; tile_decode(t, BATCH * tpb, NTN, tm_, tn_);
            const int r0 = row0(tm_), n0 = tn_ * 128; const int b = r0 / T, t0 = r0 % T; const bool islat = t0 >= CTXL;
            const float* g1 = mods + (size_t)(islat ? b : BATCH) * 6144 + 2 * 1024 + n0;
            epi_f32_halves(acc, smem, tid_, [&](int row, int c, f32x4 a) {
                int tt = t0 + row; f32x4 g = *(const f32x4*)(g1 + c * 4);
                if (islat) { size_t o = ((size_t)b * SEQ + (tt - CTXL)) * D + n0 + c * 4; f32x4 xv = *(const f32x4*)((layer == 0 ? p.x : p.out) + o); *(f32x4*)(p.out + o) = xv + g * a; }
                else { size_t o = ((size_t)b * CTXL + tt) * D + n0 + c * 4; float* cx = (float*)(p.ws + OFF_CX); *(f32x4*)(cx + o) = *(const f32x4*)(p.ctx + o) + g * a; }
            });
        });
}

DEV void phase_router(const Params& p, int layer, int bid, int nb, char* smem) {
    const bool need_ctx = layer == 0;
    const bf16_t* h2 = (const bf16_t*)(p.ws + OFF_H); const bf16_t* WR = (const bf16_t*)(p.ws + OFF_WR);
    float* aff = (float*)(p.ws + OFF_AFF);
    const int tid_ = get_tid(); const int lane = tid_ & 63, wid = tid_ >> 6;
    constexpr int NTM = R / 128;
    for (int it = bid; it < NTM; it += nb) {
        int r0 = it * 128; if (!need_ctx && (r0 % T) < CTXL) continue;
        f32x16 acc[1][1];
        gemm_mainloop<4, 1, 1, 1>(acc, [&](int i) { return h2 + (size_t)(r0 + i) * D; }, [&](int j) { return WR + (size_t)j * 1024; }, 1024, smem, (const bf16_t*)(p.ws + OFF_ZERO));
        const int cl = lane & 31;
#pragma unroll
        for (int r = 0; r < 16; ++r) {
            float v = cl < 16 ? acc[0][0][r] : -1e30f; float mx = v;
#pragma unroll
            for (int m = 1; m < 16; m <<= 1) mx = fmaxf(mx, shfl_xor_f(mx, m));
            float e = cl < 16 ? __expf(v - mx) : 0.f; float s = e;
#pragma unroll
            for (int m = 1; m < 16; m <<= 1) s += shfl_xor_f(s, m);
            if (cl < 16) aff[(size_t)(r0 + wid * 32 + crow(r, lane)) * 16 + cl] = e / s;
        }
    }
}

#ifdef EMU
DEV unsigned shfl_up_u(unsigned v, int d) { int l = emu::cur->lane; return emu::shfl_u32(v, l >= d ? l - d : l); }
DEV unsigned shfl_idx_u(unsigned v, int src) { return emu::shfl_u32(v, src); }
#else
DEV unsigned shfl_up_u(unsigned v, int d) { return __shfl_up(v, d); }
DEV unsigned shfl_idx_u(unsigned v, int src) { return __shfl(v, src); }
#endif
DEV void phase_topk(const Params& p, int layer, int bid, int nb, char* smem) {
    const bool need_ctx = layer == 0; const int tid = get_tid(); const int lane = tid & 63, wid = tid >> 6;
    const float* aff = (const float*)(p.ws + OFF_AFF);
    int* selr = (int*)(p.ws + OFF_SELR); float* selg = (float*)(p.ws + OFF_SELG); int* inv = (int*)(p.ws + OFF_INV); float* invg = (float*)(p.ws + OFF_INVG);
    unsigned* keys = (unsigned*)smem;
    unsigned* hist = keys + 2048;
    unsigned* sh = hist + 256;
    const int capT = need_ctx ? CAP_L + CAP_C : CAP_L;
    const int nitems = BATCH * NEXP * 2;
    for (int it = bid; it < nitems; it += nb) {
        int seg = it & 1, e = (it >> 1) % NEXP, b = (it >> 1) / NEXP;
        if (seg == 1 && !need_ctx) continue;
        const int n = seg ? CTXL : SEQ, cap = seg ? CAP_C : CAP_L; const int rbase = b * T + (seg ? 0 : CTXL);
        __syncthreads();
        {
            static_assert(SEQ <= 8 * NTHR && CTXL <= 8 * NTHR, "key batch");
            float kv[8];
#pragma unroll
            for (int q = 0; q < 8; ++q) { int i = tid + q * NTHR; kv[q] = i < n ? aff[(size_t)(rbase + i) * 16 + e] : 0.f; }
#pragma unroll
            for (int q = 0; q < 8; ++q) { int i = tid + q * NTHR; if (i < n) keys[i] = __builtin_bit_cast(unsigned, kv[q]); }
        }
        if (tid == 0) { sh[0] = 0u; sh[1] = (unsigned)cap; }
        for (int pass = 0; pass < 4; ++pass) {
            const int shift = 24 - 8 * pass;
            hist[tid] = 0u;
            __syncthreads();
            const unsigned prefix = sh[0], kneed = sh[1];
            const unsigned hmask = pass == 0 ? 0u : (0xffffffffu << (shift + 8));
            for (int i = tid; i < n; i += NTHR) { unsigned k = keys[i]; if ((k & hmask) == prefix) atomicAdd(&hist[(k >> shift) & 255u], 1u); }
            __syncthreads();
            if (wid == 0) {
                unsigned h0 = hist[4 * lane], h1 = hist[4 * lane + 1], h2 = hist[4 * lane + 2], h3 = hist[4 * lane + 3];
                unsigned tot = h0 + h1 + h2 + h3;
                unsigned incl = tot;
#pragma unroll
                for (int d = 1; d < 64; d <<= 1) { unsigned o = shfl_idx_u(incl, lane + d < 64 ? lane + d : lane); if (lane + d < 64) incl += o; }
                unsigned above = incl - tot;
                unsigned c3 = above, c2 = c3 + h3, c1 = c2 + h2, c0 = c1 + h1;
                if (c3 < kneed && kneed <= c3 + h3) { sh[0] = prefix | ((unsigned)(4 * lane + 3) << shift); sh[1] = kneed - c3; }
                else if (c2 < kneed && kneed <= c2 + h2) { sh[0] = prefix | ((unsigned)(4 * lane + 2) << shift); sh[1] = kneed - c2; }
                else if (c1 < kneed && kneed <= c1 + h1) { sh[0] = prefix | ((unsigned)(4 * lane + 1) << shift); sh[1] = kneed - c1; }
                else if (c0 < kneed && kneed <= c0 + h0) { sh[0] = prefix | ((unsigned)(4 * lane) << shift); sh[1] = kneed - c0; }
            }
            __syncthreads();
        }
        const unsigned tau = sh[0], keq = sh[1];
        const int per = (n + NTHR - 1) / NTHR; const int i0 = tid * per;
        unsigned cg = 0, ce = 0;
        for (int q = 0; q < per && i0 + q < n; ++q) { unsigned k = keys[i0 + q]; cg += k > tau ? 1u : 0u; ce += k == tau ? 1u : 0u; }
        unsigned packed = cg | (ce << 16), incl = packed;
#pragma unroll
        for (int d = 1; d < 64; d <<= 1) { unsigned o = shfl_up_u(incl, d); if (lane >= d) incl += o; }
        if (lane == 63) sh[8 + wid] = incl;
        __syncthreads();
        unsigned base = 0;
        for (int w = 0; w < wid; ++w) base += sh[8 + w];
        unsigned excl = base + incl - packed; unsigned gb = excl & 0xffffu, eb = excl >> 16;
        for (int q = 0; q < per && i0 + q < n; ++q) {
            unsigned k = keys[i0 + q]; bool g = k > tau, eq = k == tau; int mslot = -1;
            if (g || (eq && eb < keq)) {
                mslot = b * capT + (seg ? CAP_L : 0) + (int)(gb + (eb < keq ? eb : keq));
                selr[e * ME_MAX + mslot] = rbase + i0 + q; selg[e * ME_MAX + mslot] = __builtin_bit_cast(float, k);
            }
            inv[(size_t)e * R + rbase + i0 + q] = mslot; invg[(size_t)e * R + rbase + i0 + q] = __builtin_bit_cast(float, k);
            gb += g ? 1u : 0u; eb += eq ? 1u : 0u;
        }
    }
}

DEV void phase_gateup(const Params& p, int layer, int bid, int nb, char* smem) {
    const bool need_ctx = layer == 0; const int Me = BATCH * (need_ctx ? CAP_L + CAP_C : CAP_L);
    const bf16_t* h2 = (const bf16_t*)(p.ws + OFF_H); const bf16_t* WGU = (const bf16_t*)(p.ws + OFF_WGU);
    const int* selr = (const int*)(p.ws + OFF_SELR);
    bf16_t* hid = (bf16_t*)(p.ws + OFF_PB);
    const int tid_ = get_tid(); const int lane = tid_ & 63, wid = tid_ >> 6, wm = wid >> 1, wn = wid & 1;
    const int ntm = (Me + 255) / 256; constexpr int NTN = 16;
    int tf, te, tstr; xcd_range(bid, nb, NEXP * ntm * NTN, tf, te, tstr);
    gemm_tiles256(tf, te, tstr, 1024, smem, (const bf16_t*)(p.ws + OFF_ZERO),
        [&](int t, int which, int row) -> const bf16_t* {
            int e = t / (NTN * ntm), tm_, tn_; tile_decode(t % (NTN * ntm), ntm, NTN, tm_, tn_);
            if (which) return WGU + ((size_t)e * 2048 + tn_ * 128 + row) * 1024;
            int m = tm_ * 256 + row; return m < Me ? h2 + (size_t)selr[e * ME_MAX + m] * D : (const bf16_t*)nullptr; },
        [&](int t, f32x16 (&acc)[4][2], char* stg) {
            int e = t / (NTN * ntm), tm_, tn_; tile_decode(t % (NTN * ntm), ntm, NTN, tm_, tn_); int m0 = tm_ * 256, n0 = tn_ * 128;
            bf16_t* st = (bf16_t*)stg;
#pragma unroll
            for (int q = 0; q < 2; ++q) {
                if (wm == q) {
#pragma unroll
                    for (int i = 0; i < 4; ++i)
#pragma unroll
                        for (int rq = 0; rq < 4; ++rq) {
#pragma unroll
                            for (int r = rq * 4; r < rq * 4 + 4; ++r) { int row = i * 32 + crow(r, lane); { float gx = acc[i][0][r]; st[row * 72 + wn * 32 + (lane & 31)] = f2bf(gx * fast_rcp(1.f + __expf(-gx)) * acc[i][1][r]); } }
                            SCHED_FENCE();
                        }
                }
                lds_barrier();
#pragma unroll
                for (int k = 0; k < 4; ++k) {
                    int id = tid_ + NTHR * k; int row = id >> 3, c = id & 7; int m = m0 + q * 128 + row;
                    if (m < Me) st_nt((u32x4*)(hid + ((size_t)e * Me + m) * 1024 + n0 / 2 + c * 8), *(const u32x4*)(st + row * 72 + c * 8));
                }
                lds_barrier();
            }
        });
}
template <int MODE>
DEV void phase_gateup_probe(const Params& p, int layer, int bid, int nb, char* smem) {
    const bool need_ctx = layer == 0; const int Me = BATCH * (need_ctx ? CAP_L + CAP_C : CAP_L);
    const bf16_t* h2 = (const bf16_t*)(p.ws + OFF_H); const bf16_t* WGU = (const bf16_t*)(p.ws + OFF_WGU);
    const int* selr = (const int*)(p.ws + OFF_SELR);
    const int ntm = (Me + 255) / 256; constexpr int NTN = 16;
    int tf, te, tstr; xcd_range(bid, nb, NEXP * ntm * NTN, tf, te, tstr);
    gemm_tiles256<MODE>(tf, te, tstr, 1024, smem, (const bf16_t*)(p.ws + OFF_ZERO),
        [&](int t, int which, int row) -> const bf16_t* {
            int e = t / (NTN * ntm), tm_, tn_; tile_decode(t % (NTN * ntm), ntm, NTN, tm_, tn_);
            if (which) return WGU + ((size_t)e * 2048 + tn_ * 128 + row) * 1024;
            int m = tm_ * 256 + row; return m < Me ? h2 + (size_t)selr[e * ME_MAX + m] * D : (const bf16_t*)nullptr; },
        [&](int, f32x16 (&acc)[4][2], char*) {
#ifndef EMU
#pragma unroll
            for (int i = 0; i < 4; ++i) asm volatile("" :: "v"(acc[i][0]), "v"(acc[i][1]));
#endif
        });
}
DEV void phase_down(const Params& p, int layer, int bid, int nb, char* smem) {
    const bool need_ctx = layer == 0; const int Me = BATCH * (need_ctx ? CAP_L + CAP_C : CAP_L);
    const bf16_t* hid = (const bf16_t*)(p.ws + OFF_PB); const bf16_t* WD = (const bf16_t*)(p.ws + OFF_WD);
    bf16_t* dres = (bf16_t*)(p.ws + OFF_QKV);
    const int tid_ = get_tid();
    const int ntm = (Me + 255) / 256; constexpr int NTN = 8;
    int tf, te, tstr; xcd_range(bid, nb, NEXP * ntm * NTN, tf, te, tstr);
    gemm_tiles256(tf, te, tstr, 1024, smem, (const bf16_t*)(p.ws + OFF_ZERO),
        [&](int t, int which, int row) -> const bf16_t* {
            int e = t / (NTN * ntm), tm_, tn_; tile_decode(t % (NTN * ntm), ntm, NTN, tm_, tn_);
            if (which) return WD + ((size_t)e * 1024 + tn_ * 128 + row) * 1024;
            int m = tm_ * 256 + row; return m < Me ? hid + ((size_t)e * Me + m) * 1024 : (const bf16_t*)nullptr; },
        [&](int t, f32x16 (&acc)[4][2], char* stg) {
            int e = t / (NTN * ntm), tm_, tn_; tile_decode(t % (NTN * ntm), ntm, NTN, tm_, tn_); int m0 = tm_ * 256, n0 = tn_ * 128;
            epi256_bf16(acc, stg, tid_, [&](float v, int, int) { return v; },
                        [&](int row, int c, u32x4 v) { if (m0 + row < Me) st_nt((u32x4*)(dres + ((size_t)e * Me + m0 + row) * 1024 + n0 + c * 8), v); });
        });
}
#ifdef EMU
DEV unsigned ballot16(bool pred) { unsigned m = 0; for (int e = 0; e < 16; ++e) m |= (emu::shfl_u32(pred ? 1u : 0u, e) & 1u) << e; return m; }
DEV unsigned rdlane_u(unsigned v, int idx) { return emu::shfl_u32(v, idx); }
#else
DEV unsigned ballot16(bool pred) { return (unsigned)(__ballot(pred) & 0xffffull); }
DEV unsigned rdlane_u(unsigned v, int idx) { return (unsigned)__builtin_amdgcn_readlane((int)v, idx); }
#endif
DEV void ffn_sum(const Params& p, int clayer, int r, int lane, f32x4 (&s)[4]) {
    const int Me = BATCH * (clayer == 0 ? CAP_L + CAP_C : CAP_L);
    const bf16_t* dres = (const bf16_t*)(p.ws + OFF_QKV); const int* inv = (const int*)(p.ws + OFF_INV) + r; const float* invg = (const float*)(p.ws + OFF_INVG) + r;
#pragma unroll
    for (int i = 0; i < 4; ++i) s[i] = (f32x4){0.f, 0.f, 0.f, 0.f};
    const int mi = lane < NEXP ? inv[(size_t)lane * R] : -1;
    const float gi = lane < NEXP ? invg[(size_t)lane * R] : 0.f;
    unsigned gu; memcpy(&gu, &gi, 4);
    unsigned mask = ballot16(mi >= 0);
    while (mask) {
        const int e0 = __builtin_ctz(mask); mask &= mask - 1;
        const bool two = mask != 0u; const int e1 = two ? __builtin_ctz(mask) : e0; if (two) mask &= mask - 1;
        const int m0 = (int)rdlane_u((unsigned)mi, e0), m1 = (int)rdlane_u((unsigned)mi, e1);
        unsigned g0u = rdlane_u(gu, e0), g1u = rdlane_u(gu, e1);
        float g0, g1; memcpy(&g0, &g0u, 4); memcpy(&g1, &g1u, 4); if (!two) g1 = 0.f;
        const bf16_t* row0 = dres + ((size_t)e0 * Me + m0) * 1024; const bf16_t* row1 = dres + ((size_t)e1 * Me + m1) * 1024;
        u32x2 w0[4], w1[4];
#pragma unroll
        for (int i = 0; i < 4; ++i) w0[i] = *(const u32x2*)(row0 + i * 256 + lane * 4);
#pragma unroll
        for (int i = 0; i < 4; ++i) w1[i] = *(const u32x2*)(row1 + i * 256 + lane * 4);
#pragma unroll
        for (int i = 0; i < 4; ++i) {
            s[i][0] += g0 * bf2f((bf16_t)(w0[i][0] & 0xffff)); s[i][1] += g0 * bf2f((bf16_t)(w0[i][0] >> 16)); s[i][2] += g0 * bf2f((bf16_t)(w0[i][1] & 0xffff)); s[i][3] += g0 * bf2f((bf16_t)(w0[i][1] >> 16));
            s[i][0] += g1 * bf2f((bf16_t)(w1[i][0] & 0xffff)); s[i][1] += g1 * bf2f((bf16_t)(w1[i][0] >> 16)); s[i][2] += g1 * bf2f((bf16_t)(w1[i][1] & 0xffff)); s[i][3] += g1 * bf2f((bf16_t)(w1[i][1] >> 16));
        }
    }
}
DEV void phase_final(const Params& p, int bid, int nb) {
    const int tid = get_tid(), lane = tid & 63, wid = tid >> 6;
    const float* mods = (const float*)(p.ws + OFF_MODS) + (size_t)1 * (BATCH + 1) * 6144;
    const int W = nb * 4, w = bid * 4 + wid; const bool smaj = W % BATCH == 0;
    const int tstep = smaj ? W / BATCH : 1;
    f32x4 g2v[4]; int cur_b = -1;
    for (int it = smaj ? w / BATCH : w; it < (smaj ? T : R); it += smaj ? tstep : W) {
        const int r = smaj ? (w % BATCH) * T + it : it;
        int b = r / T, t = r % T; if (t < CTXL) continue;
        if (b != cur_b) { cur_b = b; const float* g2 = mods + (size_t)b * 6144 + 5 * 1024;
#pragma unroll
            for (int i = 0; i < 4; ++i) g2v[i] = *(const f32x4*)(g2 + i * 256 + lane * 4); }
        float* xr = p.out + ((size_t)b * SEQ + (t - CTXL)) * D;
        f32x4 sacc[4]; ffn_sum(p, 1, r, lane, sacc);
#pragma unroll
        for (int i = 0; i < 4; ++i) { int c = i * 256 + lane * 4; *(f32x4*)(xr + c) = *(const f32x4*)(xr + c) + g2v[i] * sacc[i]; }
    }
}

constexpr int SMEM_BYTES = 75 * 1024;
__global__ void __launch_bounds__(NTHR, 2) k_prep(Params p) { SMEM_DECL; phase_prep(p, blockIdx.x, gridDim.x, smem); }
__global__ void __launch_bounds__(NTHR, 2) k_convert(Params p, int layer) { SMEM_DECL; phase_convert(p, layer, blockIdx.x, gridDim.x, smem); }
__global__ void __launch_bounds__(NTHR, 2) k_norm(Params p, int layer, int which, int clayer) { phase_norm(p, layer, which, blockIdx.x, gridDim.x, clayer); }
__global__ void __launch_bounds__(NTHR, 2) k_final(Params p) { phase_final(p, blockIdx.x, gridDim.x); }
__global__ void __launch_bounds__(NTHR, 2) k_proj(Params p, int layer) { SMEM_DECL; phase_proj(p, layer, blockIdx.x, gridDim.x, smem); }
__global__ void __launch_bounds__(NTHR, 2) k_scan(Params p, int layer) { SMEM_DECL; phase_scan(p, layer, blockIdx.x, gridDim.x, smem); }
__global__ void __launch_bounds__(NTHR, 2) k_mla(Params p, int layer) { SMEM_DECL; phase_mla(p, layer, blockIdx.x, gridDim.x, smem); }
__global__ void __launch_bounds__(NTHR, 2) k_attn(Params p, int layer) { SMEM_DECL; phase_attn(p, layer, blockIdx.x, gridDim.x, smem); }
__global__ void __launch_bounds__(NTHR, 2) k_merge(Params p, int layer) { phase_merge(p, layer, blockIdx.x, gridDim.x); }
__global__ void __launch_bounds__(NTHR, 2) k_outproj(Params p, int layer) { SMEM_DECL; phase_outproj(p, layer, blockIdx.x, gridDim.x, smem); }
__global__ void __launch_bounds__(NTHR, 2) k_router(Params p, int layer) { SMEM_DECL; phase_router(p, layer, blockIdx.x, gridDim.x, smem); }
__global__ void __launch_bounds__(NTHR, 2) k_topk(Params p, int layer) { SMEM_DECL; phase_topk(p, layer, blockIdx.x, gridDim.x, smem); }
__global__ void __launch_bounds__(NTHR, 2) k_gateup(Params p, int layer) { SMEM_DECL; phase_gateup(p, layer, blockIdx.x, gridDim.x, smem); }
__global__ void __launch_bounds__(NTHR, 2) k_down(Params p, int layer) { SMEM_DECL; phase_down(p, layer, blockIdx.x, gridDim.x, smem); }

#ifdef EMU
#define GRID_SYNC() emu::grid_sync()
#define GRID_SYNC_CG() emu::grid_sync()
#else
#define GRID_SYNC_CG() cooperative_groups::this_grid().sync()
#define XB_TMO      128
#define XB_XCNT(j)  (256  + 64 * (j))
#define XB_XSUB(j)  (1280 + 64 * (j))
#define XB_XGEN(j)  (2304 + 64 * (j))
#define XB_TOP      3328
#define XB_TOPGEN   3392
#define XCD_BAR_WORDS 3456
#define XB_SPIN_CAP (1u << 22)
DEV unsigned xb_ld(unsigned* p) { return __hip_atomic_load(p, __ATOMIC_RELAXED, __HIP_MEMORY_SCOPE_AGENT); }
DEV unsigned xb_add(unsigned* p, unsigned v) { return __hip_atomic_fetch_add(p, v, __ATOMIC_RELAXED, __HIP_MEMORY_SCOPE_AGENT); }
DEV unsigned xb_xcc_id() { return (unsigned)__builtin_amdgcn_s_getreg((3 << 11) | 20) & 0xFu; }
#define XB_SPIN(cond, bar) do { unsigned _sp = 0; while (cond) { __builtin_amdgcn_s_sleep(1); \
    if ((++_sp & 255u) == 0u) { if (xb_ld(&(bar)[XB_TMO])) break; if (_sp > XB_SPIN_CAP) { atomicAdd(&(bar)[XB_TMO], 1u); break; } } } } while (0)
struct XcdBarrier { unsigned* bar; unsigned x; volatile unsigned* st; };
DEV XcdBarrier xcd_barrier_post(unsigned* bar, volatile unsigned* st) {
    XcdBarrier b; b.bar = bar; b.x = xb_xcc_id(); b.st = st;
    if (threadIdx.x == 0) (void)xb_add(&bar[XB_XCNT(b.x)], 1u);
    return b;
}
DEV void xcd_barrier_complete(unsigned* bar, unsigned x, unsigned& nloc, unsigned& nx) {
    const unsigned G = gridDim.x;
    unsigned sum, cnt, mine, sp = 0u;
    for (;;) {
        sum = 0u; cnt = 0u; mine = 0u;
#pragma unroll
        for (unsigned j = 0; j < 16; ++j) { const unsigned c = xb_ld(&bar[XB_XCNT(j)]); sum += c; cnt += (c > 0u) ? 1u : 0u; mine = (j == x) ? c : mine; }
        if (sum == G) break;
        __builtin_amdgcn_s_sleep(1);
        if ((++sp & 255u) == 0u) { if (xb_ld(&bar[XB_TMO])) break; if (sp > XB_SPIN_CAP) { atomicAdd(&bar[XB_TMO], 1u); break; } }
    }
    nloc = mine > 0u ? mine : 1u; nx = cnt > 0u ? cnt : 1u;
}
DEV void xcd_barrier(const XcdBarrier& b) {
    asm volatile("s_waitcnt vmcnt(0)" ::: "memory");
    __syncthreads();
    if (threadIdx.x == 0) {
        unsigned* bar = b.bar;
        __builtin_amdgcn_s_waitcnt(0);
        unsigned nloc = b.st[0], nx = b.st[1];
        if (nloc == 0u) { xcd_barrier_complete(bar, b.x, nloc, nx); b.st[0] = nloc; b.st[1] = nx; }
        const unsigned old = xb_add(&bar[XB_XSUB(b.x)], 1u);
        const unsigned gen = old / nloc;
        if (old + 1u == (gen + 1u) * nloc) {
            __builtin_amdgcn_fence(__ATOMIC_RELEASE, "agent");
            asm volatile("s_waitcnt vmcnt(0)" ::: "memory");
            const unsigned og = xb_add(&bar[XB_TOP], 1u);
            const unsigned tg = og / nx;
            if (og + 1u == (tg + 1u) * nx) xb_add(&bar[XB_TOPGEN], 1u);
            else XB_SPIN(xb_ld(&bar[XB_TOPGEN]) == tg, bar);
            __builtin_amdgcn_fence(__ATOMIC_ACQUIRE, "agent");
            xb_add(&bar[XB_XGEN(b.x)], 1u);
            asm volatile("s_waitcnt vmcnt(0)" ::: "memory");
        } else {
            XB_SPIN(xb_ld(&bar[XB_XGEN(b.x)]) == gen, bar);
            __builtin_amdgcn_fence(__ATOMIC_ACQUIRE, "agent");
            asm volatile("s_waitcnt vmcnt(0)" ::: "memory");
        }
    }
    __syncthreads();
}
#define GRID_SYNC() xcd_barrier(xb)
#endif
DEV void phase_scan_mla(const Params& p, int layer, int bid, int nb, char* smem) {
    const int nchains = BATCH * 4 * 2 * 2;
    int nscan = nb / 2 < nchains ? nb / 2 : nchains; if (nscan < 1) nscan = 1;
    if (nb - nscan < 1) { phase_scan(p, layer, bid, nb, smem); phase_mla(p, layer, bid, nb, smem); return; }
    if (bid < nscan) phase_scan(p, layer, bid, nscan, smem); else phase_mla(p, layer, bid - nscan, nb - nscan, smem);
}
__global__ void __launch_bounds__(NTHR, 2) k_mega(Params p) {
    SMEM_DECL;
    const int bid = blockIdx.x, nb = gridDim.x;
#ifndef EMU
    volatile unsigned* xb_st = (volatile unsigned*)(smem + SMEM_BYTES - 16);
    if (threadIdx.x == 0) { xb_st[0] = 0u; xb_st[1] = 0u; }
    __syncthreads();
    XcdBarrier xb = xcd_barrier_post((unsigned*)(p.ws + OFF_BAR), xb_st);
#endif
    phase_prep(p, bid, nb, smem);
    if (PROBE == 30) { __syncthreads(); phase_prep(p, bid, nb, smem); __syncthreads(); phase_prep(p, bid, nb, smem); }
#pragma nounroll
    for (int l = 0; l < 2; ++l) {
        if (l == 0) { phase_convert(p, l, bid, nb, smem, 1); GRID_SYNC_CG(); }
        phase_norm(p, l, 0, bid, nb, l - 1);
        GRID_SYNC();
        if (PROBE == 1) { phase_convert(p, l, bid, nb, smem); phase_norm(p, l, 0, bid, nb); GRID_SYNC(); }
        phase_proj(p, l, bid, nb, smem);
        phase_convert(p, l, bid, nb, smem, 2, (unsigned*)(p.ws + OFF_QCTR) + 16 * l);
        GRID_SYNC();
        if (PROBE == 2) { phase_proj(p, l, bid, nb, smem); GRID_SYNC(); }
        {
            const int nchains = BATCH * 4 * 2 * 2;
            if (nb >= 2 * nchains) {
                if (bid < nchains) phase_scan(p, l, bid, nchains, smem); else phase_mla(p, l, bid - nchains, nb - nchains, smem);
                phase_convert(p, l, bid, nb, smem, 2, (unsigned*)(p.ws + OFF_QCTR) + 16 * l);
            } else {
                phase_scan(p, l, bid, nb, smem); phase_convert(p, l, bid, nb, smem, 2, (unsigned*)(p.ws + OFF_QCTR) + 16 * l);
                GRID_SYNC();
                phase_mla(p, l, bid, nb, smem);
            }
        }
        GRID_SYNC();
        if (PROBE == 3) { phase_scan(p, l, bid, nb, smem); GRID_SYNC(); }
        if (PROBE == 17) { const int nchains = BATCH * 4 * 2 * 2; if (bid < nchains) phase_scan(p, l, bid, nchains, smem); else phase_convert(p, l, bid - nchains, nb - nchains, smem, 2); GRID_SYNC(); }
        if (PROBE == 18) { const int nchains = BATCH * 4 * 2 * 2; if (bid >= nchains) phase_convert(p, l, bid - nchains, nb - nchains, smem, 2); GRID_SYNC(); }
        if (PROBE == 14) { phase_scan_probe<0>(p, l, bid, nb, smem); GRID_SYNC(); }
        if (PROBE == 15) { phase_scan_probe<1>(p, l, bid, nb, smem); GRID_SYNC(); }
        if (PROBE == 16) { phase_scan_probe<2>(p, l, bid, nb, smem); GRID_SYNC(); }
        if (PROBE == 8) { phase_mla(p, l, bid, nb, smem); GRID_SYNC(); }
        {
            if (blockIdx.x >= gridDim.x / 2) phase_merge(p, l, bid, nb);
            phase_attn(p, l, bid, nb, smem);
            if (blockIdx.x < gridDim.x / 2) phase_merge(p, l, bid, nb);
        }
        GRID_SYNC();
        if (PROBE == 4) { phase_attn(p, l, bid, nb, smem); GRID_SYNC(); }
        if (PROBE == 19) { phase_attn_probe<0>(p, l, bid, nb, smem); GRID_SYNC(); }
        if (PROBE == 20) { phase_attn_probe<1>(p, l, bid, nb, smem); GRID_SYNC(); }
        if (PROBE == 21) { phase_attn_probe<2>(p, l, bid, nb, smem); GRID_SYNC(); }
        phase_outproj(p, l, bid, nb, smem);
        GRID_SYNC();
        phase_norm(p, l, 1, bid, nb);
        GRID_SYNC();
        phase_router(p, l, bid, nb, smem);
        GRID_SYNC();
        phase_topk(p, l, bid, nb, smem);
        GRID_SYNC();
        if (PROBE == 5) { phase_norm(p, l, 1, bid, nb); GRID_SYNC(); phase_router(p, l, bid, nb, smem); GRID_SYNC(); phase_topk(p, l, bid, nb, smem); GRID_SYNC(); }
        phase_gateup(p, l, bid, nb, smem);
        GRID_SYNC();
        if (PROBE == 6) { phase_gateup(p, l, bid, nb, smem); GRID_SYNC(); }
        if (PROBE == 11) { phase_gateup_probe<1>(p, l, bid, nb, smem); GRID_SYNC(); }
        if (PROBE == 12) { phase_gateup_probe<2>(p, l, bid, nb, smem); GRID_SYNC(); }
        if (PROBE == 13) { phase_gateup_probe<0>(p, l, bid, nb, smem); GRID_SYNC(); }
        if (PROBE == 7) { for (int q = 0; q < 10; ++q) GRID_SYNC(); }
        phase_down(p, l, bid, nb, smem);
        if (l == 0) phase_convert(p, 1, bid, nb, smem, 1, (unsigned*)(p.ws + OFF_QCTR) + 32);
        GRID_SYNC();
        if (PROBE == 10) { phase_down(p, l, bid, nb, smem); GRID_SYNC(); }
    }
    phase_final(p, bid, nb);
}

#ifdef EMU
void emu_dump(const char* name, const void* ptr, size_t bytes);
#define DUMP(name, off, bytes) emu_dump(name, p.ws + (off), bytes)
#else
#define DUMP(name, off, bytes)
#endif

extern "C" void kernel_launch(void* const* d_in, const int* in_sizes, int n_in, void* d_out, int out_size, void* d_ws, size_t ws_size, hipStream_t stream) {
    Params p{};
    const float** f = (const float**)&p;
    for (int i = 0; i < 26; ++i) f[i] = (const float*)d_in[i];
    p.out = (float*)d_out; p.ws = (char*)d_ws;
    if (ws_size < WS_TOTAL) { fprintf(stderr, "workspace too small: %zu < %zu\n", ws_size, (size_t)WS_TOTAL); return; }
#ifdef EMU
    if (getenv("EMU_MEGA")) { memset(p.ws + OFF_BAR, 0, 16384 + 256); emu::launch(dim3(getenv("EMU_NB") ? atoi(getenv("EMU_NB")) : 16), dim3(NTHR), SMEM_BYTES, true, [=]() { k_mega(p); }); return; }
#endif
#if !defined(MULTI_LAUNCH) && !defined(EMU)
    static int grid_blocks = 0;
    if (!grid_blocks) {
        int dev = 0, cus = 0, per_cu = 0;
        (void)hipGetDevice(&dev);
        (void)hipDeviceGetAttribute(&cus, hipDeviceAttributeMultiprocessorCount, dev);
        (void)hipFuncSetAttribute((const void*)k_mega, hipFuncAttributeMaxDynamicSharedMemorySize, SMEM_BYTES);
        (void)hipOccupancyMaxActiveBlocksPerMultiprocessor(&per_cu, k_mega, NTHR, SMEM_BYTES);
        if (per_cu > 2) per_cu = 2;
        if (per_cu < 1) per_cu = 1;
        grid_blocks = cus * per_cu;
    }
    (void)hipMemsetAsync(p.ws + OFF_BAR, 0, 16384 + 256, stream);
    void* args[] = {(void*)&p};
    hipError_t e = hipLaunchCooperativeKernel((const void*)k_mega, dim3(grid_blocks), dim3(NTHR), args, SMEM_BYTES, stream);
    if (e != hipSuccess) fprintf(stderr, "cooperative launch failed: %s (grid %d)\n", hipGetErrorString(e), grid_blocks);
#else
    const int G = 512;
#ifndef EMU
    static bool attr_done = false;
    if (!attr_done) {
        attr_done = true;
        const void* ks[] = {(const void*)k_prep, (const void*)k_convert, (const void*)k_proj, (const void*)k_scan, (const void*)k_mla, (const void*)k_attn,
                            (const void*)k_outproj, (const void*)k_router, (const void*)k_topk, (const void*)k_gateup, (const void*)k_down};
        for (const void* k : ks) (void)hipFuncSetAttribute(k, hipFuncAttributeMaxDynamicSharedMemorySize, SMEM_BYTES);
    }
#endif
    LAUNCH(k_prep, 384, SMEM_BYTES, stream, p);
    for (int l = 0; l < 2; ++l) {
        char nm[64];
        LAUNCH(k_convert, G * 2, SMEM_BYTES, stream, p, l);
        LAUNCH(k_norm, G * 2, 0, stream, p, l, 0, l - 1);
        snprintf(nm, 64, "L%d_h", l); DUMP(nm, OFF_H, (size_t)R * 1024 * 2);
        LAUNCH(k_proj, G * 2, SMEM_BYTES, stream, p, l);
        snprintf(nm, 64, "L%d_projb", l); DUMP(nm, OFF_PB, (size_t)R * PBW * 2);
        snprintf(nm, 64, "L%d_pref", l); DUMP(nm, OFF_PF, (size_t)R * 512 * 4);
        snprintf(nm, 64, "L%d_gates", l); DUMP(nm, OFF_GT, (size_t)R * 16 * 4);
        LAUNCH(k_scan, BATCH * 16, SMEM_BYTES, stream, p, l);
        snprintf(nm, 64, "L%d_scan", l); DUMP(nm, OFF_H, (size_t)4 * R * 256 * 2);
        LAUNCH(k_mla, G * 2, SMEM_BYTES, stream, p, l);
        snprintf(nm, 64, "L%d_qkv", l); DUMP(nm, OFF_QKV, 2 * SZ_Q + SZ_V);
        LAUNCH(k_attn, G * 2, SMEM_BYTES, stream, p, l);
        LAUNCH(k_merge, G * 2, 0, stream, p, l);
        snprintf(nm, 64, "L%d_y", l); DUMP(nm, OFF_PF, (size_t)R * 1024 * 2);
        LAUNCH(k_outproj, G * 2, SMEM_BYTES, stream, p, l);
        LAUNCH(k_norm, G * 2, 0, stream, p, l, 1, -1);
        snprintf(nm, 64, "L%d_h2", l); DUMP(nm, OFF_H, (size_t)R * 1024 * 2);
        LAUNCH(k_router, G, SMEM_BYTES, stream, p, l);
        snprintf(nm, 64, "L%d_aff", l); DUMP(nm, OFF_AFF, (size_t)R * 16 * 4);
        LAUNCH(k_topk, BATCH * NEXP * 2, SMEM_BYTES, stream, p, l);
        LAUNCH(k_gateup, G * 2, SMEM_BYTES, stream, p, l);
        LAUNCH(k_down, G * 2, SMEM_BYTES, stream, p, l);
    }
    LAUNCH(k_final, G * 2, 0, stream, p);
#endif
}
```

```cpp
#ifndef EMU
#include <hip/hip_runtime.h>
#include <hip/hip_cooperative_groups.h>
#endif
#include <cstdio>
#include <cstdint>
#include <cmath>

#ifndef PROBE
#define PROBE 0
#endif
#ifndef BATCH
#define BATCH 16
#endif
#ifndef SEQ
#define SEQ 2048
#endif
#ifndef CTXL
#define CTXL 256
#endif

#define DEV __device__ __forceinline__
typedef unsigned short bf16_t;
typedef short bf16x8 __attribute__((ext_vector_type(8)));
typedef short bf16x4 __attribute__((ext_vector_type(4)));
typedef float f32x16 __attribute__((ext_vector_type(16)));
typedef float f32x4 __attribute__((ext_vector_type(4)));
typedef unsigned int u32x4 __attribute__((ext_vector_type(4)));
typedef unsigned int u32x2 __attribute__((ext_vector_type(2)));

constexpr int D = 1024;
constexpr int T = CTXL + SEQ;
constexpr int R = BATCH * T;
constexpr int NTHR = 256;
constexpr int DIN_P = 2816;
constexpr int PBW = 2208;
constexpr int NEXP = 16;
constexpr int CAP_L = SEQ / 8, CAP_C = CTXL / 8;
constexpr int NC = T / 64;
constexpr float EPS = 1e-6f;
constexpr float QSCL = 0.10206207261596577f * 1.4426950408889634f;
constexpr int PB_MLQK = 0, PB_MLV = 512, PB_MLOG = 768, PB_HGQ = 1024, PB_HGV = 1280, PB_HGOG = 1536, PB_CQ = 1792, PB_CKV = 2048, PB_KR = 2176;

constexpr size_t al256(size_t x) { return (x + 255) & ~(size_t)255; }
constexpr size_t SZ_WIN = (size_t)DIN_P * 1024 * 2, SZ_WUQ = 768 * 256 * 2, SZ_WUKV = 1024 * 128 * 2, SZ_WOUT = 1024 * 1024 * 2;
constexpr size_t SZ_WGU = (size_t)NEXP * 2048 * 1024 * 2, SZ_WD = (size_t)NEXP * 1024 * 1024 * 2, SZ_WR = 32 * 1024 * 2;
constexpr size_t OFF_WIN = 0;
constexpr size_t OFF_WUQ = OFF_WIN + SZ_WIN;
constexpr size_t OFF_WUKV = OFF_WUQ + SZ_WUQ;
constexpr size_t OFF_WOUT = OFF_WUKV + SZ_WUKV;
constexpr size_t OFF_WGU = OFF_WOUT + SZ_WOUT;
constexpr size_t OFF_WD = OFF_WGU + SZ_WGU;
constexpr size_t OFF_WR = OFF_WD + SZ_WD;
constexpr size_t OFF_BPERM = OFF_WR + SZ_WR;
constexpr size_t OFF_PB = al256(OFF_BPERM + DIN_P * 4);
constexpr int ME_MAX = BATCH * (CAP_L + CAP_C);
constexpr size_t SZ_PB = ((size_t)R * PBW * 2 > (size_t)NEXP * ME_MAX * 1024 * 2) ? (size_t)R * PBW * 2 : (size_t)NEXP * ME_MAX * 1024 * 2;
constexpr size_t OFF_PF = al256(OFF_PB + SZ_PB);
constexpr size_t OFF_GT = al256(OFF_PF + (size_t)R * 512 * 4);
constexpr size_t OFF_CX = al256(OFF_GT + (size_t)R * 16 * 4);
constexpr size_t OFF_QKV = al256(OFF_CX + (size_t)BATCH * CTXL * D * 4);
constexpr size_t SZ_Q = (size_t)BATCH * 8 * T * 96 * 2, SZ_V = (size_t)BATCH * 8 * T * 64 * 2;
constexpr size_t SZ_QKV = (2 * SZ_Q + SZ_V > (size_t)R * 1024 * 2) ? 2 * SZ_Q + SZ_V : (size_t)R * 1024 * 2;
constexpr size_t OFF_H = al256(OFF_QKV + SZ_QKV);
constexpr size_t OFF_MODS = al256(OFF_H + (size_t)R * 1024 * 2);
constexpr size_t OFF_LB = al256(OFF_MODS + (size_t)2 * (BATCH + 1) * 6144 * 4);
constexpr size_t OFF_ROPE = al256(OFF_LB + 2 * 512 * 4);
constexpr size_t OFF_AFF = al256(OFF_ROPE + (size_t)SEQ * 32 * 4);
constexpr size_t OFF_SELR = al256(OFF_AFF + (size_t)R * 16 * 4);
constexpr size_t OFF_SELG = al256(OFF_SELR + (size_t)NEXP * ME_MAX * 4);
constexpr size_t OFF_INV = al256(OFF_SELG + (size_t)NEXP * ME_MAX * 4);
constexpr size_t OFF_INVG = al256(OFF_INV + (size_t)R * 16 * 4);
constexpr size_t OFF_BAR = al256(OFF_INVG + (size_t)R * 16 * 4);
constexpr size_t OFF_QCTR = OFF_BAR + 16384;
constexpr size_t OFF_ZERO = OFF_BAR + 32768;
constexpr size_t WS_TOTAL = OFF_BAR + 65536;

struct Params {
    const float *x, *c, *ctx, *c_ctx, *ada_w, *ada_b, *norm1_g, *norm2_g, *w_in, *b_in, *ml_conv_w, *ml_conv_b, *ml_norm_g,
        *hg_lb, *hg_norm_g, *mla_q_norm_g, *mla_w_uq, *mla_kv_norm_g, *mla_w_ukv, *mla_q_qk_g, *mla_k_qk_g, *w_out, *router_w,
        *ex_w_gate, *ex_w_up, *ex_w_down;
    float* out;
    char* ws;
};

#ifdef EMU
DEV float bf2f(bf16_t v) { unsigned u = (unsigned)v << 16; float f; memcpy(&f, &u, 4); return f; }
DEV bf16_t f2bf(float x) { unsigned u; memcpy(&u, &x, 4); if ((u & 0x7fffffffu) > 0x7f800000u) return 0x7fc0; u += 0x7fffu + ((u >> 16) & 1u); return (bf16_t)(u >> 16); }
DEV f32x16 mfma32(bf16x8 a, bf16x8 b, f32x16 c) {
    emu::Wave* w = emu::cur->wave; int p = emu::wave_arrive_begin(); int lane = emu::cur->lane;
    for (int j = 0; j < 8; ++j) { w->fa[p][lane][j] = bf2f((bf16_t)a[j]); w->fb[p][lane][j] = bf2f((bf16_t)b[j]); }
    emu::wave_arrive_wait();
    int col = lane & 31, h = lane >> 5;
    for (int r = 0; r < 16; ++r) {
        int row = (r & 3) + 8 * (r >> 2) + 4 * h; float s = c[r];
        for (int k = 0; k < 16; ++k) s += w->fa[p][row + 32 * (k >> 3)][k & 7] * w->fb[p][col + 32 * (k >> 3)][k & 7];
        c[r] = s;
    }
    return c;
}
DEV float shfl_xor_f(float v, int m) { unsigned u; memcpy(&u, &v, 4); u = emu::shfl_u32(u, emu::cur->lane ^ m); float f; memcpy(&f, &u, 4); return f; }
DEV float shfl_idx_f(float v, int src) { unsigned u; memcpy(&u, &v, 4); u = emu::shfl_u32(u, src); float f; memcpy(&f, &u, 4); return f; }
DEV float shfl_up_f(float v, int d) { unsigned u; memcpy(&u, &v, 4); int l = emu::cur->lane; u = emu::shfl_u32(u, l >= d ? l - d : l); float f; memcpy(&f, &u, 4); return f; }
#define LAUNCH(kern, grid, smem, stream, ...) emu::launch(dim3(grid), dim3(NTHR), smem, false, [=]() { kern(__VA_ARGS__); })
#else
DEV float bf2f(bf16_t v) { return __builtin_bit_cast(float, (unsigned)v << 16); }
DEV bf16_t f2bf(float x) { return __builtin_bit_cast(unsigned short, (__bf16)x); }
DEV f32x16 mfma32(bf16x8 a, bf16x8 b, f32x16 c) { return __builtin_amdgcn_mfma_f32_32x32x16_bf16(a, b, c, 0, 0, 0); }
DEV float shfl_xor_f(float v, int m) { return __shfl_xor(v, m); }
DEV float shfl_up_f(float v, int d) { return __shfl_up(v, d); }
DEV float shfl_idx_f(float v, int src) { return __shfl(v, src); }
#define LAUNCH(kern, grid, smem, stream, ...) hipLaunchKernelGGL(kern, dim3(grid), dim3(NTHR), smem, stream, __VA_ARGS__)
#endif
#ifdef EMU
DEV int get_tid() { return threadIdx.x; }
#else
DEV int get_tid() { int t = threadIdx.x; asm volatile("" : "+v"(t)); return t; }
#endif
#ifdef EMU
DEV bf16x4 ds_tr(const bf16_t* a) {
    emu::Wave* w = emu::cur->wave; int p = emu::wave_arrive_begin(); int lane = emu::cur->lane;
    w->pv[p][lane] = a;
    emu::wave_arrive_wait();
    int g = lane & ~15, i = lane & 15; bf16x4 r;
    for (int q = 0; q < 4; ++q) r[q] = (short)((const bf16_t*)w->pv[p][g + 4 * q + (i >> 2)])[i & 3];
    return r;
}
#else
DEV bf16x4 ds_tr(const bf16_t* a) { return __builtin_amdgcn_ds_read_tr16_b64_v4i16((__attribute__((address_space(3))) bf16x4*)a); }
#endif
#ifdef EMU
DEV void glds16(const bf16_t* g, bf16_t* l) {
    emu::Wave* w = emu::cur->wave; int p = emu::wave_arrive_begin(); int lane = emu::cur->lane;
    w->pv[p][lane] = l;
    emu::wave_arrive_wait();
    if ((const char*)l - (const char*)w->pv[p][0] != lane * 16) { fprintf(stderr, "glds16: LDS destination not wave-linear (lane %d)\n", lane); abort(); }
    memcpy(l, g, 16);
}
DEV void glds_wait() {}
#else
DEV void glds16(const bf16_t* g, bf16_t* l) {
    __builtin_amdgcn_global_load_lds((const __attribute__((address_space(1))) void*)g, (__attribute__((address_space(3))) void*)l, 16, 0, 0);
}
DEV void glds_wait() { asm volatile("s_waitcnt vmcnt(0)" ::: "memory"); }
#endif
#ifdef NO_TR
DEV bf16x8 tr_frag(const bf16_t* X, int ldx, int ks, int c0, int lane) {
    const bf16_t* a = X + (16 * ks + 8 * (lane >> 5)) * ldx + c0 + (lane & 31);
    bf16x8 r;
#pragma unroll
    for (int j = 0; j < 8; ++j) r[j] = (short)a[j * ldx];
    return r;
}
#else
DEV bf16x8 tr_frag(const bf16_t* X, int ldx, int ks, int c0, int lane) {
    const bf16_t* a = X + (16 * ks + 8 * (lane >> 5) + ((lane & 15) >> 2)) * ldx + c0 + 16 * ((lane >> 4) & 1) + 4 * (lane & 3);
    bf16x4 lo = ds_tr(a), hi = ds_tr(a + 4 * ldx);
    return (bf16x8){lo[0], lo[1], lo[2], lo[3], hi[0], hi[1], hi[2], hi[3]};
}
#endif
#ifdef EMU
DEV float fast_exp2(float x) { return exp2f(x); }
DEV bool wave_all(bool pred) { unsigned v = pred ? 1u : 0u; for (int m = 1; m < 64; m <<= 1) v &= emu::shfl_u32(v, emu::cur->lane ^ m); return v != 0; }
#else
DEV float fast_exp2(float x) { return __builtin_amdgcn_exp2f(x); }
DEV bool wave_all(bool pred) { return __all(pred); }
#endif
#ifdef EMU
DEV int launder(int v) { return v; }
#else
DEV int launder(int v) { asm volatile("" : "+v"(v)); return v; }
#endif
#ifdef EMU
#define SCHED_FENCE()
#else
#define SCHED_FENCE() __builtin_amdgcn_sched_barrier(0)
#endif
#ifdef EMU
DEV float wave_scan_add(float v, int lane) { for (int d = 1; d < 64; d <<= 1) { float o = shfl_up_f(v, d); if (lane >= d) v += o; } return v; }
DEV float wave_scan_max(float v, int lane) { for (int d = 1; d < 64; d <<= 1) { float o = shfl_up_f(v, d); if (lane >= d) v = fmaxf(v, o); } return v; }
#else
template <int CTRL, int ROWMASK> DEV float dpp_f(float ident, float v) {
    return __builtin_bit_cast(float, __builtin_amdgcn_update_dpp(__builtin_bit_cast(int, ident), __builtin_bit_cast(int, v), CTRL, ROWMASK, 0xf, false));
}
DEV float wave_scan_add(float v, int) {
    v += dpp_f<0x111, 0xf>(0.f, v); v += dpp_f<0x112, 0xf>(0.f, v); v += dpp_f<0x114, 0xf>(0.f, v); v += dpp_f<0x118, 0xf>(0.f, v);
    v += dpp_f<0x142, 0xa>(0.f, v); v += dpp_f<0x143, 0xc>(0.f, v);
    return v;
}
DEV float wave_scan_max(float v, int) {
    const float NI = -3.0e38f;
    v = fmaxf(v, dpp_f<0x111, 0xf>(NI, v)); v = fmaxf(v, dpp_f<0x112, 0xf>(NI, v)); v = fmaxf(v, dpp_f<0x114, 0xf>(NI, v)); v = fmaxf(v, dpp_f<0x118, 0xf>(NI, v));
    v = fmaxf(v, dpp_f<0x142, 0xa>(NI, v)); v = fmaxf(v, dpp_f<0x143, 0xc>(NI, v));
    return v;
}
#endif
#ifdef EMU
DEV void st_nt(u32x4* p, u32x4 v) { *p = v; }
DEV float ld_nt(const float* p) { return *p; }
#else
DEV void st_nt(u32x4* p, u32x4 v) { __builtin_nontemporal_store(v, p); }
DEV float ld_nt(const float* p) { return __builtin_nontemporal_load(p); }
#endif
DEV unsigned pack2(float lo, float hi) { return (unsigned)f2bf(lo) | ((unsigned)f2bf(hi) << 16); }
#ifdef EMU
DEV float fast_rcp(float x) { return 1.f / x; }
#else
DEV float fast_rcp(float x) { return __builtin_amdgcn_rcpf(x); }
#endif
DEV float sigmoidf_(float x) { return fast_rcp(1.f + __expf(-x)); }
DEV float siluf_(float x) { return x * sigmoidf_(x); }
DEV float logsigmoidf_(float x) { return fminf(x, 0.f) - __logf(1.f + __expf(-fabsf(x))); }
#ifdef EMU
#define SMEM_DECL char* smem = emu::cur->blk->smem
#else
#define SMEM_DECL extern __shared__ __attribute__((aligned(16))) char smem[]
#endif

DEV int crow(int r, int lane) { return (r & 3) + 8 * (r >> 2) + 4 * (lane >> 5); }

template <int WGM, int WGN, int TM, int TN> struct GemmCfg {
    static constexpr int BM = WGM * TM * 32, BN = WGN * TN * 32;
    static constexpr int A_BYTES = BM * 128, B_BYTES = BN * 128, STAGE = A_BYTES + B_BYTES, LDS = 2 * STAGE;
};
DEV int swz(int row, int c) { return c ^ ((row >> 1) & 7); }
DEV int swz4(int row, int c) { return c ^ ((row >> 2) & 3); }
template <int WGM, int WGN, int TM, int TN, class ARow, class BRow>
DEV void gemm_mainloop(f32x16 (&acc)[TM][TN], ARow arow, BRow brow, int K, char* smem, const bf16_t* zrow) {
    typedef GemmCfg<WGM, WGN, TM, TN> C;
    constexpr int NA = C::BM / 32, NB = C::BN / 32;
    const int tid = get_tid(), lane = tid & 63, wid = tid >> 6, wm = wid / WGN, wn = wid % WGN;
    const bf16_t* ap[NA]; const bf16_t* bp[NB];
#pragma unroll
    for (int i = 0; i < NA; ++i) { int row = (i * 4 + wid) * 8 + (lane >> 3); const bf16_t* p = arow(row); ap[i] = p ? p + swz(row, lane & 7) * 8 : nullptr; }
#pragma unroll
    for (int i = 0; i < NB; ++i) { int row = (i * 4 + wid) * 8 + (lane >> 3); const bf16_t* p = brow(row); bp[i] = p ? p + swz(row, lane & 7) * 8 : nullptr; }
    auto stage_load = [&](int buf, int k0) {
        bf16_t* sa = (bf16_t*)(smem + buf * C::STAGE); bf16_t* sb = (bf16_t*)(smem + buf * C::STAGE + C::A_BYTES);
#pragma unroll
        for (int i = 0; i < NA; ++i) glds16(ap[i] ? ap[i] + k0 : zrow, sa + (i * 4 + wid) * 512 + lane * 8);
#pragma unroll
        for (int i = 0; i < NB; ++i) glds16(bp[i] ? bp[i] + k0 : zrow, sb + (i * 4 + wid) * 512 + lane * 8);
    };
#pragma unroll
    for (int i = 0; i < TM; ++i)
#pragma unroll
        for (int j = 0; j < TN; ++j)
#pragma unroll
            for (int r = 0; r < 16; ++r) acc[i][j][r] = 0.f;
    const int KT = K / 64;
    __syncthreads();
    stage_load(0, 0);
    glds_wait();
    __syncthreads();
    for (int kt = 0; kt < KT; ++kt) {
        if (kt + 1 < KT) stage_load((kt + 1) & 1, (kt + 1) * 64);
        const bf16_t* sa = (const bf16_t*)(smem + (kt & 1) * C::STAGE); const bf16_t* sb = (const bf16_t*)((const char*)sa + C::A_BYTES);
#pragma unroll
        for (int ks = 0; ks < 4; ++ks) {
            bf16x8 af[TM], bfr[TN];
            const int c = ks * 2 + (lane >> 5);
#pragma unroll
            for (int i = 0; i < TM; ++i) { int r = (wm * TM + i) * 32 + (lane & 31); af[i] = *(const bf16x8*)(sa + r * 64 + swz(r, c) * 8); }
#pragma unroll
            for (int j = 0; j < TN; ++j) { int r = (wn * TN + j) * 32 + (lane & 31); bfr[j] = *(const bf16x8*)(sb + r * 64 + swz(r, c) * 8); }
#pragma unroll
            for (int i = 0; i < TM; ++i)
#pragma unroll
                for (int j = 0; j < TN; ++j) acc[i][j] = mfma32(af[i], bfr[j], acc[i][j]);
        }
        glds_wait();
        __syncthreads();
    }
}

constexpr int CLD = 136;
template <class F>
DEV void stage_tile_bf16(const f32x16 (&acc)[2][2], char* smem, int lane, int wm, int wn, F f) {
    bf16_t* st = (bf16_t*)smem;
#pragma unroll
    for (int i = 0; i < 2; ++i)
#pragma unroll
        for (int j = 0; j < 2; ++j) {
            int col = (wn * 2 + j) * 32 + (lane & 31);
#pragma unroll
            for (int r = 0; r < 16; ++r) { int row = (wm * 2 + i) * 32 + crow(r, lane); st[row * CLD + col] = f2bf(f(acc[i][j][r], row, col)); }
        }
}
DEV void stage_tile_f32(const f32x16 (&acc)[2][2], char* smem, int lane, int wm, int wn) {
    float* st = (float*)smem;
#pragma unroll
    for (int i = 0; i < 2; ++i)
#pragma unroll
        for (int j = 0; j < 2; ++j) {
            int col = (wn * 2 + j) * 32 + (lane & 31);
#pragma unroll
            for (int r = 0; r < 16; ++r) { int row = (wm * 2 + i) * 32 + crow(r, lane); st[row * 128 + col] = acc[i][j][r]; }
        }
}

DEV void xcd_range(int bid, int nb, int N, int& first, int& end, int& stride) {
    if (nb % 8 != 0) { first = bid; end = N; stride = nb; return; }
    int g = bid & 7, j = bid >> 3; stride = nb >> 3;
    int s0 = (int)(((long long)g * N) / 8); end = (int)(((long long)(g + 1) * N) / 8); first = s0 + j;
}
DEV void tile_decode(int L, int NTM, int NTN, int& tm, int& tn) {
    constexpr int GM = 8; const int full = NTM / GM, rem = NTM % GM; const int nf = full * GM * NTN;
    if (L < nf) { int grp = L / (GM * NTN), r = L % (GM * NTN); tn = r / GM; tm = grp * GM + r % GM; }
    else { int r = L - nf; tn = r / rem; tm = full * GM + r % rem; }
}
constexpr int EPI_OFF = 32768;
template <class Rows, class Epi>
DEV void gemm_tiles(int first, int ntiles, int stride, int K, char* smem, const bf16_t* zrow, Rows rows, Epi epi) {
    typedef GemmCfg<2, 2, 2, 2> C;
    const int tid = get_tid(), lane = tid & 63, wid = tid >> 6, wm = wid >> 1, wn = wid & 1;
    if (first >= ntiles) return;
    const bf16_t* ap[4]; const bf16_t* bp[4];
    auto setptrs = [&](int t) {
#pragma unroll
        for (int i = 0; i < 4; ++i) {
            int row = (i * 4 + wid) * 8 + (lane >> 3);
            const bf16_t* pa = rows(t, 0, row); ap[i] = pa ? pa + swz(row, lane & 7) * 8 : nullptr;
            const bf16_t* pb = rows(t, 1, row); bp[i] = pb ? pb + swz(row, lane & 7) * 8 : nullptr;
        }
    };
    auto stage_load = [&](int buf, int k0) {
        bf16_t* sa = (bf16_t*)(smem + buf * C::STAGE); bf16_t* sb = (bf16_t*)(smem + buf * C::STAGE + C::A_BYTES);
#pragma unroll
        for (int i = 0; i < 4; ++i) glds16(ap[i] ? ap[i] + k0 : zrow, sa + (i * 4 + wid) * 512 + lane * 8);
#pragma unroll
        for (int i = 0; i < 4; ++i) glds16(bp[i] ? bp[i] + k0 : zrow, sb + (i * 4 + wid) * 512 + lane * 8);
    };
    const int KT = K / 64;
    __syncthreads();
    setptrs(first); stage_load(0, 0);
    glds_wait();
    __syncthreads();
    for (int t = first; t < ntiles; t += stride) {
        f32x16 acc[2][2];
#pragma unroll
        for (int i = 0; i < 2; ++i)
#pragma unroll
            for (int j = 0; j < 2; ++j)
#pragma unroll
                for (int r = 0; r < 16; ++r) acc[i][j][r] = 0.f;
        for (int kt = 0; kt < KT; ++kt) {
            if (kt + 1 < KT) stage_load((kt + 1) & 1, (kt + 1) * 64);
            else if (t + stride < ntiles) { setptrs(t + stride); stage_load(0, 0); }
            const bf16_t* sa = (const bf16_t*)(smem + (kt & 1) * C::STAGE); const bf16_t* sb = (const bf16_t*)((const char*)sa + C::A_BYTES);
#pragma unroll
            for (int ks = 0; ks < 4; ++ks) {
                bf16x8 af[2], bfr[2];
                const int c = ks * 2 + (lane >> 5);
#pragma unroll
                for (int i = 0; i < 2; ++i) { int r = (wm * 2 + i) * 32 + (lane & 31); af[i] = *(const bf16x8*)(sa + r * 64 + swz(r, c) * 8); }
#pragma unroll
                for (int j = 0; j < 2; ++j) { int r = (wn * 2 + j) * 32 + (lane & 31); bfr[j] = *(const bf16x8*)(sb + r * 64 + swz(r, c) * 8); }
#pragma unroll
                for (int i = 0; i < 2; ++i)
#pragma unroll
                    for (int j = 0; j < 2; ++j) acc[i][j] = mfma32(af[i], bfr[j], acc[i][j]);
            }
            glds_wait();
            __syncthreads();
        }
        epi(t, acc);
        __syncthreads();
    }
}
constexpr int G2_STAGE = (256 + 128) * 64;
#ifdef EMU
DEV void lds_barrier() { __syncthreads(); }
template <int N> DEV void vm_wait() {}
#else
DEV void lds_barrier() { asm volatile("s_waitcnt lgkmcnt(0)" ::: "memory"); __builtin_amdgcn_s_barrier(); asm volatile("" ::: "memory"); }
template <int N> DEV void vm_wait() { asm volatile("s_waitcnt vmcnt(%0)" :: "n"(N) : "memory"); }
#endif
template <int MODE = 0, class Rows, class Epi>
DEV void gemm_tiles256(int first, int end, int stride, int K, char* smem, const bf16_t* zrow, Rows rows, Epi epi) {
    const int tid = get_tid(), lane = tid & 63, wid = tid >> 6, wm = wid >> 1, wn = wid & 1;
    if (first >= end) return;
    const int nt = (end - first + stride - 1) / stride; const int KT = K / 32; const int G = nt * KT;
    unsigned ap[4], bp[2];
    auto setptrs = [&](int t) {
#pragma unroll
        for (int i = 0; i < 4; ++i) { int row = (i * 4 + wid) * 16 + (lane >> 2); const bf16_t* pa = rows(t, 0, row); ap[i] = pa ? (unsigned)(pa + swz4(row, lane & 3) * 8 - zrow) : 0u; }
#pragma unroll
        for (int i = 0; i < 2; ++i) { int row = (i * 4 + wid) * 16 + (lane >> 2); const bf16_t* pb = rows(t, 1, row); bp[i] = pb ? (unsigned)(pb + swz4(row, lane & 3) * 8 - zrow) : 0u; }
    };
    int lg = 0, lkt = 0, lli = 0, lst = 0;
    auto issue = [&]() {
        if (lkt == 0) setptrs(first + lli * stride);
        bf16_t* sa = (bf16_t*)(smem + lst * G2_STAGE); bf16_t* sb = (bf16_t*)(smem + lst * G2_STAGE + 256 * 64);
        if (MODE != 2) {
#pragma unroll
        for (int i = 0; i < 4; ++i) glds16(ap[i] ? zrow + (int)(ap[i] + lkt * 32) : zrow, sa + (i * 4 + wid) * 512 + lane * 8);
#pragma unroll
        for (int i = 0; i < 2; ++i) glds16(bp[i] ? zrow + (int)(bp[i] + lkt * 32) : zrow, sb + (i * 4 + wid) * 512 + lane * 8);
        }
        ++lg; if (++lkt == KT) { lkt = 0; ++lli; } if (++lst == 3) lst = 0;
    };
    __syncthreads();
    issue(); if (G > 1) issue();
    int g = 0, cst = 0;
    for (int li = 0; li < nt; ++li) {
        f32x16 acc[4][2];
#pragma unroll
        for (int i = 0; i < 4; ++i)
#pragma unroll
            for (int j = 0; j < 2; ++j)
#pragma unroll
                for (int r = 0; r < 16; ++r) acc[i][j][r] = 0.f;
        for (int kt = 0; kt < KT; ++kt, ++g) {
            if (g + 1 < G) vm_wait<6>(); else vm_wait<0>();
            lds_barrier();
            if (lg < G) issue();
            const bf16_t* sa = (const bf16_t*)(smem + cst * G2_STAGE); const bf16_t* sb = sa + 256 * 32;
            if (MODE != 1)
#pragma unroll
            for (int ks = 0; ks < 2; ++ks) {
                bf16x8 bfr[2];
                const int c = ks * 2 + (lane >> 5);
#pragma unroll
                for (int j = 0; j < 2; ++j) { int r = wn * 64 + j * 32 + (lane & 31); bfr[j] = *(const bf16x8*)(sb + r * 32 + swz4(r, c) * 8); }
#pragma unroll
                for (int ip = 0; ip < 2; ++ip) {
                    bf16x8 af[2];
#pragma unroll
                    for (int i = 0; i < 2; ++i) { int r = wm * 128 + (ip * 2 + i) * 32 + (lane & 31); af[i] = *(const bf16x8*)(sa + r * 32 + swz4(r, c) * 8); }
#pragma unroll
                    for (int i = 0; i < 2; ++i)
#pragma unroll
                        for (int j = 0; j < 2; ++j) acc[ip * 2 + i][j] = mfma32(af[i], bfr[j], acc[ip * 2 + i][j]);
                }
            }
            if (kt + 1 < KT) { if (++cst == 3) cst = 0; }
        }
        lds_barrier();
        epi(first + li * stride, acc, smem + cst * G2_STAGE);
        vm_wait<0>();
        if (++cst == 3) cst = 0;
    }
    __syncthreads();
}
template <class F, class S>
DEV void epi256_bf16(const f32x16 (&acc)[4][2], char* stg, int tid, F f, S store) {
    const int lane = tid & 63, wid = tid >> 6, wm = wid >> 1, wn = wid & 1;
    bf16_t* st = (bf16_t*)stg;
#pragma unroll
    for (int q = 0; q < 4; ++q) {
        if (wm == (q >> 1)) {
#pragma unroll
            for (int ii = 0; ii < 2; ++ii)
#pragma unroll
                for (int j = 0; j < 2; ++j) {
                    int col = wn * 64 + j * 32 + (lane & 31);
#pragma unroll
                    for (int r = 0; r < 16; ++r) { int row = ii * 32 + crow(r, lane); st[row * CLD + col] = f2bf(f(acc[(q & 1) * 2 + ii][j][r], q * 64 + row, col)); }
                }
        }
        lds_barrier();
        { const int t2 = launder(tid);
#pragma unroll
        for (int k = 0; k < 4; ++k) { int id = t2 + NTHR * k; int row = id >> 4, c = id & 15; store(q * 64 + row, c, *(const u32x4*)(st + row * CLD + c * 8)); } }
        lds_barrier();
    }
}
template <class S>
DEV void epi256_f32(const f32x16 (&acc)[4][2], char* stg, int tid, S store) {
    const int lane = tid & 63, wid = tid >> 6, wm = wid >> 1, wn = wid & 1;
    float* st = (float*)stg;
#pragma unroll
    for (int q = 0; q < 8; ++q) {
        if (wm == (q >> 2)) {
#pragma unroll
            for (int j = 0; j < 2; ++j) {
                int col = wn * 64 + j * 32 + (lane & 31);
#pragma unroll
                for (int r = 0; r < 16; ++r) st[crow(r, lane) * 128 + col] = acc[q & 3][j][r];
            }
        }
        lds_barrier();
        { const int t2 = launder(tid);
#pragma unroll
        for (int k = 0; k < 4; ++k) { int id = t2 + NTHR * k; int row = id >> 5, c = id & 31; store(q * 32 + row, c, *(const f32x4*)(st + row * 128 + c * 4)); } }
        lds_barrier();
    }
}

template <class St>
DEV void epi_f32_halves(const f32x16 (&acc)[2][2], char* smem, int tid, St store) {
    const int lane = tid & 63, wid = tid >> 6, wm = wid >> 1, wn = wid & 1;
    float* st = (float*)(smem + EPI_OFF);
#pragma unroll
    for (int half = 0; half < 2; ++half) {
        if (wm == half) {
#pragma unroll
            for (int i = 0; i < 2; ++i)
#pragma unroll
                for (int j = 0; j < 2; ++j) {
                    int col = (wn * 2 + j) * 32 + (lane & 31);
#pragma unroll
                    for (int r = 0; r < 16; ++r) st[(i * 32 + crow(r, lane)) * 128 + col] = acc[i][j][r];
                }
        }
        __syncthreads();
#pragma unroll
        for (int q = 0; q < 8; ++q) { int id = tid + NTHR * q; int row = id >> 5, c = id & 31; store(half * 64 + row, c, *(const f32x4*)(st + row * 128 + c * 4)); }
        __syncthreads();
    }
}

DEV void phase_prep(const Params& p, int bid, int nb, char* smem) {
    const int tid = get_tid();
    float* mods = (float*)(p.ws + OFF_MODS);
    float* sc = (float*)smem;
    for (int i0 = tid; i0 < (BATCH + 1) * 1024; i0 += NTHR * 4) {
        float cv[4];
#pragma unroll
        for (int q = 0; q < 4; ++q) { int i = i0 + q * NTHR; int m = i >> 10, k = i & 1023; cv[q] = i < (BATCH + 1) * 1024 ? (m < BATCH ? p.c[m * 1024 + k] : p.c_ctx[k]) : 0.f; }
#pragma unroll
        for (int q = 0; q < 4; ++q) { int i = i0 + q * NTHR; if (i < (BATCH + 1) * 1024) sc[i] = siluf_(cv[q]); }
    }
    __syncthreads();
    float* red = sc + (BATCH + 1) * 1024;
    const int nitems = 2 * 192;
    for (int it = bid; it < nitems; it += nb) {
        int l = it / 192, n = (it % 192) * 32 + (tid & 31), kg = tid >> 5;
        float a[BATCH + 1];
#pragma unroll
        for (int m = 0; m <= BATCH; ++m) a[m] = 0.f;
        const float* w = p.ada_w + (size_t)l * 1024 * 6144 + n;
        for (int k = kg * 128; k < kg * 128 + 128; k += 16) {
            float wv[16];
#pragma unroll
            for (int j = 0; j < 16; ++j) wv[j] = w[(size_t)(k + j) * 6144];
#pragma unroll
            for (int j = 0; j < 16; ++j)
#pragma unroll
                for (int m = 0; m <= BATCH; ++m) a[m] += sc[m * 1024 + k + j] * wv[j];
        }
        for (int q = 0; q < 8; ++q) {
            if (kg == q) {
#pragma unroll
                for (int m = 0; m <= BATCH; ++m) red[m * 32 + (tid & 31)] = (q ? red[m * 32 + (tid & 31)] : 0.f) + a[m];
            }
            __syncthreads();
        }
        for (int i = tid; i < (BATCH + 1) * 32; i += NTHR) {
            int m = i >> 5, nn = i & 31; int col = (it % 192) * 32 + nn;
            mods[((size_t)l * (BATCH + 1) + m) * 6144 + col] = red[i] + p.ada_b[l * 6144 + col];
        }
        __syncthreads();
    }
    if (bid == 0 && tid < 64) ((unsigned*)(p.ws + OFF_ZERO))[tid] = 0u;
    float* lb = (float*)(p.ws + OFF_LB);
    for (int i = bid * NTHR + tid; i < 512; i += nb * NTHR) {
        float l0 = p.hg_lb[i], l1 = p.hg_lb[512 + i]; float mx = fmaxf(l0, l1); float e0 = expf(l0 - mx), e1 = expf(l1 - mx);
        lb[i] = 0.f; lb[512 + i] = e1 / (e0 + e1);
    }
    float* rope = (float*)(p.ws + OFF_ROPE);
    for (int i = bid * NTHR + tid; i < SEQ * 16; i += nb * NTHR) {
        int n = i >> 4, j = i & 7, isc = (i >> 3) & 1;
        float pos = isc ? (float)(n & 63) : (float)(n >> 6);
        float inv = powf(10000.f, -(float)(2 * j) / 16.f); float ang = pos * inv;
        rope[n * 32 + isc * 16 + j] = cosf(ang); rope[n * 32 + isc * 16 + 8 + j] = sinf(ang);
    }
}

DEV int win_src_col(int n) { return n < 1024 ? n : (n < 2720 ? n + 16 : (n < 2736 ? n - 2720 + 1024 : -1)); }
DEV void phase_convert(const Params& p, int layer, int bid, int nb, char* smem, int part = 0, unsigned* queue = nullptr) {
    float* tile = (float*)smem;
    const int tid = get_tid();
    const int n_win = 4 * 44, n_wuq = 1 * 12, n_wukv = 1 * 16, n_wout = 4 * 16, n_wgu = NEXP * 4 * 32, n_wd = NEXP * 4 * 16, n_wr = 4;
    const int total = n_win + n_wuq + n_wukv + n_wout + n_wgu + n_wd + n_wr;
    const int n_small = n_win + n_wuq + n_wukv + n_wout;
    const int it_lo = part == 2 ? n_small : 0, it_hi = part == 1 ? n_small : total;
    int* s_next = (int*)(smem + 256 * 65 * 4);
    for (int it = it_lo + bid;; it += nb) {
        if (queue) {
            __syncthreads();
            if (tid == 0) *s_next = it_lo + (int)atomicAdd(queue, 1u);
            __syncthreads();
            it = *s_next;
        }
        if (it >= it_hi) break;
        int t = it, mat, K, ntn;
        const float* src = nullptr; const float* src2 = nullptr; const float* kscale = nullptr; bf16_t* dst; int ldsrc;
        if (t < n_win) { mat = 0; K = 1024; ntn = 44; src = p.w_in + (size_t)layer * 1024 * 2736; ldsrc = 2736; dst = (bf16_t*)(p.ws + OFF_WIN); }
        else if ((t -= n_win) < n_wuq) { mat = 1; K = 256; ntn = 12; src = p.mla_w_uq + (size_t)layer * 256 * 768; ldsrc = 768; kscale = p.mla_q_norm_g + layer * 256; dst = (bf16_t*)(p.ws + OFF_WUQ); }
        else if ((t -= n_wuq) < n_wukv) { mat = 2; K = 128; ntn = 16; src = p.mla_w_ukv + (size_t)layer * 128 * 1024; ldsrc = 1024; kscale = p.mla_kv_norm_g + layer * 128; dst = (bf16_t*)(p.ws + OFF_WUKV); }
        else if ((t -= n_wukv) < n_wout) { mat = 3; K = 1024; ntn = 16; src = p.w_out + (size_t)layer * 1024 * 1024; ldsrc = 1024; dst = (bf16_t*)(p.ws + OFF_WOUT); }
        else if ((t -= n_wout) < n_wgu) { mat = 4; K = 1024; ntn = 32; int e = t / 128; t -= e * 128; src = p.ex_w_gate + ((size_t)layer * NEXP + e) * 1024 * 1024; src2 = p.ex_w_up + ((size_t)layer * NEXP + e) * 1024 * 1024; ldsrc = 1024; dst = (bf16_t*)(p.ws + OFF_WGU) + (size_t)e * 2048 * 1024; }
        else if ((t -= n_wgu) < n_wd) { mat = 5; K = 1024; ntn = 16; int e = t / 64; t -= e * 64; src = p.ex_w_down + ((size_t)layer * NEXP + e) * 1024 * 1024; ldsrc = 1024; dst = (bf16_t*)(p.ws + OFF_WD) + (size_t)e * 1024 * 1024; }
        else { t -= n_wd; mat = 6; K = 1024; ntn = 1; src = p.router_w + (size_t)layer * 1024 * 16; ldsrc = 16; dst = (bf16_t*)(p.ws + OFF_WR); }
        int kt = t / ntn, nt = t % ntn; int k0 = kt * 256, n0 = nt * 64; const int kn = K - k0 < 256 ? K - k0 : 256;
        {
            int tx = tid & 63, ty = tid >> 6; int n = n0 + tx; const float* sp = src; int sc;
            if (mat == 0) sc = win_src_col(n);
            else if (mat == 4) { sc = (n >> 6) * 32 + (n & 31); if (n & 32) sp = src2; }
            else if (mat == 6) sc = (n < 16) ? n : -1;
            else sc = n;
            float v[64];
#pragma unroll
            for (int q = 0; q < 64; ++q) { int kk = ty + 4 * q; v[q] = (sc >= 0 && kk < kn) ? ld_nt(sp + (size_t)(k0 + kk) * ldsrc + sc) : 0.f; }
            if (kscale) {
#pragma unroll
                for (int q = 0; q < 64; ++q) { int kk = ty + 4 * q; if (kk < kn) v[q] *= kscale[k0 + kk]; }
            }
#pragma unroll
            for (int q = 0; q < 64; ++q) tile[(ty + 4 * q) * 65 + tx] = v[q];
        }
        __syncthreads();
        {
            int nn = tid >> 2, part = tid & 3; int n = n0 + nn;
            if (!(mat == 6 && n >= 32) && part * 64 < kn) {
#pragma unroll
                for (int g = 0; g < 8; ++g) {
                    unsigned w[4];
#pragma unroll
                    for (int j = 0; j < 4; ++j) w[j] = pack2(tile[(part * 64 + g * 8 + 2 * j) * 65 + nn], tile[(part * 64 + g * 8 + 2 * j + 1) * 65 + nn]);
                    *(u32x4*)(dst + (size_t)n * K + k0 + part * 64 + g * 8) = (u32x4){w[0], w[1], w[2], w[3]};
                }
            }
        }
        __syncthreads();
    }
    float* bperm = (float*)(p.ws + OFF_BPERM);
    if (part != 2) for (int i = bid * NTHR + tid; i < DIN_P; i += nb * NTHR) { int sc = win_src_col(i); bperm[i] = sc >= 0 ? p.b_in[layer * 2736 + sc] : 0.f; }
}

DEV const float* xrow_ptr(const Params& p, int layer, int r, bool post) {
    int b = r / T, t = r % T;
    if (t < CTXL) return ((layer == 0 && !post) ? p.ctx : (const float*)(p.ws + OFF_CX)) + ((size_t)b * CTXL + t) * D;
    return ((layer == 0 && !post) ? p.x : (const float*)p.out) + ((size_t)b * SEQ + (t - CTXL)) * D;
}
DEV void ffn_sum(const Params& p, int clayer, int r, int lane, f32x4 (&s)[4]);
DEV void phase_norm(const Params& p, int layer, int which, int bid, int nb, int clayer = -1) {
    const int tid = get_tid(), lane = tid & 63, wid = tid >> 6;
    const float* g = (which ? p.norm2_g : p.norm1_g) + layer * D;
    const float* mods = (const float*)(p.ws + OFF_MODS) + (size_t)layer * (BATCH + 1) * 6144;
    bf16_t* h = (bf16_t*)(p.ws + OFF_H);
    const bool need_ctx = layer == 0;
    const int W = nb * 4, w = bid * 4 + wid; const bool smaj = W % BATCH == 0;
    const int tstep = smaj ? W / BATCH : 1;
    f32x4 gsc[4], shv[4], g2v[4]; int cur_id = -1;
    for (int it = smaj ? w / BATCH : w; it < (smaj ? T : R); it += smaj ? tstep : W) {
        const int r = smaj ? (w % BATCH) * T + it : it;
        int b = r / T, t = r % T;
        if (which == 1 && t < CTXL && !need_ctx) continue;
        const float* xr = xrow_ptr(p, layer, r, which == 1);
        const int mod_id = t < CTXL ? BATCH : b;
        if (mod_id != cur_id) {
            cur_id = mod_id;
            const float* mrow = mods + (size_t)mod_id * 6144 + (which ? 3 * 1024 : 0);
#pragma unroll
            for (int i = 0; i < 4; ++i) { int c = i * 256 + lane * 4; f32x4 gg = *(const f32x4*)(g + c), sc = *(const f32x4*)(mrow + 1024 + c); shv[i] = *(const f32x4*)(mrow + c);
                gsc[i] = (f32x4){gg[0] * (1.f + sc[0]), gg[1] * (1.f + sc[1]), gg[2] * (1.f + sc[2]), gg[3] * (1.f + sc[3])}; }
            if (clayer >= 0) {
                const float* g2 = (const float*)(p.ws + OFF_MODS) + ((size_t)clayer * (BATCH + 1) + mod_id) * 6144 + 5 * 1024;
#pragma unroll
                for (int i = 0; i < 4; ++i) g2v[i] = *(const f32x4*)(g2 + i * 256 + lane * 4);
            }
        }
        f32x4 v[4]; float ss = 0.f;
#pragma unroll
        for (int i = 0; i < 4; ++i) v[i] = *(const f32x4*)(xr + i * 256 + lane * 4);
        if (clayer >= 0) {
            f32x4 sacc[4]; ffn_sum(p, clayer, r, lane, sacc);
#pragma unroll
            for (int i = 0; i < 4; ++i) { int c = i * 256 + lane * 4; v[i] = v[i] + g2v[i] * sacc[i]; *(f32x4*)((float*)xr + c) = v[i]; }
        }
#pragma unroll
        for (int i = 0; i < 4; ++i) ss += v[i][0] * v[i][0] + v[i][1] * v[i][1] + v[i][2] * v[i][2] + v[i][3] * v[i][3];
#pragma unroll
        for (int m = 1; m < 64; m <<= 1) ss += shfl_xor_f(ss, m);
        float rstd = rsqrtf(ss * (1.f / 1024.f) + EPS);
#pragma unroll
        for (int i = 0; i < 4; ++i) {
            int c = i * 256 + lane * 4;
            float o0 = v[i][0] * rstd * gsc[i][0] + shv[i][0], o1 = v[i][1] * rstd * gsc[i][1] + shv[i][1];
            float o2 = v[i][2] * rstd * gsc[i][2] + shv[i][2], o3 = v[i][3] * rstd * gsc[i][3] + shv[i][3];
            *(u32x2*)(h + (size_t)r * D + c) = (u32x2){pack2(o0, o1), pack2(o2, o3)};
        }
    }
}

DEV void phase_proj(const Params& p, int layer, int bid, int nb, char* smem) {
    const bf16_t* h = (const bf16_t*)(p.ws + OFF_H); const bf16_t* W = (const bf16_t*)(p.ws + OFF_WIN);
    const float* bperm = (const float*)(p.ws + OFF_BPERM);
    bf16_t* projb = (bf16_t*)(p.ws + OFF_PB); float* pref = (float*)(p.ws + OFF_PF); float* gates = (float*)(p.ws + OFF_GT);
    const int tid = get_tid(); const int lane = tid & 63, wid = tid >> 6, wm = wid >> 1, wn = wid & 1;
    constexpr int NTN = DIN_P / 128, NTM = R / 256;
    int tf, te, tstr; xcd_range(bid, nb, NTM * NTN, tf, te, tstr);
    gemm_tiles256(tf, te, tstr, 1024, smem, (const bf16_t*)(p.ws + OFF_ZERO),
        [&](int t, int which, int row) { int tm, tn; tile_decode(t, NTM, NTN, tm, tn); return which ? W + (size_t)(tn * 128 + row) * 1024 : h + (size_t)(tm * 256 + row) * D; },
        [&](int t, f32x16 (&acc)[4][2], char* stg) {
            int tm_, tn_; tile_decode(t, NTM, NTN, tm_, tn_);
            const int r0 = tm_ * 256, n0 = tn_ * 128;
            float bias[2];
#pragma unroll
            for (int j = 0; j < 2; ++j) bias[j] = bperm[n0 + wn * 64 + j * 32 + (lane & 31)];
            if (n0 < 1792 || (n0 >= 2304 && n0 < 2688)) {
                const int cdst = n0 < 1792 ? n0 : n0 - 512;
                epi256_bf16(acc, stg, tid, [&](float v, int, int col) { return v + bias[(col >> 5) & 1]; },
                            [&](int row, int c, u32x4 v) { *(u32x4*)(projb + (size_t)(r0 + row) * PBW + cdst + c * 8) = v; });
            } else if (n0 < 2304) {
#pragma unroll
                for (int i = 0; i < 4; ++i)
#pragma unroll
                    for (int j = 0; j < 2; ++j)
#pragma unroll
                        for (int r = 0; r < 16; ++r) acc[i][j][r] += bias[j];
                epi256_f32(acc, stg, tid, [&](int row, int c, f32x4 v) { *(f32x4*)(pref + (size_t)(r0 + row) * 512 + (n0 - 1792) + c * 4) = v; });
            } else {
#pragma unroll
                for (int i = 0; i < 4; ++i)
#pragma unroll
                    for (int j = 0; j < 2; ++j)
#pragma unroll
                        for (int r = 0; r < 16; ++r) acc[i][j][r] += bias[j];
                epi256_f32(acc, stg, tid, [&](int row, int c, f32x4 v) {
                    if (c < 8) { *(u32x2*)(projb + (size_t)(r0 + row) * PBW + PB_KR + c * 4) = (u32x2){pack2(v[0], v[1]), pack2(v[2], v[3])}; }
                    else if (c < 12) { *(f32x4*)(gates + (size_t)(r0 + row) * 16 + (c - 8) * 4) = v; } });
            }
        });
}

constexpr int SLD = 72;
DEV void mm64(f32x16& acc, const bf16_t* sA, const bf16_t* sBt, int wr, int wc, int lane) {
#pragma unroll
    for (int ks = 0; ks < 4; ++ks) {
        bf16x8 a = *(const bf16x8*)(sA + (wr * 32 + (lane & 31)) * SLD + ks * 16 + (lane >> 5) * 8);
        bf16x8 b = *(const bf16x8*)(sBt + (wc * 32 + (lane & 31)) * SLD + ks * 16 + (lane >> 5) * 8);
        acc = mfma32(a, b, acc);
    }
}
DEV int chunk_base(int dir, int c) { if (dir == 0) return c * 64; return (64 * c < CTXL) ? CTXL - 64 * (c + 1) : T + CTXL - 64 * (c + 1); }

DEV void mm64_nx(f32x16& acc, const bf16_t* sA, const bf16_t* X, int wr, int wc, int lane) {
#pragma unroll
    for (int ks = 0; ks < 4; ++ks) {
        bf16x8 a = *(const bf16x8*)(sA + (wr * 32 + (lane & 31)) * SLD + ks * 16 + (lane >> 5) * 8);
        bf16x8 b = tr_frag(X, SLD, ks, wc * 32, lane);
        acc = mfma32(a, b, acc);
    }
}
DEV int scan_tok(int dir, int j) { return dir ? 63 - j : j; }

template <bool NOOUT = false>
DEV void scan_ml(const Params& p, int layer, int b, int hd, int dir, char* smem) {
    const int tid = get_tid(), lane = tid & 63, wid = tid >> 6, wr = wid >> 1, wc = wid & 1;
    const bool need_ctx = layer == 0;
    const bf16_t* projb = (const bf16_t*)(p.ws + OFF_PB); const float* gates = (const float*)(p.ws + OFF_GT);
    bf16_t* outp = (bf16_t*)(p.ws + OFF_H) + (size_t)dir * R * 256;
    constexpr int RLD = 136;
    bf16_t* sRaw = (bf16_t*)smem;
    bf16_t* sQ = sRaw + 66 * RLD; bf16_t* sK = sQ + 64 * SLD; bf16_t* sV = sK + 64 * SLD; bf16_t* sP = sV + 64 * SLD; bf16_t* sCt = sP + 64 * SLD;
    float* fb = (float*)(sCt + 64 * SLD);
    float* s_rowf = fb, *s_wst = fb + 64, *s_emt = fb + 128, *s_e = fb + 192, *s_n = fb + 256, *s_sc = fb + 320, *s_cw = fb + 336;
    bf16_t* s_nh = (bf16_t*)(s_cw + 512); bf16_t* s_nl = s_nh + 64;
    float* s_wsv = s_cw + 512 + 64; float* s_fdv = s_wsv + 64;
    const bf16x8 ones = {0x3F80, 0x3F80, 0x3F80, 0x3F80, 0x3F80, 0x3F80, 0x3F80, 0x3F80};
    f32x16 cst;
#pragma unroll
    for (int r = 0; r < 16; ++r) cst[r] = 0.f;
    __syncthreads();
    for (int i = tid; i < 64 * SLD; i += NTHR) sCt[i] = 0;
    if (tid < 64) { s_n[tid] = 0.f; s_nh[tid] = 0; s_nl[tid] = 0; }
    if (tid < 128) {
        int col = (tid < 64 ? 0 : 256) + hd * 64 + (tid & 63);
        const float* cw = p.ml_conv_w + layer * 3 * 512;
        s_cw[tid] = cw[col]; s_cw[128 + tid] = cw[512 + col]; s_cw[256 + tid] = cw[1024 + col]; s_cw[384 + tid] = p.ml_conv_b[layer * 512 + col];
    }
    float mprev = 0.f;
    const size_t rb = (size_t)b * T;
    u32x4 praw[5], pv[2]; float pig = 0.f, pfg = 0.f;
    auto prefetch = [&](int c) {
        const int base = chunk_base(dir, c); const int seg_lo = base < CTXL ? 0 : CTXL, seg_hi = base < CTXL ? CTXL : T;
#pragma unroll
        for (int i = 0; i < 5; ++i) {
            int id = tid + NTHR * i; int row = id >> 4, cg = id & 15; int tok = base - 1 + row;
            praw[i] = (u32x4){0, 0, 0, 0};
            if (id < 66 * 16 && tok >= seg_lo && tok < seg_hi) praw[i] = *(const u32x4*)(projb + (rb + tok) * PBW + PB_MLQK + (cg < 8 ? 0 : 256) + hd * 64 + (cg & 7) * 8);
        }
#pragma unroll
        for (int i = 0; i < 2; ++i) { int id = tid + NTHR * i; int row = id >> 3, cg = id & 7; pv[i] = *(const u32x4*)(projb + (rb + base + row) * PBW + PB_MLV + hd * 64 + cg * 8); }
        if (tid < 64) { const float* g = gates + (rb + base + scan_tok(dir, tid)) * 16 + dir * 8 + hd; pig = g[0]; pfg = g[4]; }
    };
    prefetch(0);
    for (int c = 0; c < NC; ++c) {
        const int base = chunk_base(dir, c);
        const bool want_out = !NOOUT && (need_ctx || base >= CTXL);
#pragma unroll
        for (int i = 0; i < 5; ++i) { int id = tid + NTHR * i; if (id < 66 * 16) *(u32x4*)(sRaw + (id >> 4) * RLD + (id & 15) * 8) = praw[i]; }
#pragma unroll
        for (int i = 0; i < 2; ++i) { int id = tid + NTHR * i; *(u32x4*)(sV + (id >> 3) * SLD + (id & 7) * 8) = pv[i]; }
        if (tid < 64) {
            float ig = pig, lf = logsigmoidf_(pfg);
            float bc = wave_scan_add(lf, lane);
            float a = ig - bc, pm = wave_scan_max(a, lane);
            float mu = shfl_idx_f(pm, 63);
            float mm_ = fmaxf(mprev, pm);
            int u = scan_tok(dir, lane);
            s_rowf[u] = __expf(fminf(mu - mm_, 80.f)); s_wst[u] = __expf(mprev - mm_); s_emt[u] = __expf(-(bc + mm_)); s_e[u] = __expf(a - mu);
            float mx = fmaxf(mprev, mu);
            s_wsv[lane] = __expf(mprev - mx); s_fdv[lane] = __expf(mu - mx);
            mprev = shfl_idx_f(bc, 63) + mx;
        }
        if (c + 1 < NC) prefetch(c + 1);
        __syncthreads();
#pragma unroll
        for (int i = 0; i < 4; ++i) {
            int id = tid + NTHR * i; int u = id >> 4, cg = id & 15;
            const bf16_t* r1 = sRaw + (u + 1) * RLD + cg * 8;
            u32x4 c0 = *(const u32x4*)(r1 - RLD), c1 = *(const u32x4*)r1, c2 = *(const u32x4*)(r1 + RLD);
            float sc = cg < 8 ? 1.f : 0.125f * s_e[u];
            float o[8];
#pragma unroll
            for (int q = 0; q < 8; ++q) {
                unsigned w0 = c0[q >> 1], w1 = c1[q >> 1], w2 = c2[q >> 1];
                float a0 = bf2f((bf16_t)((q & 1) ? w0 >> 16 : w0 & 0xffff)), a1 = bf2f((bf16_t)((q & 1) ? w1 >> 16 : w1 & 0xffff)), a2 = bf2f((bf16_t)((q & 1) ? w2 >> 16 : w2 & 0xffff));
                int cc = cg * 8 + q;
                o[q] = siluf_(s_cw[cc] * a0 + s_cw[128 + cc] * a1 + s_cw[256 + cc] * a2 + s_cw[384 + cc]) * sc;
            }
            *(u32x4*)((cg < 8 ? sQ : sK) + u * SLD + (cg & 7) * 8) = (u32x4){pack2(o[0], o[1]), pack2(o[2], o[3]), pack2(o[4], o[5]), pack2(o[6], o[7])};
        }
        __syncthreads();
        f32x16 accn, accd;
#pragma unroll
        for (int r = 0; r < 16; ++r) { accn[r] = 0.f; accd[r] = 0.f; }
        if (want_out) {
            f32x16 acc;
#pragma unroll
            for (int r = 0; r < 16; ++r) acc[r] = 0.f;
            const bool skip = dir ? (wr == 1 && wc == 0) : (wr == 0 && wc == 1);
            if (!skip) mm64(acc, sQ, sK, wr, wc, lane);
            {
                int sidx = wc * 32 + (lane & 31);
#pragma unroll
                for (int r = 0; r < 16; ++r) {
                    int t = wr * 32 + crow(r, lane);
                    bool ok = dir ? (sidx >= t) : (sidx <= t);
                    sP[t * SLD + sidx] = f2bf(ok ? acc[r] * s_rowf[t] : 0.f);
                }
            }
            mm64(accn, sQ, sCt, wr, wc, lane);
#pragma unroll
            for (int ks = 0; ks < 4; ++ks) {
                bf16x8 a = *(const bf16x8*)(sQ + (wr * 32 + (lane & 31)) * SLD + ks * 16 + (lane >> 5) * 8);
                accd = mfma32(a, *(const bf16x8*)(s_nh + ks * 16 + (lane >> 5) * 8), accd);
                accd = mfma32(a, *(const bf16x8*)(s_nl + ks * 16 + (lane >> 5) * 8), accd);
            }
#pragma unroll
            for (int r = 0; r < 16; ++r) { float w = s_wst[wr * 32 + crow(r, lane)]; accn[r] *= w; accd[r] *= w; }
        }
        __syncthreads();
        if (want_out) {
#pragma unroll
            for (int ks = 0; ks < 4; ++ks) {
                bf16x8 a = *(const bf16x8*)(sP + (wr * 32 + (lane & 31)) * SLD + ks * 16 + (lane >> 5) * 8);
                accn = mfma32(a, tr_frag(sV, SLD, ks, wc * 32, lane), accn);
                accd = mfma32(a, ones, accd);
            }
            int v = wc * 32 + (lane & 31);
#pragma unroll
            for (int r = 0; r < 16; ++r) {
                int t = wr * 32 + crow(r, lane);
                float den = fmaxf(fabsf(accd[r]), s_emt[t]);
                outp[(rb + base + t) * 256 + hd * 64 + v] = f2bf(accn[r] * fast_rcp(den));
            }
        }
        {
            f32x16 x, nacc;
#pragma unroll
            for (int r = 0; r < 16; ++r) { x[r] = 0.f; nacc[r] = 0.f; }
#pragma unroll
            for (int ks = 0; ks < 4; ++ks) {
                bf16x8 a = tr_frag(sK, SLD, ks, wr * 32, lane);
                x = mfma32(a, tr_frag(sV, SLD, ks, wc * 32, lane), x);
                nacc = mfma32(a, ones, nacc);
            }
            const float ws = s_wsv[lane], fd = s_fdv[lane];
            int v = wc * 32 + (lane & 31);
#pragma unroll
            for (int r = 0; r < 16; ++r) { cst[r] = ws * cst[r] + fd * x[r]; sCt[v * SLD + wr * 32 + crow(r, lane)] = f2bf(cst[r]); }
            if (wc == 0 && (lane & 31) == 0) {
#pragma unroll
                for (int r = 0; r < 16; ++r) {
                    int k = wr * 32 + crow(r, lane); float nn = ws * s_n[k] + fd * nacc[r];
                    s_n[k] = nn; bf16_t hi = f2bf(nn); s_nh[k] = hi; s_nl[k] = f2bf(nn - bf2f(hi));
                }
            }
        }
        __syncthreads();
    }
}

template <bool NOOUT = false>
DEV void scan_hg(const Params& p, int layer, int b, int hd, int dir, char* smem) {
    const int tid = get_tid(), lane = tid & 63, wid = tid >> 6, wr = wid >> 1, wc = wid & 1;
    const bool need_ctx = layer == 0;
    const bf16_t* projb = (const bf16_t*)(p.ws + OFF_PB); const float* pref = (const float*)(p.ws + OFF_PF);
    bf16_t* outp = (bf16_t*)(p.ws + OFF_H) + (size_t)(2 + dir) * R * 256;
    const float* lbp = (const float*)(p.ws + OFF_LB) + layer * 512 + dir * 256 + hd * 64;
    bf16_t* sQs = (bf16_t*)smem; bf16_t* sKs = sQs + 64 * SLD; bf16_t* sV = sKs + 64 * SLD; bf16_t* sP = sV + 64 * SLD; bf16_t* sSt = sP + 64 * SLD;
    float* s_ps = (float*)(sSt + 64 * SLD);
    float* s_r = s_ps + 256; float* s_bend = s_r + 64;
    f32x16 st;
#pragma unroll
    for (int r = 0; r < 16; ++r) st[r] = 0.f;
    __syncthreads();
    const int k = tid & 63, part = tid >> 6;
    const float low = lbp[k];
    const size_t rb = (size_t)b * T;
    float ppre[16]; bf16_t pq[16]; u32x4 pv[2];
    auto prefetch = [&](int c) {
        const int base = chunk_base(dir, c);
#pragma unroll
        for (int i = 0; i < 16; ++i) {
            int tok = base + scan_tok(dir, part * 16 + i);
            ppre[i] = pref[(rb + tok) * 512 + dir * 256 + hd * 64 + k];
            pq[i] = projb[(rb + tok) * PBW + PB_HGQ + hd * 64 + k];
        }
#pragma unroll
        for (int i = 0; i < 2; ++i) { int id = tid + NTHR * i; int row = id >> 3, cg = id & 7; pv[i] = *(const u32x4*)(projb + (rb + base + row) * PBW + PB_HGV + hd * 64 + cg * 8); }
    };
    prefetch(0);
    for (int c = 0; c < NC; ++c) {
        const int base = chunk_base(dir, c);
        const bool want_out = !NOOUT && (need_ctx || base >= CTXL);
        float kk[16], lfc[16], qv[16]; float run = 0.f;
#pragma unroll
        for (int i = 0; i < 16; ++i) {
            float pre = ppre[i];
            float lf = (low == 0.f) ? logsigmoidf_(pre) : __logf(low + (1.f - low) * sigmoidf_(pre));
            kk[i] = (1.f - low) * sigmoidf_(-pre);
            run += lf; lfc[i] = run; qv[i] = siluf_(bf2f(pq[i]));
        }
        s_ps[part * 64 + k] = run;
#pragma unroll
        for (int i = 0; i < 2; ++i) { int id = tid + NTHR * i; *(u32x4*)(sV + (id >> 3) * SLD + (id & 7) * 8) = pv[i]; }
        if (c + 1 < NC) prefetch(c + 1);
        __syncthreads();
        float off = 0.f;
        for (int q = 0; q < part; ++q) off += s_ps[q * 64 + k];
#pragma unroll
        for (int i = 0; i < 16; ++i) lfc[i] += off;
        if (part == 1) s_r[k] = lfc[15];
        if (part == 3) s_bend[k] = lfc[15];
        __syncthreads();
        const float rref = s_r[k];
#pragma unroll
        for (int i = 0; i < 16; ++i) {
            int u = scan_tok(dir, part * 16 + i);
            sQs[u * SLD + k] = f2bf(qv[i] * __expf(lfc[i] - rref));
            sKs[u * SLD + k] = f2bf(kk[i] * __expf(rref - lfc[i]));
        }
        {
            int v = wc * 32 + (lane & 31);
#pragma unroll
            for (int r = 0; r < 16; ++r) { int kr = wr * 32 + crow(r, lane); sSt[v * SLD + kr] = f2bf(st[r] * __expf(s_r[kr])); }
        }
        __syncthreads();
        f32x16 acc;
#pragma unroll
        for (int r = 0; r < 16; ++r) acc[r] = 0.f;
        if (want_out) {
            f32x16 sacc;
#pragma unroll
            for (int r = 0; r < 16; ++r) sacc[r] = 0.f;
            const bool skip = dir ? (wr == 1 && wc == 0) : (wr == 0 && wc == 1);
            if (!skip) mm64(sacc, sQs, sKs, wr, wc, lane);
            int sidx = wc * 32 + (lane & 31);
#pragma unroll
            for (int r = 0; r < 16; ++r) { int t = wr * 32 + crow(r, lane); bool ok = dir ? (sidx >= t) : (sidx <= t); sP[t * SLD + sidx] = f2bf(ok ? sacc[r] : 0.f); }
            mm64(acc, sQs, sSt, wr, wc, lane);
        }
        __syncthreads();
        if (want_out) {
            mm64_nx(acc, sP, sV, wr, wc, lane);
            int v = wc * 32 + (lane & 31);
#pragma unroll
            for (int r = 0; r < 16; ++r) { int t = wr * 32 + crow(r, lane); outp[(rb + base + t) * 256 + hd * 64 + v] = f2bf(acc[r]); }
        }
        {
            f32x16 x;
#pragma unroll
            for (int r = 0; r < 16; ++r) x[r] = 0.f;
#pragma unroll
            for (int ks = 0; ks < 4; ++ks) x = mfma32(tr_frag(sKs, SLD, ks, wr * 32, lane), tr_frag(sV, SLD, ks, wc * 32, lane), x);
#pragma unroll
            for (int r = 0; r < 16; ++r) { int kr = wr * 32 + crow(r, lane); float be = s_bend[kr]; st[r] = __expf(be) * st[r] + __expf(be - s_r[kr]) * x[r]; }
        }
        __syncthreads();
    }
}
DEV void phase_scan(const Params& p, int layer, int bid, int nb, char* smem) {
    const int nchains = BATCH * 4 * 2 * 2;
    for (int it = bid; it < nchains; it += nb) {
        int type = it & 1, dir = (it >> 1) & 1, hd = (it >> 2) & 3, b = it >> 4;
        if (type == 0) scan_ml(p, layer, b, hd, dir, smem); else scan_hg(p, layer, b, hd, dir, smem);
    }
}
template <int WHICH>
DEV void phase_scan_probe(const Params& p, int layer, int bid, int nb, char* smem) {
    const int nchains = BATCH * 4 * 2 * 2;
    for (int it = bid; it < nchains; it += nb) {
        int type = it & 1, dir = (it >> 1) & 1, hd = (it >> 2) & 3, b = it >> 4;
        if (WHICH == 0) { if (type == 0) scan_ml<true>(p, layer, b, hd, dir, smem); else scan_hg<true>(p, layer, b, hd, dir, smem); }
        if (WHICH == 1 && type == 0) scan_ml(p, layer, b, hd, dir, smem);
        if (WHICH == 2 && type == 1) scan_hg(p, layer, b, hd, dir, smem);
    }
}

template <int TN, class ARows, class BRows, class Epi>
DEV void gemm_stream_w4(int first, int end, int stride, int nsub, int KT, char* smem, const bf16_t* zrow, ARows arows, BRows brows, Epi epi) {
    constexpr int STAGE = 32768, A_BYTES = 16384;
    const int tid = get_tid(), lane = tid & 63, wid = tid >> 6;
    if (first >= end) return;
    const int nt = (end - first + stride - 1) / stride; const int G = nt * nsub * KT;
    int lli = 0, lsub = 0, lkt = 0, lg = 0;
    auto issue = [&]() {
        const int t = first + lli * stride;
        bf16_t* sa = (bf16_t*)(smem + (lg & 1) * STAGE); bf16_t* sb = (bf16_t*)(smem + (lg & 1) * STAGE + A_BYTES);
#pragma unroll
        for (int i = 0; i < 4; ++i) { int row = (i * 4 + wid) * 8 + (lane >> 3); const bf16_t* pa = arows(t, row); glds16(pa ? pa + swz(row, lane & 7) * 8 + lkt * 64 : zrow, sa + (i * 4 + wid) * 512 + lane * 8); }
#pragma unroll
        for (int i = 0; i < TN; ++i) { int row = (i * 4 + wid) * 8 + (lane >> 3); glds16(brows(t, lsub, row) + swz(row, lane & 7) * 8 + lkt * 64, sb + (i * 4 + wid) * 512 + lane * 8); }
        ++lg; if (++lkt == KT) { lkt = 0; if (++lsub == nsub) { lsub = 0; ++lli; } }
    };
    __syncthreads();
    issue();
    glds_wait();
    __syncthreads();
    int g = 0;
    for (int li = 0; li < nt; ++li)
        for (int sub = 0; sub < nsub; ++sub) {
            f32x16 acc[TN];
#pragma unroll
            for (int j = 0; j < TN; ++j)
#pragma unroll
                for (int r = 0; r < 16; ++r) acc[j][r] = 0.f;
            for (int kt = 0; kt < KT; ++kt, ++g) {
                if (lg < G) issue();
                const bf16_t* sa = (const bf16_t*)(smem + (g & 1) * STAGE); const bf16_t* sb = (const bf16_t*)((const char*)sa + A_BYTES);
#pragma unroll
                for (int ks = 0; ks < 4; ++ks) {
                    const int c = ks * 2 + (lane >> 5);
                    int ra = wid * 32 + (lane & 31);
                    bf16x8 af = *(const bf16x8*)(sa + ra * 64 + swz(ra, c) * 8);
#pragma unroll
                    for (int j = 0; j < TN; ++j) { int rb = j * 32 + (lane & 31); acc[j] = mfma32(af, *(const bf16x8*)(sb + rb * 64 + swz(rb, c) * 8), acc[j]); }
                }
                glds_wait();
                __syncthreads();
            }
            epi(first + li * stride, sub, acc);
            __syncthreads();
        }
}

DEV void phase_mla(const Params& p, int layer, int bid, int nb, char* smem) {
    const int tid = get_tid(), lane = tid & 63, wid = tid >> 6, cl = lane & 31;
    const bool need_ctx = layer == 0;
    const bf16_t* projb = (const bf16_t*)(p.ws + OFF_PB);
    bf16_t* Qg = (bf16_t*)(p.ws + OFF_QKV); bf16_t* Kg = Qg + (size_t)BATCH * 8 * T * 96; bf16_t* Vt = Kg + (size_t)BATCH * 8 * T * 96;
    const float* rope = (const float*)(p.ws + OFF_ROPE);
    const bf16_t* WUQ = (const bf16_t*)(p.ws + OFF_WUQ); const bf16_t* WUKV = (const bf16_t*)(p.ws + OFF_WUKV);
    const bf16_t* zrow = (const bf16_t*)(p.ws + OFF_ZERO);
    bf16_t* stK = (bf16_t*)(smem + EPI_OFF);
    bf16_t* stV = (bf16_t*)(smem + EPI_OFF + 24576);
    float* s_rstd = (float*)(smem + EPI_OFF + 24576 + 17408);
    constexpr int NSUB = 2, NHG = 8 / NSUB;
    const int tpb = need_ctx ? T / 128 : SEQ / 128;
    auto row_rstd = [&](int r0, int col0, int ncol) {
        int row = tid >> 1, half = tid & 1; const bf16_t* src = projb + (size_t)(r0 + row) * PBW + col0 + half * (ncol / 2);
        float ss = 0.f;
        for (int i = 0; i < ncol / 2; i += 8) { u32x4 v = *(const u32x4*)(src + i);
#pragma unroll
            for (int q = 0; q < 4; ++q) { float lo = bf2f((bf16_t)(v[q] & 0xffff)), hi = bf2f((bf16_t)(v[q] >> 16)); ss += lo * lo + hi * hi; } }
        ss += shfl_xor_f(ss, 1);
        if (half == 0) s_rstd[row] = rsqrtf(ss / (float)ncol + EPS);
        __syncthreads();
    };
    {
        auto qrow0 = [&](int t) { int rt = t / NHG; int b = rt / tpb, j = rt % tpb; return b * T + (need_ctx ? 0 : CTXL) + j * 128; };
        const int nrt = BATCH * tpb; const bool xok = (nb % 8 == 0) && (nrt % 8 == 0);
        auto qmap = [&](int t) { if (!xok) return t; int idx = t >> 3, g = t & 7; int rtl = idx / NHG, hgp = idx % NHG; return (rtl * 8 + g) * NHG + hgp; };
        gemm_stream_w4<3>(xok ? (bid & 7) + 8 * (bid >> 3) : bid, nrt * NHG, nb, NSUB, 4, smem, zrow,
            [&](int t0_, int row) { int t = qmap(t0_); return projb + (size_t)(qrow0(t) + row) * PBW + PB_CQ; },
            [&](int t0_, int sub, int row) { int t = qmap(t0_); int hd = (t % NHG) * NSUB + sub; return WUQ + (size_t)(hd * 96 + row) * 256; },
            [&](int t0_, int sub, f32x16 (&acc)[3]) {
                const int t = qmap(t0_); const int r0 = qrow0(t), hd = (t % NHG) * NSUB + sub; const int b = r0 / T, t0 = r0 % T; const bool islat = t0 >= CTXL;
                if (sub == 0) row_rstd(r0, PB_CQ, 256);
                const float* gq = p.mla_q_qk_g + layer * 96;
                float ssq[16];
#pragma unroll
                for (int r = 0; r < 16; ++r) { float rs = s_rstd[wid * 32 + crow(r, lane)]; float sacc = 0.f;
#pragma unroll
                    for (int j = 0; j < 3; ++j) { acc[j][r] *= rs; sacc += acc[j][r] * acc[j][r]; }
                    ssq[r] = sacc; }
#pragma unroll
                for (int m = 1; m < 32; m <<= 1)
#pragma unroll
                    for (int r = 0; r < 16; ++r) ssq[r] += shfl_xor_f(ssq[r], m);
#pragma unroll
                for (int r = 0; r < 16; ++r) {
                    float rn = rsqrtf(ssq[r] * (1.f / 96.f) + EPS) * QSCL; int rl = wid * 32 + crow(r, lane); int tt = t0 + rl;
                    float v0 = acc[0][r] * rn * gq[cl], v1 = acc[1][r] * rn * gq[32 + cl], v2 = acc[2][r] * rn * gq[64 + cl];
                    float pv = shfl_xor_f(v2, 8);
                    if (islat) { const float* rt = rope + (size_t)(tt - CTXL) * 32 + (cl >> 4) * 16; int j = cl & 7; float cs = rt[j], sn = rt[8 + j]; v2 = v2 * cs + ((cl & 8) ? pv : -pv) * sn; }
                    stK[rl * 96 + cl] = f2bf(v0); stK[rl * 96 + 32 + cl] = f2bf(v1); stK[rl * 96 + 64 + cl] = f2bf(v2);
                    SCHED_FENCE();
                }
                __syncthreads();
                u32x4* dst = (u32x4*)(Qg + (((size_t)b * 8 + hd) * T + t0) * 96);
#pragma unroll
                for (int q = 0; q < 6; ++q) dst[tid + NTHR * q] = ((const u32x4*)stK)[tid + NTHR * q];
            });
    }
    {
        const int nrk = R / 128; const bool xk = (nb % 8 == 0) && (nrk % 8 == 0);
        auto kmap = [&](int t) { if (!xk) return t; int idx = t >> 3, g = t & 7; int rtl = idx / NHG, hgp = idx % NHG; return (rtl * 8 + g) * NHG + hgp; };
        gemm_stream_w4<4>(bid, nrk * NHG, nb, NSUB, 2, smem, zrow,
            [&](int t0_, int row) { int t = kmap(t0_); return projb + (size_t)((t / NHG) * 128 + row) * PBW + PB_CKV; },
            [&](int t0_, int sub, int row) { int t = kmap(t0_); int hd = (t % NHG) * NSUB + sub; return WUKV + (size_t)(hd * 128 + row) * 128; },
            [&](int t0_, int sub, f32x16 (&acc)[4]) {
                const int t = kmap(t0_); const int r0 = (t / NHG) * 128, hd = (t % NHG) * NSUB + sub; const int b = r0 / T, t0 = r0 % T; const bool islat = t0 >= CTXL;
                if (sub == 0) row_rstd(r0, PB_CKV, 128);
                bf16_t* sV = (bf16_t*)(smem + EPI_OFF);
#pragma unroll
                for (int j = 0; j < 2; ++j)
#pragma unroll
                    for (int g = 0; g < 4; ++g) {
                        int tl = wid * 32 + 8 * g + 4 * (lane >> 5); int dv = j * 32 + cl;
                        f32x4 rs4 = *(const f32x4*)(s_rstd + tl);
                        *(u32x2*)(sV + dv * CLD + tl) = (u32x2){pack2(acc[2 + j][4 * g] * rs4[0], acc[2 + j][4 * g + 1] * rs4[1]), pack2(acc[2 + j][4 * g + 2] * rs4[2], acc[2 + j][4 * g + 3] * rs4[3])};
                    }
                __syncthreads();
#pragma unroll
                for (int q = 0; q < 4; ++q) { int id = tid + NTHR * q; int dv = id >> 4, c = id & 15; *(u32x4*)(Vt + (((size_t)b * 8 + hd) * 64 + dv) * T + t0 + c * 8) = *(const u32x4*)(sV + dv * CLD + c * 8); }
                __syncthreads();
                constexpr int KFL = 68;
                float* sKf = (float*)(smem + EPI_OFF);
#pragma unroll
                for (int j = 0; j < 2; ++j)
#pragma unroll
                    for (int r = 0; r < 16; ++r) { int rl = wid * 32 + crow(r, lane); sKf[rl * KFL + j * 32 + cl] = acc[j][r] * s_rstd[rl]; }
                __syncthreads();
                {
                    const int row = tid >> 1, half = tid & 1; const int tt = t0 + row;
                    const float* gk = p.mla_k_qk_g + layer * 96;
                    float v[48];
                    if (half == 0) {
#pragma unroll
                        for (int c = 0; c < 48; c += 4) { f32x4 x = *(const f32x4*)(sKf + row * KFL + c); v[c] = x[0]; v[c + 1] = x[1]; v[c + 2] = x[2]; v[c + 3] = x[3]; }
                    } else {
#pragma unroll
                        for (int c = 0; c < 16; c += 4) { f32x4 x = *(const f32x4*)(sKf + row * KFL + 48 + c); v[c] = x[0]; v[c + 1] = x[1]; v[c + 2] = x[2]; v[c + 3] = x[3]; }
                        const u32x4* kp = (const u32x4*)(projb + (size_t)(r0 + row) * PBW + PB_KR);
#pragma unroll
                        for (int q = 0; q < 4; ++q) { u32x4 w = kp[q];
#pragma unroll
                            for (int e = 0; e < 4; ++e) { v[16 + q * 8 + 2 * e] = bf2f((bf16_t)(w[e] & 0xffff)); v[16 + q * 8 + 2 * e + 1] = bf2f((bf16_t)(w[e] >> 16)); } }
                    }
                    float ss = 0.f;
#pragma unroll
                    for (int c = 0; c < 48; ++c) ss += v[c] * v[c];
                    ss += shfl_xor_f(ss, 1);
                    const float rn = rsqrtf(ss * (1.f / 96.f) + EPS);
#pragma unroll
                    for (int c = 0; c < 48; ++c) v[c] *= rn * gk[half * 48 + c];
                    if (half == 1 && islat) {
                        const float* rt = rope + (size_t)(tt - CTXL) * 32;
#pragma unroll
                        for (int gph = 0; gph < 2; ++gph)
#pragma unroll
                            for (int j = 0; j < 8; ++j) {
                                float cs = rt[gph * 16 + j], sn = rt[gph * 16 + 8 + j]; float x1 = v[16 + gph * 16 + j], x2 = v[16 + gph * 16 + 8 + j];
                                v[16 + gph * 16 + j] = x1 * cs - x2 * sn; v[16 + gph * 16 + 8 + j] = x2 * cs + x1 * sn;
                            }
                    }
                    u32x4* dst = (u32x4*)(Kg + (((size_t)b * 8 + hd) * T + tt) * 96 + half * 48);
#pragma unroll
                    for (int q = 0; q < 6; ++q) dst[q] = (u32x4){pack2(v[q * 8], v[q * 8 + 1]), pack2(v[q * 8 + 2], v[q * 8 + 3]), pack2(v[q * 8 + 4], v[q * 8 + 5]), pack2(v[q * 8 + 6], v[q * 8 + 7])};
                }
            });
    }
}

DEV void phase_attn(const Params& p, int layer, int bid, int nb, char* smem) {
    const int tid = get_tid(), lane = tid & 63, wid = tid >> 6, cl = lane & 31, hh = lane >> 5;
    const bool need_ctx = layer == 0;
    const bf16_t* Qg = (const bf16_t*)(p.ws + OFF_QKV); const bf16_t* Kg = Qg + (size_t)BATCH * 8 * T * 96; const bf16_t* Vt = Kg + (size_t)BATCH * 8 * T * 96;
    bf16_t* yb = (bf16_t*)(p.ws + OFF_PF);
    constexpr int KA = 64 * 128, KB = 64 * 64, VB = 64 * 128, STG = KA + KB + VB;
    constexpr int NQT = T / 128;
    const int nlat = SEQ / 128, nctx = need_ctx ? CTXL / 128 : 0; const int per_bh = nlat + nctx;
    const int nlat_items = BATCH * 8 * nlat, nctx_items = BATCH * 8 * nctx;
    const bool xcd_ok = (nb % 8 == 0) && ((BATCH * 8) % 8 == 0);
    const int lat_first = xcd_ok ? (bid >> 3) : bid, lat_stride = xcd_ok ? (nb >> 3) : nb, lat_cnt = xcd_ok ? nlat_items / 8 : nlat_items;
    const int my_lat = lat_first < lat_cnt ? (lat_cnt - lat_first + lat_stride - 1) / lat_stride : 0;
    const int my_ctx = bid < nctx_items ? (nctx_items - bid + nb - 1) / nb : 0;
    for (int wi = 0; wi < my_lat + my_ctx; ++wi) {
        int bh, qt;
        if (wi < my_lat) { int idx = lat_first + wi * lat_stride; int bhl = idx / nlat; qt = CTXL / 128 + idx % nlat; bh = xcd_ok ? bhl * 8 + (bid & 7) : bhl; }
        else { int u = bid + (wi - my_lat) * nb; bh = u / nctx; qt = u % nctx; }
        int t0 = qt * 128; const bool islat = t0 >= CTXL;
        const int nkeys = islat ? T : CTXL; const int nkt = nkeys / 64;
        const bf16_t* Kb_ = Kg + (size_t)bh * T * 96; const bf16_t* Vb_ = Vt + (size_t)bh * 64 * T;
        bf16x8 qf[6];
        { const bf16_t* q = Qg + ((size_t)bh * T + t0 + wid * 32 + cl) * 96 + hh * 8;
#pragma unroll
          for (int s2 = 0; s2 < 6; ++s2) qf[s2] = *(const bf16x8*)(q + s2 * 16); }
        f32x16 o0, o1;
#pragma unroll
        for (int r = 0; r < 16; ++r) { o0[r] = 0.f; o1[r] = 0.f; }
        float mrun = -1e30f, lrun = 0.f;
        auto stage_load = [&](int buf, int kt) {
            bf16_t* ska = (bf16_t*)(smem + buf * STG); bf16_t* skb = (bf16_t*)(smem + buf * STG + KA); bf16_t* sv = (bf16_t*)(smem + buf * STG + KA + KB);
#pragma unroll
            for (int i = 0; i < 2; ++i) { int row = (i * 4 + wid) * 8 + (lane >> 3); glds16(Kb_ + (size_t)(kt * 64 + row) * 96 + swz(row, lane & 7) * 8, ska + (i * 4 + wid) * 512 + lane * 8); }
            { int row = wid * 16 + (lane >> 2); glds16(Kb_ + (size_t)(kt * 64 + row) * 96 + 64 + swz4(row, lane & 3) * 8, skb + wid * 512 + lane * 8); }
#pragma unroll
            for (int i = 0; i < 2; ++i) { int row = (i * 4 + wid) * 8 + (lane >> 3); glds16(Vb_ + (size_t)row * T + kt * 64 + swz(row, lane & 7) * 8, sv + (i * 4 + wid) * 512 + lane * 8); }
        };
        __syncthreads();
        stage_load(0, 0);
        glds_wait();
        __syncthreads();
        for (int kt = 0; kt < nkt; ++kt) {
            if (kt + 1 < nkt) stage_load((kt + 1) & 1, kt + 1);
            const bf16_t* ska = (const bf16_t*)(smem + (kt & 1) * STG); const bf16_t* skb = (const bf16_t*)(smem + (kt & 1) * STG + KA); const bf16_t* sv = (const bf16_t*)(smem + (kt & 1) * STG + KA + KB);
            f32x16 s0, s1;
#pragma unroll
            for (int r = 0; r < 16; ++r) { s0[r] = 0.f; s1[r] = 0.f; }
#pragma unroll
            for (int s2 = 0; s2 < 4; ++s2) {
                int c = s2 * 2 + hh;
                bf16x8 k0 = *(const bf16x8*)(ska + cl * 64 + swz(cl, c) * 8), k1 = *(const bf16x8*)(ska + (32 + cl) * 64 + swz(32 + cl, c) * 8);
                s0 = mfma32(k0, qf[s2], s0); s1 = mfma32(k1, qf[s2], s1);
            }
#pragma unroll
            for (int s2 = 4; s2 < 6; ++s2) {
                int c = (s2 - 4) * 2 + hh;
                bf16x8 k0 = *(const bf16x8*)(skb + cl * 32 + swz4(cl, c) * 8), k1 = *(const bf16x8*)(skb + (32 + cl) * 32 + swz4(32 + cl, c) * 8);
                s0 = mfma32(k0, qf[s2], s0); s1 = mfma32(k1, qf[s2], s1);
            }
            float mx = -1e30f;
#pragma unroll
            for (int r = 0; r < 16; ++r) mx = fmaxf(mx, fmaxf(s0[r], s1[r]));
            mx = fmaxf(mx, shfl_xor_f(mx, 32));
            if (!wave_all(mx <= mrun + 8.f)) {
                float mnew = fmaxf(mrun, mx), alpha = fast_exp2(mrun - mnew); mrun = mnew; lrun *= alpha;
#pragma unroll
                for (int r = 0; r < 16; ++r) { o0[r] *= alpha; o1[r] *= alpha; }
            }
            float ls = 0.f;
#pragma unroll
            for (int r = 0; r < 16; ++r) { s0[r] = fast_exp2(s0[r] - mrun); s1[r] = fast_exp2(s1[r] - mrun); ls += s0[r] + s1[r]; }
            lrun += ls;
#pragma unroll
            for (int s2 = 0; s2 < 4; ++s2) {
                const f32x16& sx = (s2 < 2) ? s0 : s1; int rbase = (s2 & 1) * 8;
                bf16x8 pb;
#pragma unroll
                for (int j = 0; j < 8; ++j) pb[j] = (short)f2bf(sx[rbase + j]);
#pragma unroll
                for (int i = 0; i < 2; ++i) {
                    int row = i * 32 + cl;
                    bf16x4 lo = *(const bf16x4*)(sv + row * 64 + swz(row, 2 * s2) * 8 + 4 * hh), hi = *(const bf16x4*)(sv + row * 64 + swz(row, 2 * s2 + 1) * 8 + 4 * hh);
                    bf16x8 va = {lo[0], lo[1], lo[2], lo[3], hi[0], hi[1], hi[2], hi[3]};
                    if (i == 0) o0 = mfma32(va, pb, o0); else o1 = mfma32(va, pb, o1);
                }
            }
            glds_wait();
            __syncthreads();
        }
        lrun += shfl_xor_f(lrun, 32);
        float inv = 1.f / lrun;
        int b = bh >> 3, hd = bh & 7; size_t row = (size_t)b * T + t0 + wid * 32 + cl;
#pragma unroll
        for (int i = 0; i < 2; ++i)
#pragma unroll
            for (int g = 0; g < 4; ++g) {
                const f32x16& ox = i ? o1 : o0; int dv = i * 32 + 8 * g + 4 * hh;
                *(u32x2*)(yb + row * 1024 + 512 + hd * 64 + dv) = (u32x2){pack2(ox[4 * g] * inv, ox[4 * g + 1] * inv), pack2(ox[4 * g + 2] * inv, ox[4 * g + 3] * inv)};
            }
    }
    (void)NQT;
}

template <int MODE>
DEV void phase_attn_probe(const Params& p, int layer, int bid, int nb, char* smem) {
    const int tid = get_tid(), lane = tid & 63, wid = tid >> 6, cl = lane & 31, hh = lane >> 5;
    const bool need_ctx = layer == 0;
    const bf16_t* Qg = (const bf16_t*)(p.ws + OFF_QKV); const bf16_t* Kg = Qg + (size_t)BATCH * 8 * T * 96; const bf16_t* Vt = Kg + (size_t)BATCH * 8 * T * 96;
    bf16_t* yb = (bf16_t*)(p.ws + OFF_H);
    constexpr int KA = 64 * 128, KB = 64 * 64, VB = 64 * 128, STG = KA + KB + VB;
    constexpr int NQT = T / 128;
    const int nlat = SEQ / 128, nctx = need_ctx ? CTXL / 128 : 0; const int per_bh = nlat + nctx;
    const int nlat_items = BATCH * 8 * nlat, nctx_items = BATCH * 8 * nctx;
    const bool xcd_ok = (nb % 8 == 0) && ((BATCH * 8) % 8 == 0);
    const int lat_first = xcd_ok ? (bid >> 3) : bid, lat_stride = xcd_ok ? (nb >> 3) : nb, lat_cnt = xcd_ok ? nlat_items / 8 : nlat_items;
    const int my_lat = lat_first < lat_cnt ? (lat_cnt - lat_first + lat_stride - 1) / lat_stride : 0;
    const int my_ctx = bid < nctx_items ? (nctx_items - bid + nb - 1) / nb : 0;
    for (int wi = 0; wi < my_lat + my_ctx; ++wi) {
        int bh, qt;
        if (wi < my_lat) { int idx = lat_first + wi * lat_stride; int bhl = idx / nlat; qt = CTXL / 128 + idx % nlat; bh = xcd_ok ? bhl * 8 + (bid & 7) : bhl; }
        else { int u = bid + (wi - my_lat) * nb; bh = u / nctx; qt = u % nctx; }
        int t0 = qt * 128; const bool islat = t0 >= CTXL;
        const int nkeys = islat ? T : CTXL; const int nkt = nkeys / 64;
        const bf16_t* Kb_ = Kg + (size_t)bh * T * 96; const bf16_t* Vb_ = Vt + (size_t)bh * 64 * T;
        bf16x8 qf[6];
        { const bf16_t* q = Qg + ((size_t)bh * T + t0 + wid * 32 + cl) * 96 + hh * 8;
#pragma unroll
          for (int s2 = 0; s2 < 6; ++s2) qf[s2] = *(const bf16x8*)(q + s2 * 16); }
        f32x16 o0, o1;
#pragma unroll
        for (int r = 0; r < 16; ++r) { o0[r] = 0.f; o1[r] = 0.f; }
        float mrun = -1e30f, lrun = 0.f;
        auto stage_load = [&](int buf, int kt) {
            bf16_t* ska = (bf16_t*)(smem + buf * STG); bf16_t* skb = (bf16_t*)(smem + buf * STG + KA); bf16_t* sv = (bf16_t*)(smem + buf * STG + KA + KB);
#pragma unroll
            for (int i = 0; i < 2; ++i) { int row = (i * 4 + wid) * 8 + (lane >> 3); glds16(Kb_ + (size_t)(kt * 64 + row) * 96 + swz(row, lane & 7) * 8, ska + (i * 4 + wid) * 512 + lane * 8); }
            { int row = wid * 16 + (lane >> 2); glds16(Kb_ + (size_t)(kt * 64 + row) * 96 + 64 + swz4(row, lane & 3) * 8, skb + wid * 512 + lane * 8); }
#pragma unroll
            for (int i = 0; i < 2; ++i) { int row = (i * 4 + wid) * 8 + (lane >> 3); glds16(Vb_ + (size_t)row * T + kt * 64 + swz(row, lane & 7) * 8, sv + (i * 4 + wid) * 512 + lane * 8); }
        };
        __syncthreads();
        stage_load(0, 0);
        glds_wait();
        __syncthreads();
        for (int kt = 0; kt < nkt; ++kt) {
            if (MODE != 2 && kt + 1 < nkt) stage_load((kt + 1) & 1, kt + 1);
            const bf16_t* ska = (const bf16_t*)(smem + (kt & 1) * STG); const bf16_t* skb = (const bf16_t*)(smem + (kt & 1) * STG + KA); const bf16_t* sv = (const bf16_t*)(smem + (kt & 1) * STG + KA + KB);
            f32x16 s0, s1;
#pragma unroll
            for (int r = 0; r < 16; ++r) { s0[r] = 0.f; s1[r] = 0.f; }
#pragma unroll
            for (int s2 = 0; s2 < 4; ++s2) {
                int c = s2 * 2 + hh;
                bf16x8 k0 = *(const bf16x8*)(ska + cl * 64 + swz(cl, c) * 8), k1 = *(const bf16x8*)(ska + (32 + cl) * 64 + swz(32 + cl, c) * 8);
                s0 = mfma32(k0, qf[s2], s0); s1 = mfma32(k1, qf[s2], s1);
            }
#pragma unroll
            for (int s2 = 4; s2 < 6; ++s2) {
                int c = (s2 - 4) * 2 + hh;
                bf16x8 k0 = *(const bf16x8*)(skb + cl * 32 + swz4(cl, c) * 8), k1 = *(const bf16x8*)(skb + (32 + cl) * 32 + swz4(32 + cl, c) * 8);
                s0 = mfma32(k0, qf[s2], s0); s1 = mfma32(k1, qf[s2], s1);
            }
            float mx = -1e30f;
            if (MODE != 1)
#pragma unroll
            for (int r = 0; r < 16; ++r) mx = fmaxf(mx, fmaxf(s0[r], s1[r]));
            mx = fmaxf(mx, shfl_xor_f(mx, 32));
            if (!wave_all(mx <= mrun + 8.f)) {
                float mnew = fmaxf(mrun, mx), alpha = fast_exp2(mrun - mnew); mrun = mnew; lrun *= alpha;
#pragma unroll
                for (int r = 0; r < 16; ++r) { o0[r] *= alpha; o1[r] *= alpha; }
            }
            float ls = 0.f;
            if (MODE != 1)
#pragma unroll
            for (int r = 0; r < 16; ++r) { s0[r] = fast_exp2(s0[r] - mrun); s1[r] = fast_exp2(s1[r] - mrun); ls += s0[r] + s1[r]; }
            lrun += ls;
#pragma unroll
            for (int s2 = 0; s2 < 4; ++s2) {
                const f32x16& sx = (s2 < 2) ? s0 : s1; int rbase = (s2 & 1) * 8;
                bf16x8 pb;
#pragma unroll
                for (int j = 0; j < 8; ++j) pb[j] = (short)f2bf(sx[rbase + j]);
#pragma unroll
                for (int i = 0; i < 2; ++i) {
                    int row = i * 32 + cl;
                    bf16x4 lo = *(const bf16x4*)(sv + row * 64 + swz(row, 2 * s2) * 8 + 4 * hh), hi = *(const bf16x4*)(sv + row * 64 + swz(row, 2 * s2 + 1) * 8 + 4 * hh);
                    bf16x8 va = {lo[0], lo[1], lo[2], lo[3], hi[0], hi[1], hi[2], hi[3]};
                    if (i == 0) o0 = mfma32(va, pb, o0); else o1 = mfma32(va, pb, o1);
                }
            }
            glds_wait();
            __syncthreads();
        }
        lrun += shfl_xor_f(lrun, 32);
        float inv = 1.f / lrun;
        int b = bh >> 3, hd = bh & 7; size_t row = (size_t)b * T + t0 + wid * 32 + cl;
#pragma unroll
        for (int i = 0; i < 2; ++i)
#pragma unroll
            for (int g = 0; g < 4; ++g) {
                const f32x16& ox = i ? o1 : o0; int dv = i * 32 + 8 * g + 4 * hh;
                *(u32x2*)(yb + row * 1024 + 512 + hd * 64 + dv) = (u32x2){pack2(ox[4 * g] * inv, ox[4 * g + 1] * inv), pack2(ox[4 * g + 2] * inv, ox[4 * g + 3] * inv)};
            }
    }
    (void)NQT;
}

DEV void phase_merge(const Params& p, int layer, int bid, int nb) {
    const int tid = get_tid(), lane = tid & 63, wid = tid >> 6, hl = lane & 31;
    const bool need_ctx = layer == 0;
    const bf16_t* so = (const bf16_t*)(p.ws + OFF_H); const bf16_t* projb = (const bf16_t*)(p.ws + OFF_PB);
    bf16_t* y = (bf16_t*)(p.ws + OFF_PF);
    for (int r2 = bid * 4 + wid; r2 < R / 2; r2 += nb * 4) {
        const int r = r2 * 2 + (lane >> 5);
        if (!need_ctx && (r % T) < CTXL) continue;
        const bool isml = hl < 16; const int cc = (hl * 16) & 255;
        const bf16_t* a0 = so + ((size_t)(isml ? 0 : 2) * R + r) * 256 + cc; const bf16_t* a1 = so + ((size_t)(isml ? 1 : 3) * R + r) * 256 + cc;
        u32x4 x0 = *(const u32x4*)a0, x1 = *(const u32x4*)(a0 + 8), y0 = *(const u32x4*)a1, y1 = *(const u32x4*)(a1 + 8);
        float v[16]; float ss = 0.f;
#pragma unroll
        for (int i = 0; i < 16; ++i) {
            unsigned wa = (i < 8 ? x0 : x1)[(i & 7) >> 1], wb = (i < 8 ? y0 : y1)[(i & 7) >> 1];
            v[i] = bf2f((bf16_t)((i & 1) ? wa >> 16 : wa & 0xffff)) + bf2f((bf16_t)((i & 1) ? wb >> 16 : wb & 0xffff)); ss += v[i] * v[i];
        }
        ss += shfl_xor_f(ss, 1); ss += shfl_xor_f(ss, 2);
        const bf16_t* gt = projb + (size_t)r * PBW + (isml ? PB_MLOG : PB_HGOG) + cc;
        const float* g = (isml ? p.ml_norm_g : p.hg_norm_g) + layer * 256 + cc;
        float rn = rsqrtf(ss * (1.f / 64.f) + EPS);
        u32x4 g0 = *(const u32x4*)gt, g1 = *(const u32x4*)(gt + 8);
        unsigned outw[8];
#pragma unroll
        for (int i = 0; i < 16; i += 2) {
            unsigned gw = (i < 8 ? g0 : g1)[(i & 7) >> 1];
            float ga = bf2f((bf16_t)(gw & 0xffff)), gb = bf2f((bf16_t)(gw >> 16));
            float a = v[i] * rn * g[i] * (isml ? sigmoidf_(ga) : siluf_(ga)), bb = v[i + 1] * rn * g[i + 1] * (isml ? sigmoidf_(gb) : siluf_(gb));
            outw[i >> 1] = pack2(a, bb);
        }
        u32x4* d = (u32x4*)(y + (size_t)r * D + hl * 16);
        d[0] = (u32x4){outw[0], outw[1], outw[2], outw[3]}; d[1] = (u32x4){outw[4], outw[5], outw[6], outw[7]};
    }
}

DEV void phase_outproj(const Params& p, int layer, int bid, int nb, char* smem) {
    const bool need_ctx = layer == 0;
    const bf16_t* y = (const bf16_t*)(p.ws + OFF_PF); const bf16_t* W = (const bf16_t*)(p.ws + OFF_WOUT);
    const float* mods = (const float*)(p.ws + OFF_MODS) + (size_t)layer * (BATCH + 1) * 6144;
    const int tid_ = get_tid();
    constexpr int NTN = 8; const int tpb = need_ctx ? T / 128 : SEQ / 128;
    auto row0 = [&](int tm) { int b = tm / tpb, j = tm % tpb; return b * T + (need_ctx ? 0 : CTXL) + j * 128; };
    int tf, te, tstr; xcd_range(bid, nb, BATCH * tpb * NTN, tf, te, tstr);
    gemm_tiles(tf, te, tstr, 1024, smem, (const bf16_t*)(p.ws + OFF_ZERO),
        [&](int t, int which, int row) { int tm, tn; tile_decode(t, BATCH * tpb, NTN, tm, tn); return which ? W + (size_t)(tn * 128 + row) * 1024 : y + (size_t)(row0(tm) + row) * D; },
        [&](int t, f32x16 (&acc)[2][2]) {
            int tm_, tn_; tile_decode(t, BATCH * tpb, NTN, tm_, tn_);
            const int r0 = row0(tm_), n0 = tn_ * 128; const int b = r0 / T, t0 = r0 % T; const bool islat = t0 >= CTXL;
            const float* g1 = mods + (size_t)(islat ? b : BATCH) * 6144 + 2 * 1024 + n0;
            const f32x4 gch = *(const f32x4*)(g1 + (tid_ & 31) * 4);
            epi_f32_halves(acc, smem, tid_, [&](int row, int c, f32x4 a) {
                int tt = t0 + row; const f32x4 g = gch;
                if (islat) { size_t o = ((size_t)b * SEQ + (tt - CTXL)) * D + n0 + c * 4; f32x4 xv = *(const f32x4*)((layer == 0 ? p.x : p.out) + o); *(f32x4*)(p.out + o) = xv + g * a; }
                else { size_t o = ((size_t)b * CTXL + tt) * D + n0 + c * 4; float* cx = (float*)(p.ws + OFF_CX); *(f32x4*)(cx + o) = *(const f32x4*)(p.ctx + o) + g * a; }
            });
        });
}

DEV void phase_router(const Params& p, int layer, int bid, int nb, char* smem) {
    const bool need_ctx = layer == 0;
    const bf16_t* h2 = (const bf16_t*)(p.ws + OFF_H); const bf16_t* WR = (const bf16_t*)(p.ws + OFF_WR);
    float* aff = (float*)(p.ws + OFF_AFF);
    const int tid_ = get_tid(); const int lane = tid_ & 63, wid = tid_ >> 6;
    constexpr int NTM = R / 128;
    for (int it = bid; it < NTM; it += nb) {
        int r0 = it * 128; if (!need_ctx && (r0 % T) < CTXL) continue;
        f32x16 acc[1][1];
        gemm_mainloop<4, 1, 1, 1>(acc, [&](int i) { return h2 + (size_t)(r0 + i) * D; }, [&](int j) { return WR + (size_t)j * 1024; }, 1024, smem, (const bf16_t*)(p.ws + OFF_ZERO));
        const int cl = lane & 31;
#pragma unroll
        for (int r = 0; r < 16; ++r) {
            float v = cl < 16 ? acc[0][0][r] : -1e30f; float mx = v;
#pragma unroll
            for (int m = 1; m < 16; m <<= 1) mx = fmaxf(mx, shfl_xor_f(mx, m));
            float e = cl < 16 ? __expf(v - mx) : 0.f; float s = e;
#pragma unroll
            for (int m = 1; m < 16; m <<= 1) s += shfl_xor_f(s, m);
            if (cl < 16) aff[(size_t)(r0 + wid * 32 + crow(r, lane)) * 16 + cl] = e / s;
        }
    }
}

#ifdef EMU
DEV unsigned shfl_up_u(unsigned v, int d) { int l = emu::cur->lane; return emu::shfl_u32(v, l >= d ? l - d : l); }
DEV unsigned shfl_idx_u(unsigned v, int src) { return emu::shfl_u32(v, src); }
#else
DEV unsigned shfl_up_u(unsigned v, int d) { return __shfl_up(v, d); }
DEV unsigned shfl_idx_u(unsigned v, int src) { return __shfl(v, src); }
#endif
DEV void phase_topk(const Params& p, int layer, int bid, int nb, char* smem) {
    const bool need_ctx = layer == 0; const int tid = get_tid(); const int lane = tid & 63, wid = tid >> 6;
    const float* aff = (const float*)(p.ws + OFF_AFF);
    int* selr = (int*)(p.ws + OFF_SELR); float* selg = (float*)(p.ws + OFF_SELG); int* inv = (int*)(p.ws + OFF_INV); float* invg = (float*)(p.ws + OFF_INVG);
    unsigned* keys = (unsigned*)smem;
    unsigned* hist = keys + 2048;
    unsigned* sh = hist + 256;
    const int capT = need_ctx ? CAP_L + CAP_C : CAP_L;
    const int nitems = BATCH * NEXP * 2;
    for (int it = bid; it < nitems; it += nb) {
        int seg = it & 1, e = (it >> 1) % NEXP, b = (it >> 1) / NEXP;
        if (seg == 1 && !need_ctx) continue;
        const int n = seg ? CTXL : SEQ, cap = seg ? CAP_C : CAP_L; const int rbase = b * T + (seg ? 0 : CTXL);
        __syncthreads();
        {
            static_assert(SEQ <= 8 * NTHR && CTXL <= 8 * NTHR, "key batch");
            float kv[8];
#pragma unroll
            for (int q = 0; q < 8; ++q) { int i = tid + q * NTHR; kv[q] = i < n ? aff[(size_t)(rbase + i) * 16 + e] : 0.f; }
#pragma unroll
            for (int q = 0; q < 8; ++q) { int i = tid + q * NTHR; if (i < n) keys[i] = __builtin_bit_cast(unsigned, kv[q]); }
        }
        if (tid == 0) { sh[0] = 0u; sh[1] = (unsigned)cap; }
        for (int pass = 0; pass < 4; ++pass) {
            const int shift = 24 - 8 * pass;
            hist[tid] = 0u;
            __syncthreads();
            const unsigned prefix = sh[0], kneed = sh[1];
            const unsigned hmask = pass == 0 ? 0u : (0xffffffffu << (shift + 8));
            for (int i = tid; i < n; i += NTHR) { unsigned k = keys[i]; if ((k & hmask) == prefix) atomicAdd(&hist[(k >> shift) & 255u], 1u); }
            __syncthreads();
            if (wid == 0) {
                unsigned h0 = hist[4 * lane], h1 = hist[4 * lane + 1], h2 = hist[4 * lane + 2], h3 = hist[4 * lane + 3];
                unsigned tot = h0 + h1 + h2 + h3;
                unsigned incl = tot;
#pragma unroll
                for (int d = 1; d < 64; d <<= 1) { unsigned o = shfl_idx_u(incl, lane + d < 64 ? lane + d : lane); if (lane + d < 64) incl += o; }
                unsigned above = incl - tot;
                unsigned c3 = above, c2 = c3 + h3, c1 = c2 + h2, c0 = c1 + h1;
                if (c3 < kneed && kneed <= c3 + h3) { sh[0] = prefix | ((unsigned)(4 * lane + 3) << shift); sh[1] = kneed - c3; }
                else if (c2 < kneed && kneed <= c2 + h2) { sh[0] = prefix | ((unsigned)(4 * lane + 2) << shift); sh[1] = kneed - c2; }
                else if (c1 < kneed && kneed <= c1 + h1) { sh[0] = prefix | ((unsigned)(4 * lane + 1) << shift); sh[1] = kneed - c1; }
                else if (c0 < kneed && kneed <= c0 + h0) { sh[0] = prefix | ((unsigned)(4 * lane) << shift); sh[1] = kneed - c0; }
            }
            __syncthreads();
        }
        const unsigned tau = sh[0], keq = sh[1];
        const int per = (n + NTHR - 1) / NTHR; const int i0 = tid * per;
        unsigned cg = 0, ce = 0;
        for (int q = 0; q < per && i0 + q < n; ++q) { unsigned k = keys[i0 + q]; cg += k > tau ? 1u : 0u; ce += k == tau ? 1u : 0u; }
        unsigned packed = cg | (ce << 16), incl = packed;
#pragma unroll
        for (int d = 1; d < 64; d <<= 1) { unsigned o = shfl_up_u(incl, d); if (lane >= d) incl += o; }
        if (lane == 63) sh[8 + wid] = incl;
        __syncthreads();
        unsigned base = 0;
        for (int w = 0; w < wid; ++w) base += sh[8 + w];
        unsigned excl = base + incl - packed; unsigned gb = excl & 0xffffu, eb = excl >> 16;
        for (int q = 0; q < per && i0 + q < n; ++q) {
            unsigned k = keys[i0 + q]; bool g = k > tau, eq = k == tau; int mslot = -1;
            if (g || (eq && eb < keq)) {
                mslot = b * capT + (seg ? CAP_L : 0) + (int)(gb + (eb < keq ? eb : keq));
                selr[e * ME_MAX + mslot] = rbase + i0 + q; selg[e * ME_MAX + mslot] = __builtin_bit_cast(float, k);
            }
            inv[(size_t)e * R + rbase + i0 + q] = mslot; invg[(size_t)e * R + rbase + i0 + q] = __builtin_bit_cast(float, k);
            gb += g ? 1u : 0u; eb += eq ? 1u : 0u;
        }
    }
}

DEV void phase_gateup(const Params& p, int layer, int bid, int nb, char* smem) {
    const bool need_ctx = layer == 0; const int Me = BATCH * (need_ctx ? CAP_L + CAP_C : CAP_L);
    const bf16_t* h2 = (const bf16_t*)(p.ws + OFF_H); const bf16_t* WGU = (const bf16_t*)(p.ws + OFF_WGU);
    const int* selr = (const int*)(p.ws + OFF_SELR);
    bf16_t* hid = (bf16_t*)(p.ws + OFF_PB);
    const int tid_ = get_tid(); const int lane = tid_ & 63, wid = tid_ >> 6, wm = wid >> 1, wn = wid & 1;
    const int ntm = (Me + 255) / 256; constexpr int NTN = 16;
    int tf, te, tstr; xcd_range(bid, nb, NEXP * ntm * NTN, tf, te, tstr);
    gemm_tiles256(tf, te, tstr, 1024, smem, (const bf16_t*)(p.ws + OFF_ZERO),
        [&](int t, int which, int row) -> const bf16_t* {
            int e = t / (NTN * ntm), tm_, tn_; tile_decode(t % (NTN * ntm), ntm, NTN, tm_, tn_);
            if (which) return WGU + ((size_t)e * 2048 + tn_ * 128 + row) * 1024;
            int m = tm_ * 256 + row; return m < Me ? h2 + (size_t)selr[e * ME_MAX + m] * D : (const bf16_t*)nullptr; },
        [&](int t, f32x16 (&acc)[4][2], char* stg) {
            int e = t / (NTN * ntm), tm_, tn_; tile_decode(t % (NTN * ntm), ntm, NTN, tm_, tn_); int m0 = tm_ * 256, n0 = tn_ * 128;
            bf16_t* st = (bf16_t*)stg;
#pragma unroll
            for (int q = 0; q < 2; ++q) {
                if (wm == q) {
#pragma unroll
                    for (int i = 0; i < 4; ++i)
#pragma unroll
                        for (int rq = 0; rq < 4; ++rq) {
#pragma unroll
                            for (int r = rq * 4; r < rq * 4 + 4; ++r) { int row = i * 32 + crow(r, lane); { float gx = acc[i][0][r]; st[row * 72 + wn * 32 + (lane & 31)] = f2bf(gx * fast_rcp(1.f + __expf(-gx)) * acc[i][1][r]); } }
                            SCHED_FENCE();
                        }
                }
                lds_barrier();
#pragma unroll
                for (int k = 0; k < 4; ++k) {
                    int id = tid_ + NTHR * k; int row = id >> 3, c = id & 7; int m = m0 + q * 128 + row;
                    if (m < Me) st_nt((u32x4*)(hid + ((size_t)e * Me + m) * 1024 + n0 / 2 + c * 8), *(const u32x4*)(st + row * 72 + c * 8));
                }
                lds_barrier();
            }
        });
}
template <int MODE>
DEV void phase_gateup_probe(const Params& p, int layer, int bid, int nb, char* smem) {
    const bool need_ctx = layer == 0; const int Me = BATCH * (need_ctx ? CAP_L + CAP_C : CAP_L);
    const bf16_t* h2 = (const bf16_t*)(p.ws + OFF_H); const bf16_t* WGU = (const bf16_t*)(p.ws + OFF_WGU);
    const int* selr = (const int*)(p.ws + OFF_SELR);
    const int ntm = (Me + 255) / 256; constexpr int NTN = 16;
    int tf, te, tstr; xcd_range(bid, nb, NEXP * ntm * NTN, tf, te, tstr);
    gemm_tiles256<MODE>(tf, te, tstr, 1024, smem, (const bf16_t*)(p.ws + OFF_ZERO),
        [&](int t, int which, int row) -> const bf16_t* {
            int e = t / (NTN * ntm), tm_, tn_; tile_decode(t % (NTN * ntm), ntm, NTN, tm_, tn_);
            if (which) return WGU + ((size_t)e * 2048 + tn_ * 128 + row) * 1024;
            int m = tm_ * 256 + row; return m < Me ? h2 + (size_t)selr[e * ME_MAX + m] * D : (const bf16_t*)nullptr; },
        [&](int, f32x16 (&acc)[4][2], char*) {
#ifndef EMU
#pragma unroll
            for (int i = 0; i < 4; ++i) asm volatile("" :: "v"(acc[i][0]), "v"(acc[i][1]));
#endif
        });
}
DEV void phase_down(const Params& p, int layer, int bid, int nb, char* smem) {
    const bool need_ctx = layer == 0; const int Me = BATCH * (need_ctx ? CAP_L + CAP_C : CAP_L);
    const bf16_t* hid = (const bf16_t*)(p.ws + OFF_PB); const bf16_t* WD = (const bf16_t*)(p.ws + OFF_WD);
    bf16_t* dres = (bf16_t*)(p.ws + OFF_QKV);
    const int tid_ = get_tid();
    const int ntm = (Me + 255) / 256; constexpr int NTN = 8;
    int tf, te, tstr; xcd_range(bid, nb, NEXP * ntm * NTN, tf, te, tstr);
    gemm_tiles256(tf, te, tstr, 1024, smem, (const bf16_t*)(p.ws + OFF_ZERO),
        [&](int t, int which, int row) -> const bf16_t* {
            int e = t / (NTN * ntm), tm_, tn_; tile_decode(t % (NTN * ntm), ntm, NTN, tm_, tn_);
            if (which) return WD + ((size_t)e * 1024 + tn_ * 128 + row) * 1024;
            int m = tm_ * 256 + row; return m < Me ? hid + ((size_t)e * Me + m) * 1024 : (const bf16_t*)nullptr; },
        [&](int t, f32x16 (&acc)[4][2], char* stg) {
            int e = t / (NTN * ntm), tm_, tn_; tile_decode(t % (NTN * ntm), ntm, NTN, tm_, tn_); int m0 = tm_ * 256, n0 = tn_ * 128;
            epi256_bf16(acc, stg, tid_, [&](float v, int, int) { return v; },
                        [&](int row, int c, u32x4 v) { if (m0 + row < Me) st_nt((u32x4*)(dres + ((size_t)e * Me + m0 + row) * 1024 + n0 + c * 8), v); });
        });
}
#ifdef EMU
DEV unsigned ballot16(bool pred) { unsigned m = 0; for (int e = 0; e < 16; ++e) m |= (emu::shfl_u32(pred ? 1u : 0u, e) & 1u) << e; return m; }
DEV unsigned rdlane_u(unsigned v, int idx) { return emu::shfl_u32(v, idx); }
#else
DEV unsigned ballot16(bool pred) { return (unsigned)(__ballot(pred) & 0xffffull); }
DEV unsigned rdlane_u(unsigned v, int idx) { return (unsigned)__builtin_amdgcn_readlane((int)v, idx); }
#endif
DEV void ffn_sum(const Params& p, int clayer, int r, int lane, f32x4 (&s)[4]) {
    const int Me = BATCH * (clayer == 0 ? CAP_L + CAP_C : CAP_L);
    const bf16_t* dres = (const bf16_t*)(p.ws + OFF_QKV); const int* inv = (const int*)(p.ws + OFF_INV) + r; const float* invg = (const float*)(p.ws + OFF_INVG) + r;
#pragma unroll
    for (int i = 0; i < 4; ++i) s[i] = (f32x4){0.f, 0.f, 0.f, 0.f};
    const int mi = lane < NEXP ? inv[(size_t)lane * R] : -1;
    const float gi = lane < NEXP ? invg[(size_t)lane * R] : 0.f;
    unsigned gu; memcpy(&gu, &gi, 4);
    unsigned mask = ballot16(mi >= 0);
    while (mask) {
        const int e0 = __builtin_ctz(mask); mask &= mask - 1;
        const bool two = mask != 0u; const int e1 = two ? __builtin_ctz(mask) : e0; if (two) mask &= mask - 1;
        const int m0 = (int)rdlane_u((unsigned)mi, e0), m1 = (int)rdlane_u((unsigned)mi, e1);
        unsigned g0u = rdlane_u(gu, e0), g1u = rdlane_u(gu, e1);
        float g0, g1; memcpy(&g0, &g0u, 4); memcpy(&g1, &g1u, 4); if (!two) g1 = 0.f;
        const bf16_t* row0 = dres + ((size_t)e0 * Me + m0) * 1024; const bf16_t* row1 = dres + ((size_t)e1 * Me + m1) * 1024;
        u32x2 w0[4], w1[4];
#pragma unroll
        for (int i = 0; i < 4; ++i) w0[i] = *(const u32x2*)(row0 + i * 256 + lane * 4);
#pragma unroll
        for (int i = 0; i < 4; ++i) w1[i] = *(const u32x2*)(row1 + i * 256 + lane * 4);
#pragma unroll
        for (int i = 0; i < 4; ++i) {
            s[i][0] += g0 * bf2f((bf16_t)(w0[i][0] & 0xffff)); s[i][1] += g0 * bf2f((bf16_t)(w0[i][0] >> 16)); s[i][2] += g0 * bf2f((bf16_t)(w0[i][1] & 0xffff)); s[i][3] += g0 * bf2f((bf16_t)(w0[i][1] >> 16));
            s[i][0] += g1 * bf2f((bf16_t)(w1[i][0] & 0xffff)); s[i][1] += g1 * bf2f((bf16_t)(w1[i][0] >> 16)); s[i][2] += g1 * bf2f((bf16_t)(w1[i][1] & 0xffff)); s[i][3] += g1 * bf2f((bf16_t)(w1[i][1] >> 16));
        }
    }
}
DEV void phase_final(const Params& p, int bid, int nb) {
    const int tid = get_tid(), lane = tid & 63, wid = tid >> 6;
    const float* mods = (const float*)(p.ws + OFF_MODS) + (size_t)1 * (BATCH + 1) * 6144;
    const int W = nb * 4, w = bid * 4 + wid; const bool smaj = W % BATCH == 0;
    const int tstep = smaj ? W / BATCH : 1;
    f32x4 g2v[4]; int cur_b = -1;
    for (int it = smaj ? w / BATCH : w; it < (smaj ? T : R); it += smaj ? tstep : W) {
        const int r = smaj ? (w % BATCH) * T + it : it;
        int b = r / T, t = r % T; if (t < CTXL) continue;
        if (b != cur_b) { cur_b = b; const float* g2 = mods + (size_t)b * 6144 + 5 * 1024;
#pragma unroll
            for (int i = 0; i < 4; ++i) g2v[i] = *(const f32x4*)(g2 + i * 256 + lane * 4); }
        float* xr = p.out + ((size_t)b * SEQ + (t - CTXL)) * D;
        f32x4 sacc[4]; ffn_sum(p, 1, r, lane, sacc);
#pragma unroll
        for (int i = 0; i < 4; ++i) { int c = i * 256 + lane * 4; *(f32x4*)(xr + c) = *(const f32x4*)(xr + c) + g2v[i] * sacc[i]; }
    }
}

constexpr int SMEM_BYTES = 75 * 1024;
__global__ void __launch_bounds__(NTHR, 2) k_prep(Params p) { SMEM_DECL; phase_prep(p, blockIdx.x, gridDim.x, smem); }
__global__ void __launch_bounds__(NTHR, 2) k_convert(Params p, int layer) { SMEM_DECL; phase_convert(p, layer, blockIdx.x, gridDim.x, smem); }
__global__ void __launch_bounds__(NTHR, 2) k_norm(Params p, int layer, int which, int clayer) { phase_norm(p, layer, which, blockIdx.x, gridDim.x, clayer); }
__global__ void __launch_bounds__(NTHR, 2) k_final(Params p) { phase_final(p, blockIdx.x, gridDim.x); }
__global__ void __launch_bounds__(NTHR, 2) k_proj(Params p, int layer) { SMEM_DECL; phase_proj(p, layer, blockIdx.x, gridDim.x, smem); }
__global__ void __launch_bounds__(NTHR, 2) k_scan(Params p, int layer) { SMEM_DECL; phase_scan(p, layer, blockIdx.x, gridDim.x, smem); }
__global__ void __launch_bounds__(NTHR, 2) k_mla(Params p, int layer) { SMEM_DECL; phase_mla(p, layer, blockIdx.x, gridDim.x, smem); }
__global__ void __launch_bounds__(NTHR, 2) k_attn(Params p, int layer) { SMEM_DECL; phase_attn(p, layer, blockIdx.x, gridDim.x, smem); }
__global__ void __launch_bounds__(NTHR, 2) k_merge(Params p, int layer) { phase_merge(p, layer, blockIdx.x, gridDim.x); }
__global__ void __launch_bounds__(NTHR, 2) k_outproj(Params p, int layer) { SMEM_DECL; phase_outproj(p, layer, blockIdx.x, gridDim.x, smem); }
__global__ void __launch_bounds__(NTHR, 2) k_router(Params p, int layer) { SMEM_DECL; phase_router(p, layer, blockIdx.x, gridDim.x, smem); }
__global__ void __launch_bounds__(NTHR, 2) k_topk(Params p, int layer) { SMEM_DECL; phase_topk(p, layer, blockIdx.x, gridDim.x, smem); }
__global__ void __launch_bounds__(NTHR, 2) k_gateup(Params p, int layer) { SMEM_DECL; phase_gateup(p, layer, blockIdx.x, gridDim.x, smem); }
__global__ void __launch_bounds__(NTHR, 2) k_down(Params p, int layer) { SMEM_DECL; phase_down(p, layer, blockIdx.x, gridDim.x, smem); }

#ifdef EMU
#define GRID_SYNC() emu::grid_sync()
#define GRID_SYNC_CG() emu::grid_sync()
#else
#define GRID_SYNC_CG() cooperative_groups::this_grid().sync()
#define XB_TMO      128
#define XB_XCNT(j)  (256  + 64 * (j))
#define XB_XSUB(j)  (1280 + 64 * (j))
#define XB_XGEN(j)  (2304 + 64 * (j))
#define XB_TOP      3328
#define XB_TOPGEN   3392
#define XCD_BAR_WORDS 3456
#define XB_SPIN_CAP (1u << 22)
DEV unsigned xb_ld(unsigned* p) { return __hip_atomic_load(p, __ATOMIC_RELAXED, __HIP_MEMORY_SCOPE_AGENT); }
DEV unsigned xb_add(unsigned* p, unsigned v) { return __hip_atomic_fetch_add(p, v, __ATOMIC_RELAXED, __HIP_MEMORY_SCOPE_AGENT); }
DEV unsigned xb_xcc_id() { return (unsigned)__builtin_amdgcn_s_getreg((3 << 11) | 20) & 0xFu; }
#define XB_SPIN(cond, bar) do { unsigned _sp = 0; while (cond) { __builtin_amdgcn_s_sleep(1); \
    if ((++_sp & 255u) == 0u) { if (xb_ld(&(bar)[XB_TMO])) break; if (_sp > XB_SPIN_CAP) { atomicAdd(&(bar)[XB_TMO], 1u); break; } } } } while (0)
struct XcdBarrier { unsigned* bar; unsigned x; volatile unsigned* st; };
DEV XcdBarrier xcd_barrier_post(unsigned* bar, volatile unsigned* st) {
    XcdBarrier b; b.bar = bar; b.x = xb_xcc_id(); b.st = st;
    if (threadIdx.x == 0) (void)xb_add(&bar[XB_XCNT(b.x)], 1u);
    return b;
}
DEV void xcd_barrier_complete(unsigned* bar, unsigned x, unsigned& nloc, unsigned& nx) {
    const unsigned G = gridDim.x;
    unsigned sum, cnt, mine, sp = 0u;
    for (;;) {
        sum = 0u; cnt = 0u; mine = 0u;
#pragma unroll
        for (unsigned j = 0; j < 16; ++j) { const unsigned c = xb_ld(&bar[XB_XCNT(j)]); sum += c; cnt += (c > 0u) ? 1u : 0u; mine = (j == x) ? c : mine; }
        if (sum == G) break;
        __builtin_amdgcn_s_sleep(1);
        if ((++sp & 255u) == 0u) { if (xb_ld(&bar[XB_TMO])) break; if (sp > XB_SPIN_CAP) { atomicAdd(&bar[XB_TMO], 1u); break; } }
    }
    nloc = mine > 0u ? mine : 1u; nx = cnt > 0u ? cnt : 1u;
}
DEV void xcd_barrier(const XcdBarrier& b) {
    asm volatile("s_waitcnt vmcnt(0)" ::: "memory");
    __syncthreads();
    if (threadIdx.x == 0) {
        unsigned* bar = b.bar;
        __builtin_amdgcn_s_waitcnt(0);
        unsigned nloc = b.st[0], nx = b.st[1];
        if (nloc == 0u) { xcd_barrier_complete(bar, b.x, nloc, nx); b.st[0] = nloc; b.st[1] = nx; }
        const unsigned old = xb_add(&bar[XB_XSUB(b.x)], 1u);
        const unsigned gen = old / nloc;
        if (old + 1u == (gen + 1u) * nloc) {
            __builtin_amdgcn_fence(__ATOMIC_RELEASE, "agent");
            asm volatile("s_waitcnt vmcnt(0)" ::: "memory");
            const unsigned og = xb_add(&bar[XB_TOP], 1u);
            const unsigned tg = og / nx;
            if (og + 1u == (tg + 1u) * nx) xb_add(&bar[XB_TOPGEN], 1u);
            else XB_SPIN(xb_ld(&bar[XB_TOPGEN]) == tg, bar);
            __builtin_amdgcn_fence(__ATOMIC_ACQUIRE, "agent");
            xb_add(&bar[XB_XGEN(b.x)], 1u);
            asm volatile("s_waitcnt vmcnt(0)" ::: "memory");
        } else {
            XB_SPIN(xb_ld(&bar[XB_XGEN(b.x)]) == gen, bar);
            __builtin_amdgcn_fence(__ATOMIC_ACQUIRE, "agent");
            asm volatile("s_waitcnt vmcnt(0)" ::: "memory");
        }
    }
    __syncthreads();
}
#define GRID_SYNC() xcd_barrier(xb)
#endif
DEV void phase_scan_mla(const Params& p, int layer, int bid, int nb, char* smem) {
    const int nchains = BATCH * 4 * 2 * 2;
    int nscan = nb / 2 < nchains ? nb / 2 : nchains; if (nscan < 1) nscan = 1;
    if (nb - nscan < 1) { phase_scan(p, layer, bid, nb, smem); phase_mla(p, layer, bid, nb, smem); return; }
    if (bid < nscan) phase_scan(p, layer, bid, nscan, smem); else phase_mla(p, layer, bid - nscan, nb - nscan, smem);
}
__global__ void __launch_bounds__(NTHR, 2) k_mega(Params p) {
    SMEM_DECL;
    const int bid = blockIdx.x, nb = gridDim.x;
#ifndef EMU
    volatile unsigned* xb_st = (volatile unsigned*)(smem + SMEM_BYTES - 16);
    if (threadIdx.x == 0) { xb_st[0] = 0u; xb_st[1] = 0u; }
    __syncthreads();
    XcdBarrier xb = xcd_barrier_post((unsigned*)(p.ws + OFF_BAR), xb_st);
#endif
    phase_prep(p, bid, nb, smem);
    if (PROBE == 30) { __syncthreads(); phase_prep(p, bid, nb, smem); __syncthreads(); phase_prep(p, bid, nb, smem); }
#pragma nounroll
    for (int l = 0; l < 2; ++l) {
        if (l == 0) { phase_convert(p, l, bid, nb, smem, 1); GRID_SYNC_CG(); }
        phase_norm(p, l, 0, bid, nb, l - 1);
        GRID_SYNC();
        if (PROBE == 1) { phase_convert(p, l, bid, nb, smem); phase_norm(p, l, 0, bid, nb); GRID_SYNC(); }
        phase_proj(p, l, bid, nb, smem);
        phase_convert(p, l, bid, nb, smem, 2, (unsigned*)(p.ws + OFF_QCTR) + 16 * l);
        GRID_SYNC();
        if (PROBE == 2) { phase_proj(p, l, bid, nb, smem); GRID_SYNC(); }
        {
            const int nchains = BATCH * 4 * 2 * 2;
            if (nb >= 2 * nchains) {
                if (bid < nchains) phase_scan(p, l, bid, nchains, smem); else phase_mla(p, l, bid - nchains, nb - nchains, smem);
                phase_convert(p, l, bid, nb, smem, 2, (unsigned*)(p.ws + OFF_QCTR) + 16 * l);
            } else {
                phase_scan(p, l, bid, nb, smem); phase_convert(p, l, bid, nb, smem, 2, (unsigned*)(p.ws + OFF_QCTR) + 16 * l);
                GRID_SYNC();
                phase_mla(p, l, bid, nb, smem);
            }
        }
        GRID_SYNC();
        if (PROBE == 3) { phase_scan(p, l, bid, nb, smem); GRID_SYNC(); }
        if (PROBE == 17) { const int nchains = BATCH * 4 * 2 * 2; if (bid < nchains) phase_scan(p, l, bid, nchains, smem); else phase_convert(p, l, bid - nchains, nb - nchains, smem, 2); GRID_SYNC(); }
        if (PROBE == 18) { const int nchains = BATCH * 4 * 2 * 2; if (bid >= nchains) phase_convert(p, l, bid - nchains, nb - nchains, smem, 2); GRID_SYNC(); }
        if (PROBE == 14) { phase_scan_probe<0>(p, l, bid, nb, smem); GRID_SYNC(); }
        if (PROBE == 15) { phase_scan_probe<1>(p, l, bid, nb, smem); GRID_SYNC(); }
        if (PROBE == 16) { phase_scan_probe<2>(p, l, bid, nb, smem); GRID_SYNC(); }
        if (PROBE == 8) { phase_mla(p, l, bid, nb, smem); GRID_SYNC(); }
        {
            if (blockIdx.x >= gridDim.x / 2) phase_merge(p, l, bid, nb);
            phase_attn(p, l, bid, nb, smem);
            if (blockIdx.x < gridDim.x / 2) phase_merge(p, l, bid, nb);
        }
        GRID_SYNC();
        if (PROBE == 4) { phase_attn(p, l, bid, nb, smem); GRID_SYNC(); }
        if (PROBE == 19) { phase_attn_probe<0>(p, l, bid, nb, smem); GRID_SYNC(); }
        if (PROBE == 20) { phase_attn_probe<1>(p, l, bid, nb, smem); GRID_SYNC(); }
        if (PROBE == 21) { phase_attn_probe<2>(p, l, bid, nb, smem); GRID_SYNC(); }
        phase_outproj(p, l, bid, nb, smem);
        GRID_SYNC();
        phase_norm(p, l, 1, bid, nb);
        GRID_SYNC();
        phase_router(p, l, bid, nb, smem);
        GRID_SYNC();
        phase_topk(p, l, bid, nb, smem);
        GRID_SYNC();
        if (PROBE == 5) { phase_norm(p, l, 1, bid, nb); GRID_SYNC(); phase_router(p, l, bid, nb, smem); GRID_SYNC(); phase_topk(p, l, bid, nb, smem); GRID_SYNC(); }
        phase_gateup(p, l, bid, nb, smem);
        GRID_SYNC();
        if (PROBE == 6) { phase_gateup(p, l, bid, nb, smem); GRID_SYNC(); }
        if (PROBE == 11) { phase_gateup_probe<1>(p, l, bid, nb, smem); GRID_SYNC(); }
        if (PROBE == 12) { phase_gateup_probe<2>(p, l, bid, nb, smem); GRID_SYNC(); }
        if (PROBE == 13) { phase_gateup_probe<0>(p, l, bid, nb, smem); GRID_SYNC(); }
        if (PROBE == 7) { for (int q = 0; q < 10; ++q) GRID_SYNC(); }
        phase_down(p, l, bid, nb, smem);
        if (l == 0) phase_convert(p, 1, bid, nb, smem, 1, (unsigned*)(p.ws + OFF_QCTR) + 32);
        GRID_SYNC();
        if (PROBE == 10) { phase_down(p, l, bid, nb, smem); GRID_SYNC(); }
    }
    phase_final(p, bid, nb);
}

#ifdef EMU
void emu_dump(const char* name, const void* ptr, size_t bytes);
#define DUMP(name, off, bytes) emu_dump(name, p.ws + (off), bytes)
#else
#define DUMP(name, off, bytes)
#endif

extern "C" void kernel_launch(void* const* d_in, const int* in_sizes, int n_in, void* d_out, int out_size, void* d_ws, size_t ws_size, hipStream_t stream) {
    Params p{};
    const float** f = (const float**)&p;
    for (int i = 0; i < 26; ++i) f[i] = (const float*)d_in[i];
    p.out = (float*)d_out; p.ws = (char*)d_ws;
    if (ws_size < WS_TOTAL) { fprintf(stderr, "workspace too small: %zu < %zu\n", ws_size, (size_t)WS_TOTAL); return; }
#ifdef EMU
    if (getenv("EMU_MEGA")) { memset(p.ws + OFF_BAR, 0, 16384 + 256); emu::launch(dim3(getenv("EMU_NB") ? atoi(getenv("EMU_NB")) : 16), dim3(NTHR), SMEM_BYTES, true, [=]() { k_mega(p); }); return; }
#endif
#if !defined(MULTI_LAUNCH) && !defined(EMU)
    static int grid_blocks = 0;
    if (!grid_blocks) {
        int dev = 0, cus = 0, per_cu = 0;
        (void)hipGetDevice(&dev);
        (void)hipDeviceGetAttribute(&cus, hipDeviceAttributeMultiprocessorCount, dev);
        (void)hipFuncSetAttribute((const void*)k_mega, hipFuncAttributeMaxDynamicSharedMemorySize, SMEM_BYTES);
        (void)hipOccupancyMaxActiveBlocksPerMultiprocessor(&per_cu, k_mega, NTHR, SMEM_BYTES);
        if (per_cu > 2) per_cu = 2;
        if (per_cu < 1) per_cu = 1;
        grid_blocks = cus * per_cu;
    }
    (void)hipMemsetAsync(p.ws + OFF_BAR, 0, 16384 + 256, stream);
    void* args[] = {(void*)&p};
    hipError_t e = hipLaunchCooperativeKernel((const void*)k_mega, dim3(grid_blocks), dim3(NTHR), args, SMEM_BYTES, stream);
    if (e != hipSuccess) fprintf(stderr, "cooperative launch failed: %s (grid %d)\n", hipGetErrorString(e), grid_blocks);
#else
    const int G = 512;
#ifndef EMU
    static bool attr_done = false;
    if (!attr_done) {
        attr_done = true;
        const void* ks[] = {(const void*)k_prep, (const void*)k_convert, (const void*)k_proj, (const void*)k_scan, (const void*)k_mla, (const void*)k_attn,
                            (const void*)k_outproj, (const void*)k_router, (const void*)k_topk, (const void*)k_gateup, (const void*)k_down};
        for (const void* k : ks) (void)hipFuncSetAttribute(k, hipFuncAttributeMaxDynamicSharedMemorySize, SMEM_BYTES);
    }
#endif
    LAUNCH(k_prep, 384, SMEM_BYTES, stream, p);
    for (int l = 0; l < 2; ++l) {
        char nm[64];
        LAUNCH(k_convert, G * 2, SMEM_BYTES, stream, p, l);
        LAUNCH(k_norm, G * 2, 0, stream, p, l, 0, l - 1);
        snprintf(nm, 64, "L%d_h", l); DUMP(nm, OFF_H, (size_t)R * 1024 * 2);
        LAUNCH(k_proj, G * 2, SMEM_BYTES, stream, p, l);
        snprintf(nm, 64, "L%d_projb", l); DUMP(nm, OFF_PB, (size_t)R * PBW * 2);
        snprintf(nm, 64, "L%d_pref", l); DUMP(nm, OFF_PF, (size_t)R * 512 * 4);
        snprintf(nm, 64, "L%d_gates", l); DUMP(nm, OFF_GT, (size_t)R * 16 * 4);
        LAUNCH(k_scan, BATCH * 16, SMEM_BYTES, stream, p, l);
        snprintf(nm, 64, "L%d_scan", l); DUMP(nm, OFF_H, (size_t)4 * R * 256 * 2);
        LAUNCH(k_mla, G * 2, SMEM_BYTES, stream, p, l);
        snprintf(nm, 64, "L%d_qkv", l); DUMP(nm, OFF_QKV, 2 * SZ_Q + SZ_V);
        LAUNCH(k_attn, G * 2, SMEM_BYTES, stream, p, l);
        LAUNCH(k_merge, G * 2, 0, stream, p, l);
        snprintf(nm, 64, "L%d_y", l); DUMP(nm, OFF_PF, (size_t)R * 1024 * 2);
        LAUNCH(k_outproj, G * 2, SMEM_BYTES, stream, p, l);
        LAUNCH(k_norm, G * 2, 0, stream, p, l, 1, -1);
        snprintf(nm, 64, "L%d_h2", l); DUMP(nm, OFF_H, (size_t)R * 1024 * 2);
        LAUNCH(k_router, G, SMEM_BYTES, stream, p, l);
        snprintf(nm, 64, "L%d_aff", l); DUMP(nm, OFF_AFF, (size_t)R * 16 * 4);
        LAUNCH(k_topk, BATCH * NEXP * 2, SMEM_BYTES, stream, p, l);
        LAUNCH(k_gateup, G * 2, SMEM_BYTES, stream, p, l);
        LAUNCH(k_down, G * 2, SMEM_BYTES, stream, p, l);
    }
    LAUNCH(k_final, G * 2, 0, stream, p);
#endif
}
```

```cpp
#ifndef EMU
#include <hip/hip_runtime.h>
#include <hip/hip_cooperative_groups.h>
#endif
#include <cstdio>
#include <cstdint>
#include <cmath>

#ifndef PROBE
#define PROBE 0
#endif
#ifndef BATCH
#define BATCH 16
#endif
#ifndef SEQ
#define SEQ 2048
#endif
#ifndef CTXL
#define CTXL 256
#endif

#define DEV __device__ __forceinline__
typedef unsigned short bf16_t;
typedef short bf16x8 __attribute__((ext_vector_type(8)));
typedef short bf16x4 __attribute__((ext_vector_type(4)));
typedef float f32x16 __attribute__((ext_vector_type(16)));
typedef float f32x4 __attribute__((ext_vector_type(4)));
typedef unsigned int u32x4 __attribute__((ext_vector_type(4)));
typedef unsigned int u32x2 __attribute__((ext_vector_type(2)));

constexpr int D = 1024;
constexpr int T = CTXL + SEQ;
constexpr int R = BATCH * T;
constexpr int NTHR = 256;
constexpr int DIN_P = 2816;
constexpr int PBW = 2208;
constexpr int NEXP = 16;
constexpr int CAP_L = SEQ / 8, CAP_C = CTXL / 8;
constexpr int NC = T / 64;
constexpr float EPS = 1e-6f;
constexpr float QSCL = 0.10206207261596577f * 1.4426950408889634f;
constexpr int PB_MLQK = 0, PB_MLV = 512, PB_MLOG = 768, PB_HGQ = 1024, PB_HGV = 1280, PB_HGOG = 1536, PB_CQ = 1792, PB_CKV = 2048, PB_KR = 2176;

constexpr size_t al256(size_t x) { return (x + 255) & ~(size_t)255; }
constexpr size_t SZ_WIN = (size_t)DIN_P * 1024 * 2, SZ_WUQ = 768 * 256 * 2, SZ_WUKV = 1024 * 128 * 2, SZ_WOUT = 1024 * 1024 * 2;
constexpr size_t SZ_WGU = (size_t)NEXP * 2048 * 1024 * 2, SZ_WD = (size_t)NEXP * 1024 * 1024 * 2, SZ_WR = 32 * 1024 * 2;
constexpr size_t OFF_WIN = 0;
constexpr size_t OFF_WUQ = OFF_WIN + SZ_WIN;
constexpr size_t OFF_WUKV = OFF_WUQ + SZ_WUQ;
constexpr size_t OFF_WOUT = OFF_WUKV + SZ_WUKV;
constexpr size_t OFF_WGU = OFF_WOUT + SZ_WOUT;
constexpr size_t OFF_WD = OFF_WGU + SZ_WGU;
constexpr size_t OFF_WR = OFF_WD + SZ_WD;
constexpr size_t OFF_BPERM = OFF_WR + SZ_WR;
constexpr size_t OFF_PB = al256(OFF_BPERM + DIN_P * 4);
constexpr int ME_MAX = BATCH * (CAP_L + CAP_C);
constexpr size_t SZ_PB = ((size_t)R * PBW * 2 > (size_t)NEXP * ME_MAX * 1024 * 2) ? (size_t)R * PBW * 2 : (size_t)NEXP * ME_MAX * 1024 * 2;
constexpr size_t OFF_PF = al256(OFF_PB + SZ_PB);
constexpr size_t OFF_GT = al256(OFF_PF + (size_t)R * 512 * 4);
constexpr size_t OFF_CX = al256(OFF_GT + (size_t)R * 16 * 4);
constexpr size_t OFF_QKV = al256(OFF_CX + (size_t)BATCH * CTXL * D * 4);
constexpr size_t SZ_Q = (size_t)BATCH * 8 * T * 96 * 2, SZ_V = (size_t)BATCH * 8 * T * 64 * 2;
constexpr size_t SZ_QKV = (2 * SZ_Q + SZ_V > (size_t)R * 1024 * 2) ? 2 * SZ_Q + SZ_V : (size_t)R * 1024 * 2;
constexpr size_t OFF_H = al256(OFF_QKV + SZ_QKV);
constexpr size_t OFF_MODS = al256(OFF_H + (size_t)R * 1024 * 2);
constexpr size_t OFF_LB = al256(OFF_MODS + (size_t)2 * (BATCH + 1) * 6144 * 4);
constexpr size_t OFF_ROPE = al256(OFF_LB + 2 * 512 * 4);
constexpr size_t OFF_AFF = al256(OFF_ROPE + (size_t)SEQ * 32 * 4);
constexpr size_t OFF_SELR = al256(OFF_AFF + (size_t)R * 16 * 4);
constexpr size_t OFF_SELG = al256(OFF_SELR + (size_t)NEXP * ME_MAX * 4);
constexpr size_t OFF_INV = al256(OFF_SELG + (size_t)NEXP * ME_MAX * 4);
constexpr size_t OFF_INVG = al256(OFF_INV + (size_t)R * 16 * 4);
constexpr size_t OFF_BAR = al256(OFF_INVG + (size_t)R * 16 * 4);
constexpr size_t OFF_QCTR = OFF_BAR + 16384;
constexpr size_t OFF_ZERO = OFF_BAR + 32768;
constexpr size_t WS_TOTAL = OFF_BAR + 65536;

struct Params {
    const float *x, *c, *ctx, *c_ctx, *ada_w, *ada_b, *norm1_g, *norm2_g, *w_in, *b_in, *ml_conv_w, *ml_conv_b, *ml_norm_g,
        *hg_lb, *hg_norm_g, *mla_q_norm_g, *mla_w_uq, *mla_kv_norm_g, *mla_w_ukv, *mla_q_qk_g, *mla_k_qk_g, *w_out, *router_w,
        *ex_w_gate, *ex_w_up, *ex_w_down;
    float* out;
    char* ws;
};

#ifdef EMU
DEV float bf2f(bf16_t v) { unsigned u = (unsigned)v << 16; float f; memcpy(&f, &u, 4); return f; }
DEV bf16_t f2bf(float x) { unsigned u; memcpy(&u, &x, 4); if ((u & 0x7fffffffu) > 0x7f800000u) return 0x7fc0; u += 0x7fffu + ((u >> 16) & 1u); return (bf16_t)(u >> 16); }
DEV f32x16 mfma32(bf16x8 a, bf16x8 b, f32x16 c) {
    emu::Wave* w = emu::cur->wave; int p = emu::wave_arrive_begin(); int lane = emu::cur->lane;
    for (int j = 0; j < 8; ++j) { w->fa[p][lane][j] = bf2f((bf16_t)a[j]); w->fb[p][lane][j] = bf2f((bf16_t)b[j]); }
    emu::wave_arrive_wait();
    int col = lane & 31, h = lane >> 5;
    for (int r = 0; r < 16; ++r) {
        int row = (r & 3) + 8 * (r >> 2) + 4 * h; float s = c[r];
        for (int k = 0; k < 16; ++k) s += w->fa[p][row + 32 * (k >> 3)][k & 7] * w->fb[p][col + 32 * (k >> 3)][k & 7];
        c[r] = s;
    }
    return c;
}
DEV float shfl_xor_f(float v, int m) { unsigned u; memcpy(&u, &v, 4); u = emu::shfl_u32(u, emu::cur->lane ^ m); float f; memcpy(&f, &u, 4); return f; }
DEV float shfl_idx_f(float v, int src) { unsigned u; memcpy(&u, &v, 4); u = emu::shfl_u32(u, src); float f; memcpy(&f, &u, 4); return f; }
DEV float shfl_up_f(float v, int d) { unsigned u; memcpy(&u, &v, 4); int l = emu::cur->lane; u = emu::shfl_u32(u, l >= d ? l - d : l); float f; memcpy(&f, &u, 4); return f; }
#define LAUNCH(kern, grid, smem, stream, ...) emu::launch(dim3(grid), dim3(NTHR), smem, false, [=]() { kern(__VA_ARGS__); })
#else
DEV float bf2f(bf16_t v) { return __builtin_bit_cast(float, (unsigned)v << 16); }
DEV bf16_t f2bf(float x) { return __builtin_bit_cast(unsigned short, (__bf16)x); }
DEV f32x16 mfma32(bf16x8 a, bf16x8 b, f32x16 c) { return __builtin_amdgcn_mfma_f32_32x32x16_bf16(a, b, c, 0, 0, 0); }
DEV float shfl_xor_f(float v, int m) { return __shfl_xor(v, m); }
DEV float shfl_up_f(float v, int d) { return __shfl_up(v, d); }
DEV float shfl_idx_f(float v, int src) { return __shfl(v, src); }
#define LAUNCH(kern, grid, smem, stream, ...) hipLaunchKernelGGL(kern, dim3(grid), dim3(NTHR), smem, stream, __VA_ARGS__)
#endif
#ifdef EMU
DEV int get_tid() { return threadIdx.x; }
#else
DEV int get_tid() { int t = threadIdx.x; asm volatile("" : "+v"(t)); return t; }
#endif
#ifdef EMU
DEV bf16x4 ds_tr(const bf16_t* a) {
    emu::Wave* w = emu::cur->wave; int p = emu::wave_arrive_begin(); int lane = emu::cur->lane;
    w->pv[p][lane] = a;
    emu::wave_arrive_wait();
    int g = lane & ~15, i = lane & 15; bf16x4 r;
    for (int q = 0; q < 4; ++q) r[q] = (short)((const bf16_t*)w->pv[p][g + 4 * q + (i >> 2)])[i & 3];
    return r;
}
#else
DEV bf16x4 ds_tr(const bf16_t* a) { return __builtin_amdgcn_ds_read_tr16_b64_v4i16((__attribute__((address_space(3))) bf16x4*)a); }
#endif
#ifdef EMU
DEV void glds16(const bf16_t* g, bf16_t* l) {
    emu::Wave* w = emu::cur->wave; int p = emu::wave_arrive_begin(); int lane = emu::cur->lane;
    w->pv[p][lane] = l;
    emu::wave_arrive_wait();
    if ((const char*)l - (const char*)w->pv[p][0] != lane * 16) { fprintf(stderr, "glds16: LDS destination not wave-linear (lane %d)\n", lane); abort(); }
    memcpy(l, g, 16);
}
DEV void glds_wait() {}
#else
DEV void glds16(const bf16_t* g, bf16_t* l) {
    __builtin_amdgcn_global_load_lds((const __attribute__((address_space(1))) void*)g, (__attribute__((address_space(3))) void*)l, 16, 0, 0);
}
DEV void glds_wait() { asm volatile("s_waitcnt vmcnt(0)" ::: "memory"); }
#endif
#ifdef NO_TR
DEV bf16x8 tr_frag(const bf16_t* X, int ldx, int ks, int c0, int lane) {
    const bf16_t* a = X + (16 * ks + 8 * (lane >> 5)) * ldx + c0 + (lane & 31);
    bf16x8 r;
#pragma unroll
    for (int j = 0; j < 8; ++j) r[j] = (short)a[j * ldx];
    return r;
}
#else
DEV bf16x8 tr_frag(const bf16_t* X, int ldx, int ks, int c0, int lane) {
    const bf16_t* a = X + (16 * ks + 8 * (lane >> 5) + ((lane & 15) >> 2)) * ldx + c0 + 16 * ((lane >> 4) & 1) + 4 * (lane & 3);
    bf16x4 lo = ds_tr(a), hi = ds_tr(a + 4 * ldx);
    return (bf16x8){lo[0], lo[1], lo[2], lo[3], hi[0], hi[1], hi[2], hi[3]};
}
#endif
#ifdef EMU
DEV float fast_exp2(float x) { return exp2f(x); }
DEV bool wave_all(bool pred) { unsigned v = pred ? 1u : 0u; for (int m = 1; m < 64; m <<= 1) v &= emu::shfl_u32(v, emu::cur->lane ^ m); return v != 0; }
#else
DEV float fast_exp2(float x) { return __builtin_amdgcn_exp2f(x); }
DEV bool wave_all(bool pred) { return __all(pred); }
#endif
#ifdef EMU
DEV int launder(int v) { return v; }
#else
DEV int launder(int v) { asm volatile("" : "+v"(v)); return v; }
#endif
#ifdef EMU
#define SCHED_FENCE()
#else
#define SCHED_FENCE() __builtin_amdgcn_sched_barrier(0)
#endif
#ifdef EMU
DEV float wave_scan_add(float v, int lane) { for (int d = 1; d < 64; d <<= 1) { float o = shfl_up_f(v, d); if (lane >= d) v += o; } return v; }
DEV float wave_scan_max(float v, int lane) { for (int d = 1; d < 64; d <<= 1) { float o = shfl_up_f(v, d); if (lane >= d) v = fmaxf(v, o); } return v; }
#else
template <int CTRL, int ROWMASK> DEV float dpp_f(float ident, float v) {
    return __builtin_bit_cast(float, __builtin_amdgcn_update_dpp(__builtin_bit_cast(int, ident), __builtin_bit_cast(int, v), CTRL, ROWMASK, 0xf, false));
}
DEV float wave_scan_add(float v, int) {
    v += dpp_f<0x111, 0xf>(0.f, v); v += dpp_f<0x112, 0xf>(0.f, v); v += dpp_f<0x114, 0xf>(0.f, v); v += dpp_f<0x118, 0xf>(0.f, v);
    v += dpp_f<0x142, 0xa>(0.f, v); v += dpp_f<0x143, 0xc>(0.f, v);
    return v;
}
DEV float wave_scan_max(float v, int) {
    const float NI = -3.0e38f;
    v = fmaxf(v, dpp_f<0x111, 0xf>(NI, v)); v = fmaxf(v, dpp_f<0x112, 0xf>(NI, v)); v = fmaxf(v, dpp_f<0x114, 0xf>(NI, v)); v = fmaxf(v, dpp_f<0x118, 0xf>(NI, v));
    v = fmaxf(v, dpp_f<0x142, 0xa>(NI, v)); v = fmaxf(v, dpp_f<0x143, 0xc>(NI, v));
    return v;
}
#endif
#ifdef EMU
DEV void st_nt(u32x4* p, u32x4 v) { *p = v; }
DEV float ld_nt(const float* p) { return *p; }
#else
DEV void st_nt(u32x4* p, u32x4 v) { __builtin_nontemporal_store(v, p); }
DEV float ld_nt(const float* p) { return __builtin_nontemporal_load(p); }
#endif
DEV unsigned pack2(float lo, float hi) { return (unsigned)f2bf(lo) | ((unsigned)f2bf(hi) << 16); }
#ifdef EMU
DEV float fast_rcp(float x) { return 1.f / x; }
#else
DEV float fast_rcp(float x) { return __builtin_amdgcn_rcpf(x); }
#endif
DEV float sigmoidf_(float x) { return fast_rcp(1.f + __expf(-x)); }
DEV float siluf_(float x) { return x * sigmoidf_(x); }
DEV float logsigmoidf_(float x) { return fminf(x, 0.f) - __logf(1.f + __expf(-fabsf(x))); }
#ifdef EMU
#define SMEM_DECL char* smem = emu::cur->blk->smem
#else
#define SMEM_DECL extern __shared__ __attribute__((aligned(16))) char smem[]
#endif

DEV int crow(int r, int lane) { return (r & 3) + 8 * (r >> 2) + 4 * (lane >> 5); }

template <int WGM, int WGN, int TM, int TN> struct GemmCfg {
    static constexpr int BM = WGM * TM * 32, BN = WGN * TN * 32;
    static constexpr int A_BYTES = BM * 128, B_BYTES = BN * 128, STAGE = A_BYTES + B_BYTES, LDS = 2 * STAGE;
};
DEV int swz(int row, int c) { return c ^ ((row >> 1) & 7); }
DEV int swz4(int row, int c) { return c ^ ((row >> 2) & 3); }
template <int WGM, int WGN, int TM, int TN, class ARow, class BRow>
DEV void gemm_mainloop(f32x16 (&acc)[TM][TN], ARow arow, BRow brow, int K, char* smem, const bf16_t* zrow) {
    typedef GemmCfg<WGM, WGN, TM, TN> C;
    constexpr int NA = C::BM / 32, NB = C::BN / 32;
    const int tid = get_tid(), lane = tid & 63, wid = tid >> 6, wm = wid / WGN, wn = wid % WGN;
    const bf16_t* ap[NA]; const bf16_t* bp[NB];
#pragma unroll
    for (int i = 0; i < NA; ++i) { int row = (i * 4 + wid) * 8 + (lane >> 3); const bf16_t* p = arow(row); ap[i] = p ? p + swz(row, lane & 7) * 8 : nullptr; }
#pragma unroll
    for (int i = 0; i < NB; ++i) { int row = (i * 4 + wid) * 8 + (lane >> 3); const bf16_t* p = brow(row); bp[i] = p ? p + swz(row, lane & 7) * 8 : nullptr; }
    auto stage_load = [&](int buf, int k0) {
        bf16_t* sa = (bf16_t*)(smem + buf * C::STAGE); bf16_t* sb = (bf16_t*)(smem + buf * C::STAGE + C::A_BYTES);
#pragma unroll
        for (int i = 0; i < NA; ++i) glds16(ap[i] ? ap[i] + k0 : zrow, sa + (i * 4 + wid) * 512 + lane * 8);
#pragma unroll
        for (int i = 0; i < NB; ++i) glds16(bp[i] ? bp[i] + k0 : zrow, sb + (i * 4 + wid) * 512 + lane * 8);
    };
#pragma unroll
    for (int i = 0; i < TM; ++i)
#pragma unroll
        for (int j = 0; j < TN; ++j)
#pragma unroll
            for (int r = 0; r < 16; ++r) acc[i][j][r] = 0.f;
    const int KT = K / 64;
    __syncthreads();
    stage_load(0, 0);
    glds_wait();
    __syncthreads();
    for (int kt = 0; kt < KT; ++kt) {
        if (kt + 1 < KT) stage_load((kt + 1) & 1, (kt + 1) * 64);
        const bf16_t* sa = (const bf16_t*)(smem + (kt & 1) * C::STAGE); const bf16_t* sb = (const bf16_t*)((const char*)sa + C::A_BYTES);
#pragma unroll
        for (int ks = 0; ks < 4; ++ks) {
            bf16x8 af[TM], bfr[TN];
            const int c = ks * 2 + (lane >> 5);
#pragma unroll
            for (int i = 0; i < TM; ++i) { int r = (wm * TM + i) * 32 + (lane & 31); af[i] = *(const bf16x8*)(sa + r * 64 + swz(r, c) * 8); }
#pragma unroll
            for (int j = 0; j < TN; ++j) { int r = (wn * TN + j) * 32 + (lane & 31); bfr[j] = *(const bf16x8*)(sb + r * 64 + swz(r, c) * 8); }
#pragma unroll
            for (int i = 0; i < TM; ++i)
#pragma unroll
                for (int j = 0; j < TN; ++j) acc[i][j] = mfma32(af[i], bfr[j], acc[i][j]);
        }
        glds_wait();
        __syncthreads();
    }
}

constexpr int CLD = 136;
template <class F>
DEV void stage_tile_bf16(const f32x16 (&acc)[2][2], char* smem, int lane, int wm, int wn, F f) {
    bf16_t* st = (bf16_t*)smem;
#pragma unroll
    for (int i = 0; i < 2; ++i)
#pragma unroll
        for (int j = 0; j < 2; ++j) {
            int col = (wn * 2 + j) * 32 + (lane & 31);
#pragma unroll
            for (int r = 0; r < 16; ++r) { int row = (wm * 2 + i) * 32 + crow(r, lane); st[row * CLD + col] = f2bf(f(acc[i][j][r], row, col)); }
        }
}
DEV void stage_tile_f32(const f32x16 (&acc)[2][2], char* smem, int lane, int wm, int wn) {
    float* st = (float*)smem;
#pragma unroll
    for (int i = 0; i < 2; ++i)
#pragma unroll
        for (int j = 0; j < 2; ++j) {
            int col = (wn * 2 + j) * 32 + (lane & 31);
#pragma unroll
            for (int r = 0; r < 16; ++r) { int row = (wm * 2 + i) * 32 + crow(r, lane); st[row * 128 + col] = acc[i][j][r]; }
        }
}

DEV void xcd_range(int bid, int nb, int N, int& first, int& end, int& stride) {
    if (nb % 8 != 0) { first = bid; end = N; stride = nb; return; }
    int g = bid & 7, j = bid >> 3; stride = nb >> 3;
    int s0 = (int)(((long long)g * N) / 8); end = (int)(((long long)(g + 1) * N) / 8); first = s0 + j;
}
DEV void tile_decode(int L, int NTM, int NTN, int& tm, int& tn) {
    constexpr int GM = 8; const int full = NTM / GM, rem = NTM % GM; const int nf = full * GM * NTN;
    if (L < nf) { int grp = L / (GM * NTN), r = L % (GM * NTN); tn = r / GM; tm = grp * GM + r % GM; }
    else { int r = L - nf; tn = r / rem; tm = full * GM + r % rem; }
}
constexpr int EPI_OFF = 32768;
template <class Rows, class Epi>
DEV void gemm_tiles(int first, int ntiles, int stride, int K, char* smem, const bf16_t* zrow, Rows rows, Epi epi) {
    typedef GemmCfg<2, 2, 2, 2> C;
    const int tid = get_tid(), lane = tid & 63, wid = tid >> 6, wm = wid >> 1, wn = wid & 1;
    if (first >= ntiles) return;
    const bf16_t* ap[4]; const bf16_t* bp[4];
    auto setptrs = [&](int t) {
#pragma unroll
        for (int i = 0; i < 4; ++i) {
            int row = (i * 4 + wid) * 8 + (lane >> 3);
            const bf16_t* pa = rows(t, 0, row); ap[i] = pa ? pa + swz(row, lane & 7) * 8 : nullptr;
            const bf16_t* pb = rows(t, 1, row); bp[i] = pb ? pb + swz(row, lane & 7) * 8 : nullptr;
        }
    };
    auto stage_load = [&](int buf, int k0) {
        bf16_t* sa = (bf16_t*)(smem + buf * C::STAGE); bf16_t* sb = (bf16_t*)(smem + buf * C::STAGE + C::A_BYTES);
#pragma unroll
        for (int i = 0; i < 4; ++i) glds16(ap[i] ? ap[i] + k0 : zrow, sa + (i * 4 + wid) * 512 + lane * 8);
#pragma unroll
        for (int i = 0; i < 4; ++i) glds16(bp[i] ? bp[i] + k0 : zrow, sb + (i * 4 + wid) * 512 + lane * 8);
    };
    const int KT = K / 64;
    __syncthreads();
    setptrs(first); stage_load(0, 0);
    glds_wait();
    __syncthreads();
    for (int t = first; t < ntiles; t += stride) {
        f32x16 acc[2][2];
#pragma unroll
        for (int i = 0; i < 2; ++i)
#pragma unroll
            for (int j = 0; j < 2; ++j)
#pragma unroll
                for (int r = 0; r < 16; ++r) acc[i][j][r] = 0.f;
        for (int kt = 0; kt < KT; ++kt) {
            if (kt + 1 < KT) stage_load((kt + 1) & 1, (kt + 1) * 64);
            else if (t + stride < ntiles) { setptrs(t + stride); stage_load(0, 0); }
            const bf16_t* sa = (const bf16_t*)(smem + (kt & 1) * C::STAGE); const bf16_t* sb = (const bf16_t*)((const char*)sa + C::A_BYTES);
#pragma unroll
            for (int ks = 0; ks < 4; ++ks) {
                bf16x8 af[2], bfr[2];
                const int c = ks * 2 + (lane >> 5);
#pragma unroll
                for (int i = 0; i < 2; ++i) { int r = (wm * 2 + i) * 32 + (lane & 31); af[i] = *(const bf16x8*)(sa + r * 64 + swz(r, c) * 8); }
#pragma unroll
                for (int j = 0; j < 2; ++j) { int r = (wn * 2 + j) * 32 + (lane & 31); bfr[j] = *(const bf16x8*)(sb + r * 64 + swz(r, c) * 8); }
#pragma unroll
                for (int i = 0; i < 2; ++i)
#pragma unroll
                    for (int j = 0; j < 2; ++j) acc[i][j] = mfma32(af[i], bfr[j], acc[i][j]);
            }
            glds_wait();
            __syncthreads();
        }
        epi(t, acc);
        __syncthreads();
    }
}
constexpr int G2_STAGE = (256 + 128) * 64;
#ifdef EMU
DEV void lds_barrier() { __syncthreads(); }
template <int N> DEV void vm_wait() {}
#else
DEV void lds_barrier() { asm volatile("s_waitcnt lgkmcnt(0)" ::: "memory"); __builtin_amdgcn_s_barrier(); asm volatile("" ::: "memory"); }
template <int N> DEV void vm_wait() { asm volatile("s_waitcnt vmcnt(%0)" :: "n"(N) : "memory"); }
#endif
template <int MODE = 0, class Rows, class Epi>
DEV void gemm_tiles256(int first, int end, int stride, int K, char* smem, const bf16_t* zrow, Rows rows, Epi epi) {
    const int tid = get_tid(), lane = tid & 63, wid = tid >> 6, wm = wid >> 1, wn = wid & 1;
    if (first >= end) return;
    const int nt = (end - first + stride - 1) / stride; const int KT = K / 32; const int G = nt * KT;
    unsigned ap[4], bp[2];
    auto setptrs = [&](int t) {
#pragma unroll
        for (int i = 0; i < 4; ++i) { int row = (i * 4 + wid) * 16 + (lane >> 2); const bf16_t* pa = rows(t, 0, row); ap[i] = pa ? (unsigned)(pa + swz4(row, lane & 3) * 8 - zrow) : 0u; }
#pragma unroll
        for (int i = 0; i < 2; ++i) { int row = (i * 4 + wid) * 16 + (lane >> 2); const bf16_t* pb = rows(t, 1, row); bp[i] = pb ? (unsigned)(pb + swz4(row, lane & 3) * 8 - zrow) : 0u; }
    };
    int lg = 0, lkt = 0, lli = 0, lst = 0;
    auto issue = [&]() {
        if (lkt == 0) setptrs(first + lli * stride);
        bf16_t* sa = (bf16_t*)(smem + lst * G2_STAGE); bf16_t* sb = (bf16_t*)(smem + lst * G2_STAGE + 256 * 64);
        if (MODE != 2) {
#pragma unroll
        for (int i = 0; i < 4; ++i) glds16(ap[i] ? zrow + (int)(ap[i] + lkt * 32) : zrow, sa + (i * 4 + wid) * 512 + lane * 8);
#pragma unroll
        for (int i = 0; i < 2; ++i) glds16(bp[i] ? zrow + (int)(bp[i] + lkt * 32) : zrow, sb + (i * 4 + wid) * 512 + lane * 8);
        }
        ++lg; if (++lkt == KT) { lkt = 0; ++lli; } if (++lst == 3) lst = 0;
    };
    __syncthreads();
    issue(); if (G > 1) issue();
    int g = 0, cst = 0;
    for (int li = 0; li < nt; ++li) {
        f32x16 acc[4][2];
#pragma unroll
        for (int i = 0; i < 4; ++i)
#pragma unroll
            for (int j = 0; j < 2; ++j)
#pragma unroll
                for (int r = 0; r < 16; ++r) acc[i][j][r] = 0.f;
        for (int kt = 0; kt < KT; ++kt, ++g) {
            if (g + 1 < G) vm_wait<6>(); else vm_wait<0>();
            lds_barrier();
            if (lg < G) issue();
            const bf16_t* sa = (const bf16_t*)(smem + cst * G2_STAGE); const bf16_t* sb = sa + 256 * 32;
            if (MODE != 1)
#pragma unroll
            for (int ks = 0; ks < 2; ++ks) {
                bf16x8 bfr[2];
                const int c = ks * 2 + (lane >> 5);
#pragma unroll
                for (int j = 0; j < 2; ++j) { int r = wn * 64 + j * 32 + (lane & 31); bfr[j] = *(const bf16x8*)(sb + r * 32 + swz4(r, c) * 8); }
#pragma unroll
                for (int ip = 0; ip < 2; ++ip) {
                    bf16x8 af[2];
#pragma unroll
                    for (int i = 0; i < 2; ++i) { int r = wm * 128 + (ip * 2 + i) * 32 + (lane & 31); af[i] = *(const bf16x8*)(sa + r * 32 + swz4(r, c) * 8); }
#pragma unroll
                    for (int i = 0; i < 2; ++i)
#pragma unroll
                        for (int j = 0; j < 2; ++j) acc[ip * 2 + i][j] = mfma32(af[i], bfr[j], acc[ip * 2 + i][j]);
                }
            }
            if (kt + 1 < KT) { if (++cst == 3) cst = 0; }
        }
        lds_barrier();
        epi(first + li * stride, acc, smem + cst * G2_STAGE);
        vm_wait<0>();
        if (++cst == 3) cst = 0;
    }
    __syncthreads();
}
template <class F, class S>
DEV void epi256_bf16(const f32x16 (&acc)[4][2], char* stg, int tid, F f, S store) {
    const int lane = tid & 63, wid = tid >> 6, wm = wid >> 1, wn = wid & 1;
    bf16_t* st = (bf16_t*)stg;
#pragma unroll
    for (int q = 0; q < 4; ++q) {
        if (wm == (q >> 1)) {
#pragma unroll
            for (int ii = 0; ii < 2; ++ii)
#pragma unroll
                for (int j = 0; j < 2; ++j) {
                    int col = wn * 64 + j * 32 + (lane & 31);
#pragma unroll
                    for (int r = 0; r < 16; ++r) { int row = ii * 32 + crow(r, lane); st[row * CLD + col] = f2bf(f(acc[(q & 1) * 2 + ii][j][r], q * 64 + row, col)); }
                }
        }
        lds_barrier();
        { const int t2 = launder(tid);
#pragma unroll
        for (int k = 0; k < 4; ++k) { int id = t2 + NTHR * k; int row = id >> 4, c = id & 15; store(q * 64 + row, c, *(const u32x4*)(st + row * CLD + c * 8)); } }
        lds_barrier();
    }
}
template <class S>
DEV void epi256_f32(const f32x16 (&acc)[4][2], char* stg, int tid, S store) {
    const int lane = tid & 63, wid = tid >> 6, wm = wid >> 1, wn = wid & 1;
    float* st = (float*)stg;
#pragma unroll
    for (int q = 0; q < 8; ++q) {
        if (wm == (q >> 2)) {
#pragma unroll
            for (int j = 0; j < 2; ++j) {
                int col = wn * 64 + j * 32 + (lane & 31);
#pragma unroll
                for (int r = 0; r < 16; ++r) st[crow(r, lane) * 128 + col] = acc[q & 3][j][r];
            }
        }
        lds_barrier();
        { const int t2 = launder(tid);
#pragma unroll
        for (int k = 0; k < 4; ++k) { int id = t2 + NTHR * k; int row = id >> 5, c = id & 31; store(q * 32 + row, c, *(const f32x4*)(st + row * 128 + c * 4)); } }
        lds_barrier();
    }
}

template <class St>
DEV void epi_f32_halves(const f32x16 (&acc)[2][2], char* smem, int tid, St store) {
    const int lane = tid & 63, wid = tid >> 6, wm = wid >> 1, wn = wid & 1;
    float* st = (float*)(smem + EPI_OFF);
#pragma unroll
    for (int half = 0; half < 2; ++half) {
        if (wm == half) {
#pragma unroll
            for (int i = 0; i < 2; ++i)
#pragma unroll
                for (int j = 0; j < 2; ++j) {
                    int col = (wn * 2 + j) * 32 + (lane & 31);
#pragma unroll
                    for (int r = 0; r < 16; ++r) st[(i * 32 + crow(r, lane)) * 128 + col] = acc[i][j][r];
                }
        }
        __syncthreads();
#pragma unroll
        for (int q = 0; q < 8; ++q) { int id = tid + NTHR * q; int row = id >> 5, c = id & 31; store(half * 64 + row, c, *(const f32x4*)(st + row * 128 + c * 4)); }
        __syncthreads();
    }
}

DEV void phase_prep(const Params& p, int bid, int nb, char* smem) {
    const int tid = get_tid();
    float* mods = (float*)(p.ws + OFF_MODS);
    float* sc = (float*)smem;
    for (int i0 = tid; i0 < (BATCH + 1) * 1024; i0 += NTHR * 4) {
        float cv[4];
#pragma unroll
        for (int q = 0; q < 4; ++q) { int i = i0 + q * NTHR; int m = i >> 10, k = i & 1023; cv[q] = i < (BATCH + 1) * 1024 ? (m < BATCH ? p.c[m * 1024 + k] : p.c_ctx[k]) : 0.f; }
#pragma unroll
        for (int q = 0; q < 4; ++q) { int i = i0 + q * NTHR; if (i < (BATCH + 1) * 1024) sc[i] = siluf_(cv[q]); }
    }
    __syncthreads();
    float* red = sc + (BATCH + 1) * 1024;
    const int nitems = 2 * 192;
    for (int it = bid; it < nitems; it += nb) {
        int l = it / 192, n = (it % 192) * 32 + (tid & 31), kg = tid >> 5;
        float a[BATCH + 1];
#pragma unroll
        for (int m = 0; m <= BATCH; ++m) a[m] = 0.f;
        const float* w = p.ada_w + (size_t)l * 1024 * 6144 + n;
        for (int k = kg * 128; k < kg * 128 + 128; k += 16) {
            float wv[16];
#pragma unroll
            for (int j = 0; j < 16; ++j) wv[j] = w[(size_t)(k + j) * 6144];
#pragma unroll
            for (int j = 0; j < 16; ++j)
#pragma unroll
                for (int m = 0; m <= BATCH; ++m) a[m] += sc[m * 1024 + k + j] * wv[j];
        }
        for (int q = 0; q < 8; ++q) {
            if (kg == q) {
#pragma unroll
                for (int m = 0; m <= BATCH; ++m) red[m * 32 + (tid & 31)] = (q ? red[m * 32 + (tid & 31)] : 0.f) + a[m];
            }
            __syncthreads();
        }
        for (int i = tid; i < (BATCH + 1) * 32; i += NTHR) {
            int m = i >> 5, nn = i & 31; int col = (it % 192) * 32 + nn;
            mods[((size_t)l * (BATCH + 1) + m) * 6144 + col] = red[i] + p.ada_b[l * 6144 + col];
        }
        __syncthreads();
    }
    if (bid == 0 && tid < 64) ((unsigned*)(p.ws + OFF_ZERO))[tid] = 0u;
    float* lb = (float*)(p.ws + OFF_LB);
    for (int i = bid * NTHR + tid; i < 512; i += nb * NTHR) {
        float l0 = p.hg_lb[i], l1 = p.hg_lb[512 + i]; float mx = fmaxf(l0, l1); float e0 = expf(l0 - mx), e1 = expf(l1 - mx);
        lb[i] = 0.f; lb[512 + i] = e1 / (e0 + e1);
    }
    float* rope = (float*)(p.ws + OFF_ROPE);
    for (int i = bid * NTHR + tid; i < SEQ * 16; i += nb * NTHR) {
        int n = i >> 4, j = i & 7, isc = (i >> 3) & 1;
        float pos = isc ? (float)(n & 63) : (float)(n >> 6);
        float inv = powf(10000.f, -(float)(2 * j) / 16.f); float ang = pos * inv;
        rope[n * 32 + isc * 16 + j] = cosf(ang); rope[n * 32 + isc * 16 + 8 + j] = sinf(ang);
    }
}

DEV int win_src_col(int n) { return n < 1024 ? n : (n < 2720 ? n + 16 : (n < 2736 ? n - 2720 + 1024 : -1)); }
DEV void phase_convert(const Params& p, int layer, int bid, int nb, char* smem, int part = 0, unsigned* queue = nullptr) {
    float* tile = (float*)smem;
    const int tid = get_tid();
    const int n_win = 4 * 44, n_wuq = 1 * 12, n_wukv = 1 * 16, n_wout = 4 * 16, n_wgu = NEXP * 4 * 32, n_wd = NEXP * 4 * 16, n_wr = 4;
    const int total = n_win + n_wuq + n_wukv + n_wout + n_wgu + n_wd + n_wr;
    const int n_small = n_win + n_wuq + n_wukv + n_wout;
    const int it_lo = part == 2 ? n_small : 0, it_hi = part == 1 ? n_small : total;
    int* s_next = (int*)(smem + 256 * 65 * 4);
    for (int it = it_lo + bid;; it += nb) {
        if (queue) {
            __syncthreads();
            if (tid == 0) *s_next = it_lo + (int)atomicAdd(queue, 1u);
            __syncthreads();
            it = *s_next;
        }
        if (it >= it_hi) break;
        int t = it, mat, K, ntn;
        const float* src = nullptr; const float* src2 = nullptr; const float* kscale = nullptr; bf16_t* dst; int ldsrc;
        if (t < n_win) { mat = 0; K = 1024; ntn = 44; src = p.w_in + (size_t)layer * 1024 * 2736; ldsrc = 2736; dst = (bf16_t*)(p.ws + OFF_WIN); }
        else if ((t -= n_win) < n_wuq) { mat = 1; K = 256; ntn = 12; src = p.mla_w_uq + (size_t)layer * 256 * 768; ldsrc = 768; kscale = p.mla_q_norm_g + layer * 256; dst = (bf16_t*)(p.ws + OFF_WUQ); }
        else if ((t -= n_wuq) < n_wukv) { mat = 2; K = 128; ntn = 16; src = p.mla_w_ukv + (size_t)layer * 128 * 1024; ldsrc = 1024; kscale = p.mla_kv_norm_g + layer * 128; dst = (bf16_t*)(p.ws + OFF_WUKV); }
        else if ((t -= n_wukv) < n_wout) { mat = 3; K = 1024; ntn = 16; src = p.w_out + (size_t)layer * 1024 * 1024; ldsrc = 1024; dst = (bf16_t*)(p.ws + OFF_WOUT); }
        else if ((t -= n_wout) < n_wgu) { mat = 4; K = 1024; ntn = 32; int e = t / 128; t -= e * 128; src = p.ex_w_gate + ((size_t)layer * NEXP + e) * 1024 * 1024; src2 = p.ex_w_up + ((size_t)layer * NEXP + e) * 1024 * 1024; ldsrc = 1024; dst = (bf16_t*)(p.ws + OFF_WGU) + (size_t)e * 2048 * 1024; }
        else if ((t -= n_wgu) < n_wd) { mat = 5; K = 1024; ntn = 16; int e = t / 64; t -= e * 64; src = p.ex_w_down + ((size_t)layer * NEXP + e) * 1024 * 1024; ldsrc = 1024; dst = (bf16_t*)(p.ws + OFF_WD) + (size_t)e * 1024 * 1024; }
        else { t -= n_wd; mat = 6; K = 1024; ntn = 1; src = p.router_w + (size_t)layer * 1024 * 16; ldsrc = 16; dst = (bf16_t*)(p.ws + OFF_WR); }
        int kt = t / ntn, nt = t % ntn; int k0 = kt * 256, n0 = nt * 64; const int kn = K - k0 < 256 ? K - k0 : 256;
        {
            int tx = tid & 63, ty = tid >> 6; int n = n0 + tx; const float* sp = src; int sc;
            if (mat == 0) sc = win_src_col(n);
            else if (mat == 4) { sc = (n >> 6) * 32 + (n & 31); if (n & 32) sp = src2; }
            else if (mat == 6) sc = (n < 16) ? n : -1;
            else sc = n;
            float v[64];
#pragma unroll
            for (int q = 0; q < 64; ++q) { int kk = ty + 4 * q; v[q] = (sc >= 0 && kk < kn) ? ld_nt(sp + (size_t)(k0 + kk) * ldsrc + sc) : 0.f; }
            if (kscale) {
#pragma unroll
                for (int q = 0; q < 64; ++q) { int kk = ty + 4 * q; if (kk < kn) v[q] *= kscale[k0 + kk]; }
            }
#pragma unroll
            for (int q = 0; q < 64; ++q) tile[(ty + 4 * q) * 65 + tx] = v[q];
        }
        __syncthreads();
        {
            int nn = tid >> 2, part = tid & 3; int n = n0 + nn;
            if (!(mat == 6 && n >= 32) && part * 64 < kn) {
#pragma unroll
                for (int g = 0; g < 8; ++g) {
                    unsigned w[4];
#pragma unroll
                    for (int j = 0; j < 4; ++j) w[j] = pack2(tile[(part * 64 + g * 8 + 2 * j) * 65 + nn], tile[(part * 64 + g * 8 + 2 * j + 1) * 65 + nn]);
                    *(u32x4*)(dst + (size_t)n * K + k0 + part * 64 + g * 8) = (u32x4){w[0], w[1], w[2], w[3]};
                }
            }
        }
        __syncthreads();
    }
    float* bperm = (float*)(p.ws + OFF_BPERM);
    if (part != 2) for (int i = bid * NTHR + tid; i < DIN_P; i += nb * NTHR) { int sc = win_src_col(i); bperm[i] = sc >= 0 ? p.b_in[layer * 2736 + sc] : 0.f; }
}

DEV const float* xrow_ptr(const Params& p, int layer, int r, bool post) {
    int b = r / T, t = r % T;
    if (t < CTXL) return ((layer == 0 && !post) ? p.ctx : (const float*)(p.ws + OFF_CX)) + ((size_t)b * CTXL + t) * D;
    return ((layer == 0 && !post) ? p.x : (const float*)p.out) + ((size_t)b * SEQ + (t - CTXL)) * D;
}
DEV void ffn_sum(const Params& p, int clayer, int r, int lane, f32x4 (&s)[4]);
DEV void phase_norm(const Params& p, int layer, int which, int bid, int nb, int clayer = -1) {
    const int tid = get_tid(), lane = tid & 63, wid = tid >> 6;
    const float* g = (which ? p.norm2_g : p.norm1_g) + layer * D;
    const float* mods = (const float*)(p.ws + OFF_MODS) + (size_t)layer * (BATCH + 1) * 6144;
    bf16_t* h = (bf16_t*)(p.ws + OFF_H);
    const bool need_ctx = layer == 0;
    const int W = nb * 4, w = bid * 4 + wid; const bool smaj = W % BATCH == 0;
    const int tstep = smaj ? W / BATCH : 1;
    f32x4 gsc[4], shv[4], g2v[4]; int cur_id = -1;
    for (int it = smaj ? w / BATCH : w; it < (smaj ? T : R); it += smaj ? tstep : W) {
        const int r = smaj ? (w % BATCH) * T + it : it;
        int b = r / T, t = r % T;
        if (which == 1 && t < CTXL && !need_ctx) continue;
        const float* xr = xrow_ptr(p, layer, r, which == 1);
        const int mod_id = t < CTXL ? BATCH : b;
        if (mod_id != cur_id) {
            cur_id = mod_id;
            const float* mrow = mods + (size_t)mod_id * 6144 + (which ? 3 * 1024 : 0);
#pragma unroll
            for (int i = 0; i < 4; ++i) { int c = i * 256 + lane * 4; f32x4 gg = *(const f32x4*)(g + c), sc = *(const f32x4*)(mrow + 1024 + c); shv[i] = *(const f32x4*)(mrow + c);
                gsc[i] = (f32x4){gg[0] * (1.f + sc[0]), gg[1] * (1.f + sc[1]), gg[2] * (1.f + sc[2]), gg[3] * (1.f + sc[3])}; }
            if (clayer >= 0) {
                const float* g2 = (const float*)(p.ws + OFF_MODS) + ((size_t)clayer * (BATCH + 1) + mod_id) * 6144 + 5 * 1024;
#pragma unroll
                for (int i = 0; i < 4; ++i) g2v[i] = *(const f32x4*)(g2 + i * 256 + lane * 4);
            }
        }
        f32x4 v[4]; float ss = 0.f;
#pragma unroll
        for (int i = 0; i < 4; ++i) v[i] = *(const f32x4*)(xr + i * 256 + lane * 4);
        if (clayer >= 0) {
            f32x4 sacc[4]; ffn_sum(p, clayer, r, lane, sacc);
#pragma unroll
            for (int i = 0; i < 4; ++i) { int c = i * 256 + lane * 4; v[i] = v[i] + g2v[i] * sacc[i]; *(f32x4*)((float*)xr + c) = v[i]; }
        }
#pragma unroll
        for (int i = 0; i < 4; ++i) ss += v[i][0] * v[i][0] + v[i][1] * v[i][1] + v[i][2] * v[i][2] + v[i][3] * v[i][3];
#pragma unroll
        for (int m = 1; m < 64; m <<= 1) ss += shfl_xor_f(ss, m);
        float rstd = rsqrtf(ss * (1.f / 1024.f) + EPS);
#pragma unroll
        for (int i = 0; i < 4; ++i) {
            int c = i * 256 + lane * 4;
            float o0 = v[i][0] * rstd * gsc[i][0] + shv[i][0], o1 = v[i][1] * rstd * gsc[i][1] + shv[i][1];
            float o2 = v[i][2] * rstd * gsc[i][2] + shv[i][2], o3 = v[i][3] * rstd * gsc[i][3] + shv[i][3];
            *(u32x2*)(h + (size_t)r * D + c) = (u32x2){pack2(o0, o1), pack2(o2, o3)};
        }
    }
}

DEV void phase_proj(const Params& p, int layer, int bid, int nb, char* smem) {
    const bf16_t* h = (const bf16_t*)(p.ws + OFF_H); const bf16_t* W = (const bf16_t*)(p.ws + OFF_WIN);
    const float* bperm = (const float*)(p.ws + OFF_BPERM);
    bf16_t* projb = (bf16_t*)(p.ws + OFF_PB); float* pref = (float*)(p.ws + OFF_PF); float* gates = (float*)(p.ws + OFF_GT);
    const int tid = get_tid(); const int lane = tid & 63, wid = tid >> 6, wm = wid >> 1, wn = wid & 1;
    constexpr int NTN = DIN_P / 128, NTM = R / 256;
    int tf, te, tstr; xcd_range(bid, nb, NTM * NTN, tf, te, tstr);
    gemm_tiles256(tf, te, tstr, 1024, smem, (const bf16_t*)(p.ws + OFF_ZERO),
        [&](int t, int which, int row) { int tm, tn; tile_decode(t, NTM, NTN, tm, tn); return which ? W + (size_t)(tn * 128 + row) * 1024 : h + (size_t)(tm * 256 + row) * D; },
        [&](int t, f32x16 (&acc)[4][2], char* stg) {
            int tm_, tn_; tile_decode(t, NTM, NTN, tm_, tn_);
            const int r0 = tm_ * 256, n0 = tn_ * 128;
            float bias[2];
#pragma unroll
            for (int j = 0; j < 2; ++j) bias[j] = bperm[n0 + wn * 64 + j * 32 + (lane & 31)];
            if (n0 < 1792 || (n0 >= 2304 && n0 < 2688)) {
                const int cdst = n0 < 1792 ? n0 : n0 - 512;
                epi256_bf16(acc, stg, tid, [&](float v, int, int col) { return v + bias[(col >> 5) & 1]; },
                            [&](int row, int c, u32x4 v) { *(u32x4*)(projb + (size_t)(r0 + row) * PBW + cdst + c * 8) = v; });
            } else if (n0 < 2304) {
#pragma unroll
                for (int i = 0; i < 4; ++i)
#pragma unroll
                    for (int j = 0; j < 2; ++j)
#pragma unroll
                        for (int r = 0; r < 16; ++r) acc[i][j][r] += bias[j];
                epi256_f32(acc, stg, tid, [&](int row, int c, f32x4 v) { *(f32x4*)(pref + (size_t)(r0 + row) * 512 + (n0 - 1792) + c * 4) = v; });
            } else {
#pragma unroll
                for (int i = 0; i < 4; ++i)
#pragma unroll
                    for (int j = 0; j < 2; ++j)
#pragma unroll
                        for (int r = 0; r < 16; ++r) acc[i][j][r] += bias[j];
                epi256_f32(acc, stg, tid, [&](int row, int c, f32x4 v) {
                    if (c < 8) { *(u32x2*)(projb + (size_t)(r0 + row) * PBW + PB_KR + c * 4) = (u32x2){pack2(v[0], v[1]), pack2(v[2], v[3])}; }
                    else if (c < 12) { *(f32x4*)(gates + (size_t)(r0 + row) * 16 + (c - 8) * 4) = v; } });
            }
        });
}

constexpr int SLD = 72;
DEV void mm64(f32x16& acc, const bf16_t* sA, const bf16_t* sBt, int wr, int wc, int lane) {
#pragma unroll
    for (int ks = 0; ks < 4; ++ks) {
        bf16x8 a = *(const bf16x8*)(sA + (wr * 32 + (lane & 31)) * SLD + ks * 16 + (lane >> 5) * 8);
        bf16x8 b = *(const bf16x8*)(sBt + (wc * 32 + (lane & 31)) * SLD + ks * 16 + (lane >> 5) * 8);
        acc = mfma32(a, b, acc);
    }
}
DEV int chunk_base(int dir, int c) { if (dir == 0) return c * 64; return (64 * c < CTXL) ? CTXL - 64 * (c + 1) : T + CTXL - 64 * (c + 1); }

DEV void mm64_nx(f32x16& acc, const bf16_t* sA, const bf16_t* X, int wr, int wc, int lane) {
#pragma unroll
    for (int ks = 0; ks < 4; ++ks) {
        bf16x8 a = *(const bf16x8*)(sA + (wr * 32 + (lane & 31)) * SLD + ks * 16 + (lane >> 5) * 8);
        bf16x8 b = tr_frag(X, SLD, ks, wc * 32, lane);
        acc = mfma32(a, b, acc);
    }
}
DEV int scan_tok(int dir, int j) { return dir ? 63 - j : j; }

template <bool NOOUT = false>
DEV void scan_ml(const Params& p, int layer, int b, int hd, int dir, char* smem) {
    const int tid = get_tid(), lane = tid & 63, wid = tid >> 6, wr = wid >> 1, wc = wid & 1;
    const bool need_ctx = layer == 0;
    const bf16_t* projb = (const bf16_t*)(p.ws + OFF_PB); const float* gates = (const float*)(p.ws + OFF_GT);
    bf16_t* outp = (bf16_t*)(p.ws + OFF_H) + (size_t)dir * R * 256;
    constexpr int RLD = 136;
    bf16_t* sRaw = (bf16_t*)smem;
    bf16_t* sQ = sRaw + 66 * RLD; bf16_t* sK = sQ + 64 * SLD; bf16_t* sV = sK + 64 * SLD; bf16_t* sP = sV + 64 * SLD; bf16_t* sCt = sP + 64 * SLD;
    float* fb = (float*)(sCt + 64 * SLD);
    float* s_rowf = fb, *s_wst = fb + 64, *s_emt = fb + 128, *s_e = fb + 192, *s_n = fb + 256, *s_sc = fb + 320, *s_cw = fb + 336;
    bf16_t* s_nh = (bf16_t*)(s_cw + 512); bf16_t* s_nl = s_nh + 64;
    float* s_wsv = s_cw + 512 + 64; float* s_fdv = s_wsv + 64;
    const bf16x8 ones = {0x3F80, 0x3F80, 0x3F80, 0x3F80, 0x3F80, 0x3F80, 0x3F80, 0x3F80};
    f32x16 cst;
#pragma unroll
    for (int r = 0; r < 16; ++r) cst[r] = 0.f;
    __syncthreads();
    for (int i = tid; i < 64 * SLD; i += NTHR) sCt[i] = 0;
    if (tid < 64) { s_n[tid] = 0.f; s_nh[tid] = 0; s_nl[tid] = 0; }
    if (tid < 128) {
        int col = (tid < 64 ? 0 : 256) + hd * 64 + (tid & 63);
        const float* cw = p.ml_conv_w + layer * 3 * 512;
        s_cw[tid] = cw[col]; s_cw[128 + tid] = cw[512 + col]; s_cw[256 + tid] = cw[1024 + col]; s_cw[384 + tid] = p.ml_conv_b[layer * 512 + col];
    }
    float mprev = 0.f;
    const size_t rb = (size_t)b * T;
    u32x4 praw[5], pv[2]; float pig = 0.f, pfg = 0.f;
    auto prefetch = [&](int c) {
        const int base = chunk_base(dir, c); const int seg_lo = base < CTXL ? 0 : CTXL, seg_hi = base < CTXL ? CTXL : T;
#pragma unroll
        for (int i = 0; i < 5; ++i) {
            int id = tid + NTHR * i; int row = id >> 4, cg = id & 15; int tok = base - 1 + row;
            praw[i] = (u32x4){0, 0, 0, 0};
            if (id < 66 * 16 && tok >= seg_lo && tok < seg_hi) praw[i] = *(const u32x4*)(projb + (rb + tok) * PBW + PB_MLQK + (cg < 8 ? 0 : 256) + hd * 64 + (cg & 7) * 8);
        }
#pragma unroll
        for (int i = 0; i < 2; ++i) { int id = tid + NTHR * i; int row = id >> 3, cg = id & 7; pv[i] = *(const u32x4*)(projb + (rb + base + row) * PBW + PB_MLV + hd * 64 + cg * 8); }
        if (tid < 64) { const float* g = gates + (rb + base + scan_tok(dir, tid)) * 16 + dir * 8 + hd; pig = g[0]; pfg = g[4]; }
    };
    prefetch(0);
    for (int c = 0; c < NC; ++c) {
        const int base = chunk_base(dir, c);
        const bool want_out = !NOOUT && (need_ctx || base >= CTXL);
#pragma unroll
        for (int i = 0; i < 5; ++i) { int id = tid + NTHR * i; if (id < 66 * 16) *(u32x4*)(sRaw + (id >> 4) * RLD + (id & 15) * 8) = praw[i]; }
#pragma unroll
        for (int i = 0; i < 2; ++i) { int id = tid + NTHR * i; *(u32x4*)(sV + (id >> 3) * SLD + (id & 7) * 8) = pv[i]; }
        if (tid < 64) {
            float ig = pig, lf = logsigmoidf_(pfg);
            float bc = wave_scan_add(lf, lane);
            float a = ig - bc, pm = wave_scan_max(a, lane);
            float mu = shfl_idx_f(pm, 63);
            float mm_ = fmaxf(mprev, pm);
            int u = scan_tok(dir, lane);
            s_rowf[u] = __expf(fminf(mu - mm_, 80.f)); s_wst[u] = __expf(mprev - mm_); s_emt[u] = __expf(-(bc + mm_)); s_e[u] = __expf(a - mu);
            float mx = fmaxf(mprev, mu);
            s_wsv[lane] = __expf(mprev - mx); s_fdv[lane] = __expf(mu - mx);
            mprev = shfl_idx_f(bc, 63) + mx;
        }
        if (c + 1 < NC) prefetch(c + 1);
        __syncthreads();
#pragma unroll
        for (int i = 0; i < 4; ++i) {
            int id = tid + NTHR * i; int u = id >> 4, cg = id & 15;
            const bf16_t* r1 = sRaw + (u + 1) * RLD + cg * 8;
            u32x4 c0 = *(const u32x4*)(r1 - RLD), c1 = *(const u32x4*)r1, c2 = *(const u32x4*)(r1 + RLD);
            float sc = cg < 8 ? 1.f : 0.125f * s_e[u];
            float o[8];
#pragma unroll
            for (int q = 0; q < 8; ++q) {
                unsigned w0 = c0[q >> 1], w1 = c1[q >> 1], w2 = c2[q >> 1];
                float a0 = bf2f((bf16_t)((q & 1) ? w0 >> 16 : w0 & 0xffff)), a1 = bf2f((bf16_t)((q & 1) ? w1 >> 16 : w1 & 0xffff)), a2 = bf2f((bf16_t)((q & 1) ? w2 >> 16 : w2 & 0xffff));
                int cc = cg * 8 + q;
                o[q] = siluf_(s_cw[cc] * a0 + s_cw[128 + cc] * a1 + s_cw[256 + cc] * a2 + s_cw[384 + cc]) * sc;
            }
            *(u32x4*)((cg < 8 ? sQ : sK) + u * SLD + (cg & 7) * 8) = (u32x4){pack2(o[0], o[1]), pack2(o[2], o[3]), pack2(o[4], o[5]), pack2(o[6], o[7])};
        }
        __syncthreads();
        f32x16 accn, accd;
#pragma unroll
        for (int r = 0; r < 16; ++r) { accn[r] = 0.f; accd[r] = 0.f; }
        if (want_out) {
            f32x16 acc;
#pragma unroll
            for (int r = 0; r < 16; ++r) acc[r] = 0.f;
            const bool skip = dir ? (wr == 1 && wc == 0) : (wr == 0 && wc == 1);
            if (!skip) mm64(acc, sQ, sK, wr, wc, lane);
            {
                int sidx = wc * 32 + (lane & 31);
#pragma unroll
                for (int r = 0; r < 16; ++r) {
                    int t = wr * 32 + crow(r, lane);
                    bool ok = dir ? (sidx >= t) : (sidx <= t);
                    sP[t * SLD + sidx] = f2bf(ok ? acc[r] * s_rowf[t] : 0.f);
                }
            }
            mm64(accn, sQ, sCt, wr, wc, lane);
#pragma unroll
            for (int ks = 0; ks < 4; ++ks) {
                bf16x8 a = *(const bf16x8*)(sQ + (wr * 32 + (lane & 31)) * SLD + ks * 16 + (lane >> 5) * 8);
                accd = mfma32(a, *(const bf16x8*)(s_nh + ks * 16 + (lane >> 5) * 8), accd);
                accd = mfma32(a, *(const bf16x8*)(s_nl + ks * 16 + (lane >> 5) * 8), accd);
            }
#pragma unroll
            for (int r = 0; r < 16; ++r) { float w = s_wst[wr * 32 + crow(r, lane)]; accn[r] *= w; accd[r] *= w; }
        }
        __syncthreads();
        if (want_out) {
#pragma unroll
            for (int ks = 0; ks < 4; ++ks) {
                bf16x8 a = *(const bf16x8*)(sP + (wr * 32 + (lane & 31)) * SLD + ks * 16 + (lane >> 5) * 8);
                accn = mfma32(a, tr_frag(sV, SLD, ks, wc * 32, lane), accn);
                accd = mfma32(a, ones, accd);
            }
            int v = wc * 32 + (lane & 31);
#pragma unroll
            for (int r = 0; r < 16; ++r) {
                int t = wr * 32 + crow(r, lane);
                float den = fmaxf(fabsf(accd[r]), s_emt[t]);
                outp[(rb + base + t) * 256 + hd * 64 + v] = f2bf(accn[r] * fast_rcp(den));
            }
        }
        {
            f32x16 x, nacc;
#pragma unroll
            for (int r = 0; r < 16; ++r) { x[r] = 0.f; nacc[r] = 0.f; }
#pragma unroll
            for (int ks = 0; ks < 4; ++ks) {
                bf16x8 a = tr_frag(sK, SLD, ks, wr * 32, lane);
                x = mfma32(a, tr_frag(sV, SLD, ks, wc * 32, lane), x);
                nacc = mfma32(a, ones, nacc);
            }
            const float ws = s_wsv[lane], fd = s_fdv[lane];
            int v = wc * 32 + (lane & 31);
#pragma unroll
            for (int r = 0; r < 16; ++r) { cst[r] = ws * cst[r] + fd * x[r]; sCt[v * SLD + wr * 32 + crow(r, lane)] = f2bf(cst[r]); }
            if (wc == 0 && (lane & 31) == 0) {
#pragma unroll
                for (int r = 0; r < 16; ++r) {
                    int k = wr * 32 + crow(r, lane); float nn = ws * s_n[k] + fd * nacc[r];
                    s_n[k] = nn; bf16_t hi = f2bf(nn); s_nh[k] = hi; s_nl[k] = f2bf(nn - bf2f(hi));
                }
            }
        }
        __syncthreads();
    }
}

template <bool NOOUT = false>
DEV void scan_hg(const Params& p, int layer, int b, int hd, int dir, char* smem) {
    const int tid = get_tid(), lane = tid & 63, wid = tid >> 6, wr = wid >> 1, wc = wid & 1;
    const bool need_ctx = layer == 0;
    const bf16_t* projb = (const bf16_t*)(p.ws + OFF_PB); const float* pref = (const float*)(p.ws + OFF_PF);
    bf16_t* outp = (bf16_t*)(p.ws + OFF_H) + (size_t)(2 + dir) * R * 256;
    const float* lbp = (const float*)(p.ws + OFF_LB) + layer * 512 + dir * 256 + hd * 64;
    bf16_t* sQs = (bf16_t*)smem; bf16_t* sKs = sQs + 64 * SLD; bf16_t* sV = sKs + 64 * SLD; bf16_t* sP = sV + 64 * SLD; bf16_t* sSt = sP + 64 * SLD;
    float* s_ps = (float*)(sSt + 64 * SLD);
    float* s_r = s_ps + 256; float* s_bend = s_r + 64;
    f32x16 st;
#pragma unroll
    for (int r = 0; r < 16; ++r) st[r] = 0.f;
    __syncthreads();
    const int k = tid & 63, part = tid >> 6;
    const float low = lbp[k];
    const size_t rb = (size_t)b * T;
    float ppre[16]; bf16_t pq[16]; u32x4 pv[2];
    auto prefetch = [&](int c) {
        const int base = chunk_base(dir, c);
#pragma unroll
        for (int i = 0; i < 16; ++i) {
            int tok = base + scan_tok(dir, part * 16 + i);
            ppre[i] = pref[(rb + tok) * 512 + dir * 256 + hd * 64 + k];
            pq[i] = projb[(rb + tok) * PBW + PB_HGQ + hd * 64 + k];
        }
#pragma unroll
        for (int i = 0; i < 2; ++i) { int id = tid + NTHR * i; int row = id >> 3, cg = id & 7; pv[i] = *(const u32x4*)(projb + (rb + base + row) * PBW + PB_HGV + hd * 64 + cg * 8); }
    };
    prefetch(0);
    for (int c = 0; c < NC; ++c) {
        const int base = chunk_base(dir, c);
        const bool want_out = !NOOUT && (need_ctx || base >= CTXL);
        float kk[16], lfc[16], qv[16]; float run = 0.f;
#pragma unroll
        for (int i = 0; i < 16; ++i) {
            float pre = ppre[i];
            float lf = (low == 0.f) ? logsigmoidf_(pre) : __logf(low + (1.f - low) * sigmoidf_(pre));
            kk[i] = (1.f - low) * sigmoidf_(-pre);
            run += lf; lfc[i] = run; qv[i] = siluf_(bf2f(pq[i]));
        }
        s_ps[part * 64 + k] = run;
#pragma unroll
        for (int i = 0; i < 2; ++i) { int id = tid + NTHR * i; *(u32x4*)(sV + (id >> 3) * SLD + (id & 7) * 8) = pv[i]; }
        if (c + 1 < NC) prefetch(c + 1);
        __syncthreads();
        float off = 0.f;
        for (int q = 0; q < part; ++q) off += s_ps[q * 64 + k];
#pragma unroll
        for (int i = 0; i < 16; ++i) lfc[i] += off;
        if (part == 1) s_r[k] = lfc[15];
        if (part == 3) s_bend[k] = lfc[15];
        __syncthreads();
        const float rref = s_r[k];
#pragma unroll
        for (int i = 0; i < 16; ++i) {
            int u = scan_tok(dir, part * 16 + i);
            sQs[u * SLD + k] = f2bf(qv[i] * __expf(lfc[i] - rref));
            sKs[u * SLD + k] = f2bf(kk[i] * __expf(rref - lfc[i]));
        }
        {
            int v = wc * 32 + (lane & 31);
#pragma unroll
            for (int r = 0; r < 16; ++r) { int kr = wr * 32 + crow(r, lane); sSt[v * SLD + kr] = f2bf(st[r] * __expf(s_r[kr])); }
        }
        __syncthreads();
        f32x16 acc;
#pragma unroll
        for (int r = 0; r < 16; ++r) acc[r] = 0.f;
        if (want_out) {
            f32x16 sacc;
#pragma unroll
            for (int r = 0; r < 16; ++r) sacc[r] = 0.f;
            const bool skip = dir ? (wr == 1 && wc == 0) : (wr == 0 && wc == 1);
            if (!skip) mm64(sacc, sQs, sKs, wr, wc, lane);
            int sidx = wc * 32 + (lane & 31);
#pragma unroll
            for (int r = 0; r < 16; ++r) { int t = wr * 32 + crow(r, lane); bool ok = dir ? (sidx >= t) : (sidx <= t); sP[t * SLD + sidx] = f2bf(ok ? sacc[r] : 0.f); }
            mm64(acc, sQs, sSt, wr, wc, lane);
        }
        __syncthreads();
        if (want_out) {
            mm64_nx(acc, sP, sV, wr, wc, lane);
            int v = wc * 32 + (lane & 31);
#pragma unroll
            for (int r = 0; r < 16; ++r) { int t = wr * 32 + crow(r, lane); outp[(rb + base + t) * 256 + hd * 64 + v] = f2bf(acc[r]); }
        }
        {
            f32x16 x;
#pragma unroll
            for (int r = 0; r < 16; ++r) x[r] = 0.f;
#pragma unroll
            for (int ks = 0; ks < 4; ++ks) x = mfma32(tr_frag(sKs, SLD, ks, wr * 32, lane), tr_frag(sV, SLD, ks, wc * 32, lane), x);
#pragma unroll
            for (int r = 0; r < 16; ++r) { int kr = wr * 32 + crow(r, lane); float be = s_bend[kr]; st[r] = __expf(be) * st[r] + __expf(be - s_r[kr]) * x[r]; }
        }
        __syncthreads();
    }
}
DEV void phase_scan(const Params& p, int layer, int bid, int nb, char* smem) {
    const int nchains = BATCH * 4 * 2 * 2;
    for (int it = bid; it < nchains; it += nb) {
        int type = it & 1, dir = (it >> 1) & 1, hd = (it >> 2) & 3, b = it >> 4;
        if (type == 0) scan_ml(p, layer, b, hd, dir, smem); else scan_hg(p, layer, b, hd, dir, smem);
    }
}
template <int WHICH>
DEV void phase_scan_probe(const Params& p, int layer, int bid, int nb, char* smem) {
    const int nchains = BATCH * 4 * 2 * 2;
    for (int it = bid; it < nchains; it += nb) {
        int type = it & 1, dir = (it >> 1) & 1, hd = (it >> 2) & 3, b = it >> 4;
        if (WHICH == 0) { if (type == 0) scan_ml<true>(p, layer, b, hd, dir, smem); else scan_hg<true>(p, layer, b, hd, dir, smem); }
        if (WHICH == 1 && type == 0) scan_ml(p, layer, b, hd, dir, smem);
        if (WHICH == 2 && type == 1) scan_hg(p, layer, b, hd, dir, smem);
    }
}

template <int TN, class ARows, class BRows, class Epi>
DEV void gemm_stream_w4(int first, int end, int stride, int nsub, int KT, char* smem, const bf16_t* zrow, ARows arows, BRows brows, Epi epi) {
    constexpr int STAGE = 32768, A_BYTES = 16384;
    const int tid = get_tid(), lane = tid & 63, wid = tid >> 6;
    if (first >= end) return;
    const int nt = (end - first + stride - 1) / stride; const int G = nt * nsub * KT;
    int lli = 0, lsub = 0, lkt = 0, lg = 0;
    auto issue = [&]() {
        const int t = first + lli * stride;
        bf16_t* sa = (bf16_t*)(smem + (lg & 1) * STAGE); bf16_t* sb = (bf16_t*)(smem + (lg & 1) * STAGE + A_BYTES);
#pragma unroll
        for (int i = 0; i < 4; ++i) { int row = (i * 4 + wid) * 8 + (lane >> 3); const bf16_t* pa = arows(t, row); glds16(pa ? pa + swz(row, lane & 7) * 8 + lkt * 64 : zrow, sa + (i * 4 + wid) * 512 + lane * 8); }
#pragma unroll
        for (int i = 0; i < TN; ++i) { int row = (i * 4 + wid) * 8 + (lane >> 3); glds16(brows(t, lsub, row) + swz(row, lane & 7) * 8 + lkt * 64, sb + (i * 4 + wid) * 512 + lane * 8); }
        ++lg; if (++lkt == KT) { lkt = 0; if (++lsub == nsub) { lsub = 0; ++lli; } }
    };
    __syncthreads();
    issue();
    glds_wait();
    __syncthreads();
    int g = 0;
    for (int li = 0; li < nt; ++li)
        for (int sub = 0; sub < nsub; ++sub) {
            f32x16 acc[TN];
#pragma unroll
            for (int j = 0; j < TN; ++j)
#pragma unroll
                for (int r = 0; r < 16; ++r) acc[j][r] = 0.f;
            for (int kt = 0; kt < KT; ++kt, ++g) {
                if (lg < G) issue();
                const bf16_t* sa = (const bf16_t*)(smem + (g & 1) * STAGE); const bf16_t* sb = (const bf16_t*)((const char*)sa + A_BYTES);
#pragma unroll
                for (int ks = 0; ks < 4; ++ks) {
                    const int c = ks * 2 + (lane >> 5);
                    int ra = wid * 32 + (lane & 31);
                    bf16x8 af = *(const bf16x8*)(sa + ra * 64 + swz(ra, c) * 8);
#pragma unroll
                    for (int j = 0; j < TN; ++j) { int rb = j * 32 + (lane & 31); acc[j] = mfma32(af, *(const bf16x8*)(sb + rb * 64 + swz(rb, c) * 8), acc[j]); }
                }
                glds_wait();
                __syncthreads();
            }
            epi(first + li * stride, sub, acc);
            __syncthreads();
        }
}

DEV void phase_mla(const Params& p, int layer, int bid, int nb, char* smem) {
    const int tid = get_tid(), lane = tid & 63, wid = tid >> 6, cl = lane & 31;
    const bool need_ctx = layer == 0;
    const bf16_t* projb = (const bf16_t*)(p.ws + OFF_PB);
    bf16_t* Qg = (bf16_t*)(p.ws + OFF_QKV); bf16_t* Kg = Qg + (size_t)BATCH * 8 * T * 96; bf16_t* Vt = Kg + (size_t)BATCH * 8 * T * 96;
    const float* rope = (const float*)(p.ws + OFF_ROPE);
    const bf16_t* WUQ = (const bf16_t*)(p.ws + OFF_WUQ); const bf16_t* WUKV = (const bf16_t*)(p.ws + OFF_WUKV);
    const bf16_t* zrow = (const bf16_t*)(p.ws + OFF_ZERO);
    bf16_t* stK = (bf16_t*)(smem + EPI_OFF);
    bf16_t* stV = (bf16_t*)(smem + EPI_OFF + 24576);
    float* s_rstd = (float*)(smem + EPI_OFF + 24576 + 17408);
    constexpr int NSUB = 2, NHG = 8 / NSUB;
    const int tpb = need_ctx ? T / 128 : SEQ / 128;
    auto row_rstd = [&](int r0, int col0, int ncol) {
        int row = tid >> 1, half = tid & 1; const bf16_t* src = projb + (size_t)(r0 + row) * PBW + col0 + half * (ncol / 2);
        float ss = 0.f;
        for (int i = 0; i < ncol / 2; i += 8) { u32x4 v = *(const u32x4*)(src + i);
#pragma unroll
            for (int q = 0; q < 4; ++q) { float lo = bf2f((bf16_t)(v[q] & 0xffff)), hi = bf2f((bf16_t)(v[q] >> 16)); ss += lo * lo + hi * hi; } }
        ss += shfl_xor_f(ss, 1);
        if (half == 0) s_rstd[row] = rsqrtf(ss / (float)ncol + EPS);
        __syncthreads();
    };
    {
        auto qrow0 = [&](int t) { int rt = t / NHG; int b = rt / tpb, j = rt % tpb; return b * T + (need_ctx ? 0 : CTXL) + j * 128; };
        const int nrt = BATCH * tpb; const bool xok = (nb % 8 == 0) && (nrt % 8 == 0);
        auto qmap = [&](int t) { if (!xok) return t; int idx = t >> 3, g = t & 7; int rtl = idx / NHG, hgp = idx % NHG; return (rtl * 8 + g) * NHG + hgp; };
        gemm_stream_w4<3>(xok ? (bid & 7) + 8 * (bid >> 3) : bid, nrt * NHG, nb, NSUB, 4, smem, zrow,
            [&](int t0_, int row) { int t = qmap(t0_); return projb + (size_t)(qrow0(t) + row) * PBW + PB_CQ; },
            [&](int t0_, int sub, int row) { int t = qmap(t0_); int hd = (t % NHG) * NSUB + sub; return WUQ + (size_t)(hd * 96 + row) * 256; },
            [&](int t0_, int sub, f32x16 (&acc)[3]) {
                const int t = qmap(t0_); const int r0 = qrow0(t), hd = (t % NHG) * NSUB + sub; const int b = r0 / T, t0 = r0 % T; const bool islat = t0 >= CTXL;
                if (sub == 0) row_rstd(r0, PB_CQ, 256);
                const float* gq = p.mla_q_qk_g + layer * 96;
                float ssq[16];
#pragma unroll
                for (int r = 0; r < 16; ++r) { float rs = s_rstd[wid * 32 + crow(r, lane)]; float sacc = 0.f;
#pragma unroll
                    for (int j = 0; j < 3; ++j) { acc[j][r] *= rs; sacc += acc[j][r] * acc[j][r]; }
                    ssq[r] = sacc; }
#pragma unroll
                for (int m = 1; m < 32; m <<= 1)
#pragma unroll
                    for (int r = 0; r < 16; ++r) ssq[r] += shfl_xor_f(ssq[r], m);
#pragma unroll
                for (int r = 0; r < 16; ++r) {
                    float rn = rsqrtf(ssq[r] * (1.f / 96.f) + EPS) * QSCL; int rl = wid * 32 + crow(r, lane); int tt = t0 + rl;
                    float v0 = acc[0][r] * rn * gq[cl], v1 = acc[1][r] * rn * gq[32 + cl], v2 = acc[2][r] * rn * gq[64 + cl];
                    float pv = shfl_xor_f(v2, 8);
                    if (islat) { const float* rt = rope + (size_t)(tt - CTXL) * 32 + (cl >> 4) * 16; int j = cl & 7; float cs = rt[j], sn = rt[8 + j]; v2 = v2 * cs + ((cl & 8) ? pv : -pv) * sn; }
                    stK[rl * 96 + cl] = f2bf(v0); stK[rl * 96 + 32 + cl] = f2bf(v1); stK[rl * 96 + 64 + cl] = f2bf(v2);
                    SCHED_FENCE();
                }
                __syncthreads();
                u32x4* dst = (u32x4*)(Qg + (((size_t)b * 8 + hd) * T + t0) * 96);
#pragma unroll
                for (int q = 0; q < 6; ++q) dst[tid + NTHR * q] = ((const u32x4*)stK)[tid + NTHR * q];
            });
    }
    {
        const int nrk = R / 128; const bool xk = (nb % 8 == 0) && (nrk % 8 == 0);
        auto kmap = [&](int t) { if (!xk) return t; int idx = t >> 3, g = t & 7; int rtl = idx / NHG, hgp = idx % NHG; return (rtl * 8 + g) * NHG + hgp; };
        gemm_stream_w4<4>(bid, nrk * NHG, nb, NSUB, 2, smem, zrow,
            [&](int t0_, int row) { int t = kmap(t0_); return projb + (size_t)((t / NHG) * 128 + row) * PBW + PB_CKV; },
            [&](int t0_, int sub, int row) { int t = kmap(t0_); int hd = (t % NHG) * NSUB + sub; return WUKV + (size_t)(hd * 128 + row) * 128; },
            [&](int t0_, int sub, f32x16 (&acc)[4]) {
                const int t = kmap(t0_); const int r0 = (t / NHG) * 128, hd = (t % NHG) * NSUB + sub; const int b = r0 / T, t0 = r0 % T; const bool islat = t0 >= CTXL;
                if (sub == 0) row_rstd(r0, PB_CKV, 128);
                bf16_t* sV = (bf16_t*)(smem + EPI_OFF);
#pragma unroll
                for (int j = 0; j < 2; ++j)
#pragma unroll
                    for (int g = 0; g < 4; ++g) {
                        int tl = wid * 32 + 8 * g + 4 * (lane >> 5); int dv = j * 32 + cl;
                        f32x4 rs4 = *(const f32x4*)(s_rstd + tl);
                        *(u32x2*)(sV + dv * CLD + tl) = (u32x2){pack2(acc[2 + j][4 * g] * rs4[0], acc[2 + j][4 * g + 1] * rs4[1]), pack2(acc[2 + j][4 * g + 2] * rs4[2], acc[2 + j][4 * g + 3] * rs4[3])};
                    }
                __syncthreads();
#pragma unroll
                for (int q = 0; q < 4; ++q) { int id = tid + NTHR * q; int dv = id >> 4, c = id & 15; *(u32x4*)(Vt + (((size_t)b * 8 + hd) * 64 + dv) * T + t0 + c * 8) = *(const u32x4*)(sV + dv * CLD + c * 8); }
                __syncthreads();
                constexpr int KFL = 68;
                float* sKf = (float*)(smem + EPI_OFF);
#pragma unroll
                for (int j = 0; j < 2; ++j)
#pragma unroll
                    for (int r = 0; r < 16; ++r) { int rl = wid * 32 + crow(r, lane); sKf[rl * KFL + j * 32 + cl] = acc[j][r] * s_rstd[rl]; }
                __syncthreads();
                {
                    const int row = tid >> 1, half = tid & 1; const int tt = t0 + row;
                    const float* gk = p.mla_k_qk_g + layer * 96;
                    float v[48];
                    if (half == 0) {
#pragma unroll
                        for (int c = 0; c < 48; c += 4) { f32x4 x = *(const f32x4*)(sKf + row * KFL + c); v[c] = x[0]; v[c + 1] = x[1]; v[c + 2] = x[2]; v[c + 3] = x[3]; }
                    } else {
#pragma unroll
                        for (int c = 0; c < 16; c += 4) { f32x4 x = *(const f32x4*)(sKf + row * KFL + 48 + c); v[c] = x[0]; v[c + 1] = x[1]; v[c + 2] = x[2]; v[c + 3] = x[3]; }
                        const u32x4* kp = (const u32x4*)(projb + (size_t)(r0 + row) * PBW + PB_KR);
#pragma unroll
                        for (int q = 0; q < 4; ++q) { u32x4 w = kp[q];
#pragma unroll
                            for (int e = 0; e < 4; ++e) { v[16 + q * 8 + 2 * e] = bf2f((bf16_t)(w[e] & 0xffff)); v[16 + q * 8 + 2 * e + 1] = bf2f((bf16_t)(w[e] >> 16)); } }
                    }
                    float ss = 0.f;
#pragma unroll
                    for (int c = 0; c < 48; ++c) ss += v[c] * v[c];
                    ss += shfl_xor_f(ss, 1);
                    const float rn = rsqrtf(ss * (1.f / 96.f) + EPS);
#pragma unroll
                    for (int c = 0; c < 48; ++c) v[c] *= rn * gk[half * 48 + c];
                    if (half == 1 && islat) {
                        const float* rt = rope + (size_t)(tt - CTXL) * 32;
#pragma unroll
                        for (int gph = 0; gph < 2; ++gph)
#pragma unroll
                            for (int j = 0; j < 8; ++j) {
                                float cs = rt[gph * 16 + j], sn = rt[gph * 16 + 8 + j]; float x1 = v[16 + gph * 16 + j], x2 = v[16 + gph * 16 + 8 + j];
                                v[16 + gph * 16 + j] = x1 * cs - x2 * sn; v[16 + gph * 16 + 8 + j] = x2 * cs + x1 * sn;
                            }
                    }
                    u32x4* dst = (u32x4*)(Kg + (((size_t)b * 8 + hd) * T + tt) * 96 + half * 48);
#pragma unroll
                    for (int q = 0; q < 6; ++q) dst[q] = (u32x4){pack2(v[q * 8], v[q * 8 + 1]), pack2(v[q * 8 + 2], v[q * 8 + 3]), pack2(v[q * 8 + 4], v[q * 8 + 5]), pack2(v[q * 8 + 6], v[q * 8 + 7])};
                }
            });
    }
}

DEV void phase_attn(const Params& p, int layer, int bid, int nb, char* smem) {
    const int tid = get_tid(), lane = tid & 63, wid = tid >> 6, cl = lane & 31, hh = lane >> 5;
    const bool need_ctx = layer == 0;
    const bf16_t* Qg = (const bf16_t*)(p.ws + OFF_QKV); const bf16_t* Kg = Qg + (size_t)BATCH * 8 * T * 96; const bf16_t* Vt = Kg + (size_t)BATCH * 8 * T * 96;
    bf16_t* yb = (bf16_t*)(p.ws + OFF_PF);
    constexpr int KA = 64 * 128, KB = 64 * 64, VB = 64 * 128, STG = KA + KB + VB;
    constexpr int NQT = T / 128;
    const int nlat = SEQ / 128, nctx = need_ctx ? CTXL / 128 : 0; const int per_bh = nlat + nctx;
    const int nlat_items = BATCH * 8 * nlat, nctx_items = BATCH * 8 * nctx;
    const bool xcd_ok = (nb % 8 == 0) && ((BATCH * 8) % 8 == 0);
    const int lat_first = xcd_ok ? (bid >> 3) : bid, lat_stride = xcd_ok ? (nb >> 3) : nb, lat_cnt = xcd_ok ? nlat_items / 8 : nlat_items;
    const int my_lat = lat_first < lat_cnt ? (lat_cnt - lat_first + lat_stride - 1) / lat_stride : 0;
    const int my_ctx = bid < nctx_items ? (nctx_items - bid + nb - 1) / nb : 0;
    for (int wi = 0; wi < my_lat + my_ctx; ++wi) {
        int bh, qt;
        if (wi < my_lat) { int idx = lat_first + wi * lat_stride; int bhl = idx / nlat; qt = CTXL / 128 + idx % nlat; bh = xcd_ok ? bhl * 8 + (bid & 7) : bhl; }
        else { int u = bid + (wi - my_lat) * nb; bh = u / nctx; qt = u % nctx; }
        int t0 = qt * 128; const bool islat = t0 >= CTXL;
        const int nkeys = islat ? T : CTXL; const int nkt = nkeys / 64;
        const bf16_t* Kb_ = Kg + (size_t)bh * T * 96; const bf16_t* Vb_ = Vt + (size_t)bh * 64 * T;
        bf16x8 qf[6];
        { const bf16_t* q = Qg + ((size_t)bh * T + t0 + wid * 32 + cl) * 96 + hh * 8;
#pragma unroll
          for (int s2 = 0; s2 < 6; ++s2) qf[s2] = *(const bf16x8*)(q + s2 * 16); }
        f32x16 o0, o1;
#pragma unroll
        for (int r = 0; r < 16; ++r) { o0[r] = 0.f; o1[r] = 0.f; }
        float mrun = -1e30f, lrun = 0.f;
        auto stage_load = [&](int buf, int kt) {
            bf16_t* ska = (bf16_t*)(smem + buf * STG); bf16_t* skb = (bf16_t*)(smem + buf * STG + KA); bf16_t* sv = (bf16_t*)(smem + buf * STG + KA + KB);
#pragma unroll
            for (int i = 0; i < 2; ++i) { int row = (i * 4 + wid) * 8 + (lane >> 3); glds16(Kb_ + (size_t)(kt * 64 + row) * 96 + swz(row, lane & 7) * 8, ska + (i * 4 + wid) * 512 + lane * 8); }
            { int row = wid * 16 + (lane >> 2); glds16(Kb_ + (size_t)(kt * 64 + row) * 96 + 64 + swz4(row, lane & 3) * 8, skb + wid * 512 + lane * 8); }
#pragma unroll
            for (int i = 0; i < 2; ++i) { int row = (i * 4 + wid) * 8 + (lane >> 3); glds16(Vb_ + (size_t)row * T + kt * 64 + swz(row, lane & 7) * 8, sv + (i * 4 + wid) * 512 + lane * 8); }
        };
        __syncthreads();
        stage_load(0, 0);
        glds_wait();
        __syncthreads();
        for (int kt = 0; kt < nkt; ++kt) {
            if (kt + 1 < nkt) stage_load((kt + 1) & 1, kt + 1);
            const bf16_t* ska = (const bf16_t*)(smem + (kt & 1) * STG); const bf16_t* skb = (const bf16_t*)(smem + (kt & 1) * STG + KA); const bf16_t* sv = (const bf16_t*)(smem + (kt & 1) * STG + KA + KB);
            f32x16 s0, s1;
#pragma unroll
            for (int r = 0; r < 16; ++r) { s0[r] = 0.f; s1[r] = 0.f; }
#pragma unroll
            for (int s2 = 0; s2 < 4; ++s2) {
                int c = s2 * 2 + hh;
                bf16x8 k0 = *(const bf16x8*)(ska + cl * 64 + swz(cl, c) * 8), k1 = *(const bf16x8*)(ska + (32 + cl) * 64 + swz(32 + cl, c) * 8);
                s0 = mfma32(k0, qf[s2], s0); s1 = mfma32(k1, qf[s2], s1);
            }
#pragma unroll
            for (int s2 = 4; s2 < 6; ++s2) {
                int c = (s2 - 4) * 2 + hh;
                bf16x8 k0 = *(const bf16x8*)(skb + cl * 32 + swz4(cl, c) * 8), k1 = *(const bf16x8*)(skb + (32 + cl) * 32 + swz4(32 + cl, c) * 8);
                s0 = mfma32(k0, qf[s2], s0); s1 = mfma32(k1, qf[s2], s1);
            }
            float mx = -1e30f;
#pragma unroll
            for (int r = 0; r < 16; ++r) mx = fmaxf(mx, fmaxf(s0[r], s1[r]));
            mx = fmaxf(mx, shfl_xor_f(mx, 32));
            if (!wave_all(mx <= mrun + 8.f)) {
                float mnew = fmaxf(mrun, mx), alpha = fast_exp2(mrun - mnew); mrun = mnew; lrun *= alpha;
#pragma unroll
                for (int r = 0; r < 16; ++r) { o0[r] *= alpha; o1[r] *= alpha; }
            }
            float ls = 0.f;
#pragma unroll
            for (int r = 0; r < 16; ++r) { s0[r] = fast_exp2(s0[r] - mrun); s1[r] = fast_exp2(s1[r] - mrun); ls += s0[r] + s1[r]; }
            lrun += ls;
#pragma unroll
            for (int s2 = 0; s2 < 4; ++s2) {
                const f32x16& sx = (s2 < 2) ? s0 : s1; int rbase = (s2 & 1) * 8;
                bf16x8 pb;
#pragma unroll
                for (int j = 0; j < 8; ++j) pb[j] = (short)f2bf(sx[rbase + j]);
#pragma unroll
                for (int i = 0; i < 2; ++i) {
                    int row = i * 32 + cl;
                    bf16x4 lo = *(const bf16x4*)(sv + row * 64 + swz(row, 2 * s2) * 8 + 4 * hh), hi = *(const bf16x4*)(sv + row * 64 + swz(row, 2 * s2 + 1) * 8 + 4 * hh);
                    bf16x8 va = {lo[0], lo[1], lo[2], lo[3], hi[0], hi[1], hi[2], hi[3]};
                    if (i == 0) o0 = mfma32(va, pb, o0); else o1 = mfma32(va, pb, o1);
                }
            }
            glds_wait();
            __syncthreads();
        }
        lrun += shfl_xor_f(lrun, 32);
        float inv = 1.f / lrun;
        int b = bh >> 3, hd = bh & 7; size_t row = (size_t)b * T + t0 + wid * 32 + cl;
#pragma unroll
        for (int i = 0; i < 2; ++i)
#pragma unroll
            for (int g = 0; g < 4; ++g) {
                const f32x16& ox = i ? o1 : o0; int dv = i * 32 + 8 * g + 4 * hh;
                *(u32x2*)(yb + row * 1024 + 512 + hd * 64 + dv) = (u32x2){pack2(ox[4 * g] * inv, ox[4 * g + 1] * inv), pack2(ox[4 * g + 2] * inv, ox[4 * g + 3] * inv)};
            }
    }
    (void)NQT;
}

template <int MODE>
DEV void phase_attn_probe(const Params& p, int layer, int bid, int nb, char* smem) {
    const int tid = get_tid(), lane = tid & 63, wid = tid >> 6, cl = lane & 31, hh = lane >> 5;
    const bool need_ctx = layer == 0;
    const bf16_t* Qg = (const bf16_t*)(p.ws + OFF_QKV); const bf16_t* Kg = Qg + (size_t)BATCH * 8 * T * 96; const bf16_t* Vt = Kg + (size_t)BATCH * 8 * T * 96;
    bf16_t* yb = (bf16_t*)(p.ws + OFF_H);
    constexpr int KA = 64 * 128, KB = 64 * 64, VB = 64 * 128, STG = KA + KB + VB;
    constexpr int NQT = T / 128;
    const int nlat = SEQ / 128, nctx = need_ctx ? CTXL / 128 : 0; const int per_bh = nlat + nctx;
    const int nlat_items = BATCH * 8 * nlat, nctx_items = BATCH * 8 * nctx;
    const bool xcd_ok = (nb % 8 == 0) && ((BATCH * 8) % 8 == 0);
    const int lat_first = xcd_ok ? (bid >> 3) : bid, lat_stride = xcd_ok ? (nb >> 3) : nb, lat_cnt = xcd_ok ? nlat_items / 8 : nlat_items;
    const int my_lat = lat_first < lat_cnt ? (lat_cnt - lat_first + lat_stride - 1) / lat_stride : 0;
    const int my_ctx = bid < nctx_items ? (nctx_items - bid + nb - 1) / nb : 0;
    for (int wi = 0; wi < my_lat + my_ctx; ++wi) {
        int bh, qt;
        if (wi < my_lat) { int idx = lat_first + wi * lat_stride; int bhl = idx / nlat; qt = CTXL / 128 + idx % nlat; bh = xcd_ok ? bhl * 8 + (bid & 7) : bhl; }
        else { int u = bid + (wi - my_lat) * nb; bh = u / nctx; qt = u % nctx; }
        int t0 = qt * 128; const bool islat = t0 >= CTXL;
        const int nkeys = islat ? T : CTXL; const int nkt = nkeys / 64;
        const bf16_t* Kb_ = Kg + (size_t)bh * T * 96; const bf16_t* Vb_ = Vt + (size_t)bh * 64 * T;
        bf16x8 qf[6];
        { const bf16_t* q = Qg + ((size_t)bh * T + t0 + wid * 32 + cl) * 96 + hh * 8;
#pragma unroll
          for (int s2 = 0; s2 < 6; ++s2) qf[s2] = *(const bf16x8*)(q + s2 * 16); }
        f32x16 o0, o1;
#pragma unroll
        for (int r = 0; r < 16; ++r) { o0[r] = 0.f; o1[r] = 0.f; }
        float mrun = -1e30f, lrun = 0.f;
        auto stage_load = [&](int buf, int kt) {
            bf16_t* ska = (bf16_t*)(smem + buf * STG); bf16_t* skb = (bf16_t*)(smem + buf * STG + KA); bf16_t* sv = (bf16_t*)(smem + buf * STG + KA + KB);
#pragma unroll
            for (int i = 0; i < 2; ++i) { int row = (i * 4 + wid) * 8 + (lane >> 3); glds16(Kb_ + (size_t)(kt * 64 + row) * 96 + swz(row, lane & 7) * 8, ska + (i * 4 + wid) * 512 + lane * 8); }
            { int row = wid * 16 + (lane >> 2); glds16(Kb_ + (size_t)(kt * 64 + row) * 96 + 64 + swz4(row, lane & 3) * 8, skb + wid * 512 + lane * 8); }
#pragma unroll
            for (int i = 0; i < 2; ++i) { int row = (i * 4 + wid) * 8 + (lane >> 3); glds16(Vb_ + (size_t)row * T + kt * 64 + swz(row, lane & 7) * 8, sv + (i * 4 + wid) * 512 + lane * 8); }
        };
        __syncthreads();
        stage_load(0, 0);
        glds_wait();
        __syncthreads();
        for (int kt = 0; kt < nkt; ++kt) {
            if (MODE != 2 && kt + 1 < nkt) stage_load((kt + 1) & 1, kt + 1);
            const bf16_t* ska = (const bf16_t*)(smem + (kt & 1) * STG); const bf16_t* skb = (const bf16_t*)(smem + (kt & 1) * STG + KA); const bf16_t* sv = (const bf16_t*)(smem + (kt & 1) * STG + KA + KB);
            f32x16 s0, s1;
#pragma unroll
            for (int r = 0; r < 16; ++r) { s0[r] = 0.f; s1[r] = 0.f; }
#pragma unroll
            for (int s2 = 0; s2 < 4; ++s2) {
                int c = s2 * 2 + hh;
                bf16x8 k0 = *(const bf16x8*)(ska + cl * 64 + swz(cl, c) * 8), k1 = *(const bf16x8*)(ska + (32 + cl) * 64 + swz(32 + cl, c) * 8);
                s0 = mfma32(k0, qf[s2], s0); s1 = mfma32(k1, qf[s2], s1);
            }
#pragma unroll
            for (int s2 = 4; s2 < 6; ++s2) {
                int c = (s2 - 4) * 2 + hh;
                bf16x8 k0 = *(const bf16x8*)(skb + cl * 32 + swz4(cl, c) * 8), k1 = *(const bf16x8*)(skb + (32 + cl) * 32 + swz4(32 + cl, c) * 8);
                s0 = mfma32(k0, qf[s2], s0); s1 = mfma32(k1, qf[s2], s1);
            }
            float mx = -1e30f;
            if (MODE != 1)
#pragma unroll
            for (int r = 0; r < 16; ++r) mx = fmaxf(mx, fmaxf(s0[r], s1[r]));
            mx = fmaxf(mx, shfl_xor_f(mx, 32));
            if (!wave_all(mx <= mrun + 8.f)) {
                float mnew = fmaxf(mrun, mx), alpha = fast_exp2(mrun - mnew); mrun = mnew; lrun *= alpha;
#pragma unroll
                for (int r = 0; r < 16; ++r) { o0[r] *= alpha; o1[r] *= alpha; }
            }
            float ls = 0.f;
            if (MODE != 1)
#pragma unroll
            for (int r = 0; r < 16; ++r) { s0[r] = fast_exp2(s0[r] - mrun); s1[r] = fast_exp2(s1[r] - mrun); ls += s0[r] + s1[r]; }
            lrun += ls;
#pragma unroll
            for (int s2 = 0; s2 < 4; ++s2) {
                const f32x16& sx = (s2 < 2) ? s0 : s1; int rbase = (s2 & 1) * 8;
                bf16x8 pb;
#pragma unroll
                for (int j = 0; j < 8; ++j) pb[j] = (short)f2bf(sx[rbase + j]);
#pragma unroll
                for (int i = 0; i < 2; ++i) {
                    int row = i * 32 + cl;
                    bf16x4 lo = *(const bf16x4*)(sv + row * 64 + swz(row, 2 * s2) * 8 + 4 * hh), hi = *(const bf16x4*)(sv + row * 64 + swz(row, 2 * s2 + 1) * 8 + 4 * hh);
                    bf16x8 va = {lo[0], lo[1], lo[2], lo[3], hi[0], hi[1], hi[2], hi[3]};
                    if (i == 0) o0 = mfma32(va, pb, o0); else o1 = mfma32(va, pb, o1);
                }
            }
            glds_wait();
            __syncthreads();
        }
        lrun += shfl_xor_f(lrun, 32);
        float inv = 1.f / lrun;
        int b = bh >> 3, hd = bh & 7; size_t row = (size_t)b * T + t0 + wid * 32 + cl;
#pragma unroll
        for (int i = 0; i < 2; ++i)
#pragma unroll
            for (int g = 0; g < 4; ++g) {
                const f32x16& ox = i ? o1 : o0; int dv = i * 32 + 8 * g + 4 * hh;
                *(u32x2*)(yb + row * 1024 + 512 + hd * 64 + dv) = (u32x2){pack2(ox[4 * g] * inv, ox[4 * g + 1] * inv), pack2(ox[4 * g + 2] * inv, ox[4 * g + 3] * inv)};
            }
    }
    (void)NQT;
}

DEV void phase_merge(const Params& p, int layer, int bid, int nb) {
    const int tid = get_tid(), lane = tid & 63, wid = tid >> 6, hl = lane & 31;
    const bool need_ctx = layer == 0;
    const bf16_t* so = (const bf16_t*)(p.ws + OFF_H); const bf16_t* projb = (const bf16_t*)(p.ws + OFF_PB);
    bf16_t* y = (bf16_t*)(p.ws + OFF_PF);
    float hnw[16];
    { const bool isml0 = hl < 16; const float* hn0 = (isml0 ? p.ml_norm_g : p.hg_norm_g) + layer * 256 + ((hl * 16) & 255);
#pragma unroll
      for (int i = 0; i < 16; ++i) hnw[i] = hn0[i]; }
    for (int r2 = bid * 4 + wid; r2 < R / 2; r2 += nb * 4) {
        const int r = r2 * 2 + (lane >> 5);
        if (!need_ctx && (r % T) < CTXL) continue;
        const bool isml = hl < 16; const int cc = (hl * 16) & 255;
        const bf16_t* a0 = so + ((size_t)(isml ? 0 : 2) * R + r) * 256 + cc; const bf16_t* a1 = so + ((size_t)(isml ? 1 : 3) * R + r) * 256 + cc;
        u32x4 x0 = *(const u32x4*)a0, x1 = *(const u32x4*)(a0 + 8), y0 = *(const u32x4*)a1, y1 = *(const u32x4*)(a1 + 8);
        float v[16]; float ss = 0.f;
#pragma unroll
        for (int i = 0; i < 16; ++i) {
            unsigned wa = (i < 8 ? x0 : x1)[(i & 7) >> 1], wb = (i < 8 ? y0 : y1)[(i & 7) >> 1];
            v[i] = bf2f((bf16_t)((i & 1) ? wa >> 16 : wa & 0xffff)) + bf2f((bf16_t)((i & 1) ? wb >> 16 : wb & 0xffff)); ss += v[i] * v[i];
        }
        ss += shfl_xor_f(ss, 1); ss += shfl_xor_f(ss, 2);
        const bf16_t* gt = projb + (size_t)r * PBW + (isml ? PB_MLOG : PB_HGOG) + cc;
        float rn = rsqrtf(ss * (1.f / 64.f) + EPS);
        u32x4 g0 = *(const u32x4*)gt, g1 = *(const u32x4*)(gt + 8);
        unsigned outw[8];
#pragma unroll
        for (int i = 0; i < 16; i += 2) {
            unsigned gw = (i < 8 ? g0 : g1)[(i & 7) >> 1];
            float ga = bf2f((bf16_t)(gw & 0xffff)), gb = bf2f((bf16_t)(gw >> 16));
            float a = v[i] * rn * hnw[i] * (isml ? sigmoidf_(ga) : siluf_(ga)), bb = v[i + 1] * rn * hnw[i + 1] * (isml ? sigmoidf_(gb) : siluf_(gb));
            outw[i >> 1] = pack2(a, bb);
        }
        u32x4* d = (u32x4*)(y + (size_t)r * D + hl * 16);
        d[0] = (u32x4){outw[0], outw[1], outw[2], outw[3]}; d[1] = (u32x4){outw[4], outw[5], outw[6], outw[7]};
    }
}

DEV void phase_outproj(const Params& p, int layer, int bid, int nb, char* smem) {
    const bool need_ctx = layer == 0;
    const bf16_t* y = (const bf16_t*)(p.ws + OFF_PF); const bf16_t* W = (const bf16_t*)(p.ws + OFF_WOUT);
    const float* mods = (const float*)(p.ws + OFF_MODS) + (size_t)layer * (BATCH + 1) * 6144;
    const int tid_ = get_tid();
    constexpr int NTN = 8; const int tpb = need_ctx ? T / 128 : SEQ / 128;
    auto row0 = [&](int tm) { int b = tm / tpb, j = tm % tpb; return b * T + (need_ctx ? 0 : CTXL) + j * 128; };
    int tf, te, tstr; xcd_range(bid, nb, BATCH * tpb * NTN, tf, te, tstr);
    gemm_tiles(tf, te, tstr, 1024, smem, (const bf16_t*)(p.ws + OFF_ZERO),
        [&](int t, int which, int row) { int tm, tn; tile_decode(t, BATCH * tpb, NTN, tm, tn); return which ? W + (size_t)(tn * 128 + row) * 1024 : y + (size_t)(row0(tm) + row) * D; },
        [&](int t, f32x16 (&acc)[2][2]) {
            int tm_, tn_; tile_decode(t, BATCH * tpb, NTN, tm_, tn_);
            const int r0 = row0(tm_), n0 = tn_ * 128; const int b = r0 / T, t0 = r0 % T; const bool islat = t0 >= CTXL;
            const float* g1 = mods + (size_t)(islat ? b : BATCH) * 6144 + 2 * 1024 + n0;
            const f32x4 gch = *(const f32x4*)(g1 + (tid_ & 31) * 4);
            epi_f32_halves(acc, smem, tid_, [&](int row, int c, f32x4 a) {
                int tt = t0 + row; const f32x4 g = gch;
                if (islat) { size_t o = ((size_t)b * SEQ + (tt - CTXL)) * D + n0 + c * 4; f32x4 xv = *(const f32x4*)((layer == 0 ? p.x : p.out) + o); *(f32x4*)(p.out + o) = xv + g * a; }
                else { size_t o = ((size_t)b * CTXL + tt) * D + n0 + c * 4; float* cx = (float*)(p.ws + OFF_CX); *(f32x4*)(cx + o) = *(const f32x4*)(p.ctx + o) + g * a; }
            });
        });
}

DEV void phase_router(const Params& p, int layer, int bid, int nb, char* smem) {
    const bool need_ctx = layer == 0;
    const bf16_t* h2 = (const bf16_t*)(p.ws + OFF_H); const bf16_t* WR = (const bf16_t*)(p.ws + OFF_WR);
    float* aff = (float*)(p.ws + OFF_AFF);
    const int tid_ = get_tid(); const int lane = tid_ & 63, wid = tid_ >> 6;
    constexpr int NTM = R / 128;
    for (int it = bid; it < NTM; it += nb) {
        int r0 = it * 128; if (!need_ctx && (r0 % T) < CTXL) continue;
        f32x16 acc[1][1];
        gemm_mainloop<4, 1, 1, 1>(acc, [&](int i) { return h2 + (size_t)(r0 + i) * D; }, [&](int j) { return WR + (size_t)j * 1024; }, 1024, smem, (const bf16_t*)(p.ws + OFF_ZERO));
        const int cl = lane & 31;
#pragma unroll
        for (int r = 0; r < 16; ++r) {
            float v = cl < 16 ? acc[0][0][r] : -1e30f; float mx = v;
#pragma unroll
            for (int m = 1; m < 16; m <<= 1) mx = fmaxf(mx, shfl_xor_f(mx, m));
            float e = cl < 16 ? __expf(v - mx) : 0.f; float s = e;
#pragma unroll
            for (int m = 1; m < 16; m <<= 1) s += shfl_xor_f(s, m);
            if (cl < 16) aff[(size_t)(r0 + wid * 32 + crow(r, lane)) * 16 + cl] = e / s;
        }
    }
}

#ifdef EMU
DEV unsigned shfl_up_u(unsigned v, int d) { int l = emu::cur->lane; return emu::shfl_u32(v, l >= d ? l - d : l); }
DEV unsigned shfl_idx_u(unsigned v, int src) { return emu::shfl_u32(v, src); }
#else
DEV unsigned shfl_up_u(unsigned v, int d) { return __shfl_up(v, d); }
DEV unsigned shfl_idx_u(unsigned v, int src) { return __shfl(v, src); }
#endif
DEV void phase_topk(const Params& p, int layer, int bid, int nb, char* smem) {
    const bool need_ctx = layer == 0; const int tid = get_tid(); const int lane = tid & 63, wid = tid >> 6;
    const float* aff = (const float*)(p.ws + OFF_AFF);
    int* selr = (int*)(p.ws + OFF_SELR); float* selg = (float*)(p.ws + OFF_SELG); int* inv = (int*)(p.ws + OFF_INV); float* invg = (float*)(p.ws + OFF_INVG);
    unsigned* keys = (unsigned*)smem;
    unsigned* hist = keys + 2048;
    unsigned* sh = hist + 256;
    const int capT = need_ctx ? CAP_L + CAP_C : CAP_L;
    const int nitems = BATCH * NEXP * 2;
    for (int it = bid; it < nitems; it += nb) {
        int seg = it & 1, e = (it >> 1) % NEXP, b = (it >> 1) / NEXP;
        if (seg == 1 && !need_ctx) continue;
        const int n = seg ? CTXL : SEQ, cap = seg ? CAP_C : CAP_L; const int rbase = b * T + (seg ? 0 : CTXL);
        __syncthreads();
        {
            static_assert(SEQ <= 8 * NTHR && CTXL <= 8 * NTHR, "key batch");
            float kv[8];
#pragma unroll
            for (int q = 0; q < 8; ++q) { int i = tid + q * NTHR; kv[q] = i < n ? aff[(size_t)(rbase + i) * 16 + e] : 0.f; }
#pragma unroll
            for (int q = 0; q < 8; ++q) { int i = tid + q * NTHR; if (i < n) keys[i] = __builtin_bit_cast(unsigned, kv[q]); }
        }
        if (tid == 0) { sh[0] = 0u; sh[1] = (unsigned)cap; }
        for (int pass = 0; pass < 4; ++pass) {
            const int shift = 24 - 8 * pass;
            hist[tid] = 0u;
            __syncthreads();
            const unsigned prefix = sh[0], kneed = sh[1];
            const unsigned hmask = pass == 0 ? 0u : (0xffffffffu << (shift + 8));
            for (int i = tid; i < n; i += NTHR) { unsigned k = keys[i]; if ((k & hmask) == prefix) atomicAdd(&hist[(k >> shift) & 255u], 1u); }
            __syncthreads();
            if (wid == 0) {
                unsigned h0 = hist[4 * lane], h1 = hist[4 * lane + 1], h2 = hist[4 * lane + 2], h3 = hist[4 * lane + 3];
                unsigned tot = h0 + h1 + h2 + h3;
                unsigned incl = tot;
#pragma unroll
                for (int d = 1; d < 64; d <<= 1) { unsigned o = shfl_idx_u(incl, lane + d < 64 ? lane + d : lane); if (lane + d < 64) incl += o; }
                unsigned above = incl - tot;
                unsigned c3 = above, c2 = c3 + h3, c1 = c2 + h2, c0 = c1 + h1;
                if (c3 < kneed && kneed <= c3 + h3) { sh[0] = prefix | ((unsigned)(4 * lane + 3) << shift); sh[1] = kneed - c3; }
                else if (c2 < kneed && kneed <= c2 + h2) { sh[0] = prefix | ((unsigned)(4 * lane + 2) << shift); sh[1] = kneed - c2; }
                else if (c1 < kneed && kneed <= c1 + h1) { sh[0] = prefix | ((unsigned)(4 * lane + 1) << shift); sh[1] = kneed - c1; }
                else if (c0 < kneed && kneed <= c0 + h0) { sh[0] = prefix | ((unsigned)(4 * lane) << shift); sh[1] = kneed - c0; }
            }
            __syncthreads();
        }
        const unsigned tau = sh[0], keq = sh[1];
        const int per = (n + NTHR - 1) / NTHR; const int i0 = tid * per;
        unsigned cg = 0, ce = 0;
        for (int q = 0; q < per && i0 + q < n; ++q) { unsigned k = keys[i0 + q]; cg += k > tau ? 1u : 0u; ce += k == tau ? 1u : 0u; }
        unsigned packed = cg | (ce << 16), incl = packed;
#pragma unroll
        for (int d = 1; d < 64; d <<= 1) { unsigned o = shfl_up_u(incl, d); if (lane >= d) incl += o; }
        if (lane == 63) sh[8 + wid] = incl;
        __syncthreads();
        unsigned base = 0;
        for (int w = 0; w < wid; ++w) base += sh[8 + w];
        unsigned excl = base + incl - packed; unsigned gb = excl & 0xffffu, eb = excl >> 16;
        for (int q = 0; q < per && i0 + q < n; ++q) {
            unsigned k = keys[i0 + q]; bool g = k > tau, eq = k == tau; int mslot = -1;
            if (g || (eq && eb < keq)) {
                mslot = b * capT + (seg ? CAP_L : 0) + (int)(gb + (eb < keq ? eb : keq));
                selr[e * ME_MAX + mslot] = rbase + i0 + q; selg[e * ME_MAX + mslot] = __builtin_bit_cast(float, k);
            }
            inv[(size_t)e * R + rbase + i0 + q] = mslot; invg[(size_t)e * R + rbase + i0 + q] = __builtin_bit_cast(float, k);
            gb += g ? 1u : 0u; eb += eq ? 1u : 0u;
        }
    }
}

DEV void phase_gateup(const Params& p, int layer, int bid, int nb, char* smem) {
    const bool need_ctx = layer == 0; const int Me = BATCH * (need_ctx ? CAP_L + CAP_C : CAP_L);
    const bf16_t* h2 = (const bf16_t*)(p.ws + OFF_H); const bf16_t* WGU = (const bf16_t*)(p.ws + OFF_WGU);
    const int* selr = (const int*)(p.ws + OFF_SELR);
    bf16_t* hid = (bf16_t*)(p.ws + OFF_PB);
    const int tid_ = get_tid(); const int lane = tid_ & 63, wid = tid_ >> 6, wm = wid >> 1, wn = wid & 1;
    const int ntm = (Me + 255) / 256; constexpr int NTN = 16;
    int tf, te, tstr; xcd_range(bid, nb, NEXP * ntm * NTN, tf, te, tstr);
    gemm_tiles256(tf, te, tstr, 1024, smem, (const bf16_t*)(p.ws + OFF_ZERO),
        [&](int t, int which, int row) -> const bf16_t* {
            int e = t / (NTN * ntm), tm_, tn_; tile_decode(t % (NTN * ntm), ntm, NTN, tm_, tn_);
            if (which) return WGU + ((size_t)e * 2048 + tn_ * 128 + row) * 1024;
            int m = tm_ * 256 + row; return m < Me ? h2 + (size_t)selr[e * ME_MAX + m] * D : (const bf16_t*)nullptr; },
        [&](int t, f32x16 (&acc)[4][2], char* stg) {
            int e = t / (NTN * ntm), tm_, tn_; tile_decode(t % (NTN * ntm), ntm, NTN, tm_, tn_); int m0 = tm_ * 256, n0 = tn_ * 128;
            bf16_t* st = (bf16_t*)stg;
#pragma unroll
            for (int q = 0; q < 2; ++q) {
                if (wm == q) {
#pragma unroll
                    for (int i = 0; i < 4; ++i)
#pragma unroll
                        for (int rq = 0; rq < 4; ++rq) {
#pragma unroll
                            for (int r = rq * 4; r < rq * 4 + 4; ++r) { int row = i * 32 + crow(r, lane); { float gx = acc[i][0][r]; st[row * 72 + wn * 32 + (lane & 31)] = f2bf(gx * fast_rcp(1.f + __expf(-gx)) * acc[i][1][r]); } }
                            SCHED_FENCE();
                        }
                }
                lds_barrier();
#pragma unroll
                for (int k = 0; k < 4; ++k) {
                    int id = tid_ + NTHR * k; int row = id >> 3, c = id & 7; int m = m0 + q * 128 + row;
                    if (m < Me) st_nt((u32x4*)(hid + ((size_t)e * Me + m) * 1024 + n0 / 2 + c * 8), *(const u32x4*)(st + row * 72 + c * 8));
                }
                lds_barrier();
            }
        });
}
template <int MODE>
DEV void phase_gateup_probe(const Params& p, int layer, int bid, int nb, char* smem) {
    const bool need_ctx = layer == 0; const int Me = BATCH * (need_ctx ? CAP_L + CAP_C : CAP_L);
    const bf16_t* h2 = (const bf16_t*)(p.ws + OFF_H); const bf16_t* WGU = (const bf16_t*)(p.ws + OFF_WGU);
    const int* selr = (const int*)(p.ws + OFF_SELR);
    const int ntm = (Me + 255) / 256; constexpr int NTN = 16;
    int tf, te, tstr; xcd_range(bid, nb, NEXP * ntm * NTN, tf, te, tstr);
    gemm_tiles256<MODE>(tf, te, tstr, 1024, smem, (const bf16_t*)(p.ws + OFF_ZERO),
        [&](int t, int which, int row) -> const bf16_t* {
            int e = t / (NTN * ntm), tm_, tn_; tile_decode(t % (NTN * ntm), ntm, NTN, tm_, tn_);
            if (which) return WGU + ((size_t)e * 2048 + tn_ * 128 + row) * 1024;
            int m = tm_ * 256 + row; return m < Me ? h2 + (size_t)selr[e * ME_MAX + m] * D : (const bf16_t*)nullptr; },
        [&](int, f32x16 (&acc)[4][2], char*) {
#ifndef EMU
#pragma unroll
            for (int i = 0; i < 4; ++i) asm volatile("" :: "v"(acc[i][0]), "v"(acc[i][1]));
#endif
        });
}
DEV void phase_down(const Params& p, int layer, int bid, int nb, char* smem) {
    const bool need_ctx = layer == 0; const int Me = BATCH * (need_ctx ? CAP_L + CAP_C : CAP_L);
    const bf16_t* hid = (const bf16_t*)(p.ws + OFF_PB); const bf16_t* WD = (const bf16_t*)(p.ws + OFF_WD);
    bf16_t* dres = (bf16_t*)(p.ws + OFF_QKV);
    const int tid_ = get_tid();
    const int ntm = (Me + 255) / 256; constexpr int NTN = 8;
    int tf, te, tstr; xcd_range(bid, nb, NEXP * ntm * NTN, tf, te, tstr);
    gemm_tiles256(tf, te, tstr, 1024, smem, (const bf16_t*)(p.ws + OFF_ZERO),
        [&](int t, int which, int row) -> const bf16_t* {
            int e = t / (NTN * ntm), tm_, tn_; tile_decode(t % (NTN * ntm), ntm, NTN, tm_, tn_);
            if (which) return WD + ((size_t)e * 1024 + tn_ * 128 + row) * 1024;
            int m = tm_ * 256 + row; return m < Me ? hid + ((size_t)e * Me + m) * 1024 : (const bf16_t*)nullptr; },
        [&](int t, f32x16 (&acc)[4][2], char* stg) {
            int e = t / (NTN * ntm), tm_, tn_; tile_decode(t % (NTN * ntm), ntm, NTN, tm_, tn_); int m0 = tm_ * 256, n0 = tn_ * 128;
            epi256_bf16(acc, stg, tid_, [&](float v, int, int) { return v; },
                        [&](int row, int c, u32x4 v) { if (m0 + row < Me) st_nt((u32x4*)(dres + ((size_t)e * Me + m0 + row) * 1024 + n0 + c * 8), v); });
        });
}
#ifdef EMU
DEV unsigned ballot16(bool pred) { unsigned m = 0; for (int e = 0; e < 16; ++e) m |= (emu::shfl_u32(pred ? 1u : 0u, e) & 1u) << e; return m; }
DEV unsigned rdlane_u(unsigned v, int idx) { return emu::shfl_u32(v, idx); }
#else
DEV unsigned ballot16(bool pred) { return (unsigned)(__ballot(pred) & 0xffffull); }
DEV unsigned rdlane_u(unsigned v, int idx) { return (unsigned)__builtin_amdgcn_readlane((int)v, idx); }
#endif
DEV void ffn_sum(const Params& p, int clayer, int r, int lane, f32x4 (&s)[4]) {
    const int Me = BATCH * (clayer == 0 ? CAP_L + CAP_C : CAP_L);
    const bf16_t* dres = (const bf16_t*)(p.ws + OFF_QKV); const int* inv = (const int*)(p.ws + OFF_INV) + r; const float* invg = (const float*)(p.ws + OFF_INVG) + r;
#pragma unroll
    for (int i = 0; i < 4; ++i) s[i] = (f32x4){0.f, 0.f, 0.f, 0.f};
    const int mi = lane < NEXP ? inv[(size_t)lane * R] : -1;
    const float gi = lane < NEXP ? invg[(size_t)lane * R] : 0.f;
    unsigned gu; memcpy(&gu, &gi, 4);
    unsigned mask = ballot16(mi >= 0);
    while (mask) {
        const int e0 = __builtin_ctz(mask); mask &= mask - 1;
        const bool two = mask != 0u; const int e1 = two ? __builtin_ctz(mask) : e0; if (two) mask &= mask - 1;
        const int m0 = (int)rdlane_u((unsigned)mi, e0), m1 = (int)rdlane_u((unsigned)mi, e1);
        unsigned g0u = rdlane_u(gu, e0), g1u = rdlane_u(gu, e1);
        float g0, g1; memcpy(&g0, &g0u, 4); memcpy(&g1, &g1u, 4); if (!two) g1 = 0.f;
        const bf16_t* row0 = dres + ((size_t)e0 * Me + m0) * 1024; const bf16_t* row1 = dres + ((size_t)e1 * Me + m1) * 1024;
        u32x2 w0[4], w1[4];
#pragma unroll
        for (int i = 0; i < 4; ++i) w0[i] = *(const u32x2*)(row0 + i * 256 + lane * 4);
#pragma unroll
        for (int i = 0; i < 4; ++i) w1[i] = *(const u32x2*)(row1 + i * 256 + lane * 4);
#pragma unroll
        for (int i = 0; i < 4; ++i) {
            s[i][0] += g0 * bf2f((bf16_t)(w0[i][0] & 0xffff)); s[i][1] += g0 * bf2f((bf16_t)(w0[i][0] >> 16)); s[i][2] += g0 * bf2f((bf16_t)(w0[i][1] & 0xffff)); s[i][3] += g0 * bf2f((bf16_t)(w0[i][1] >> 16));
            s[i][0] += g1 * bf2f((bf16_t)(w1[i][0] & 0xffff)); s[i][1] += g1 * bf2f((bf16_t)(w1[i][0] >> 16)); s[i][2] += g1 * bf2f((bf16_t)(w1[i][1] & 0xffff)); s[i][3] += g1 * bf2f((bf16_t)(w1[i][1] >> 16));
        }
    }
}
DEV void phase_final(const Params& p, int bid, int nb) {
    const int tid = get_tid(), lane = tid & 63, wid = tid >> 6;
    const float* mods = (const float*)(p.ws + OFF_MODS) + (size_t)1 * (BATCH + 1) * 6144;
    const int W = nb * 4, w = bid * 4 + wid; const bool smaj = W % BATCH == 0;
    const int tstep = smaj ? W / BATCH : 1;
    f32x4 g2v[4]; int cur_b = -1;
    for (int it = smaj ? w / BATCH : w; it < (smaj ? T : R); it += smaj ? tstep : W) {
        const int r = smaj ? (w % BATCH) * T + it : it;
        int b = r / T, t = r % T; if (t < CTXL) continue;
        if (b != cur_b) { cur_b = b; const float* g2 = mods + (size_t)b * 6144 + 5 * 1024;
#pragma unroll
            for (int i = 0; i < 4; ++i) g2v[i] = *(const f32x4*)(g2 + i * 256 + lane * 4); }
        float* xr = p.out + ((size_t)b * SEQ + (t - CTXL)) * D;
        f32x4 sacc[4]; ffn_sum(p, 1, r, lane, sacc);
#pragma unroll
        for (int i = 0; i < 4; ++i) { int c = i * 256 + lane * 4; *(f32x4*)(xr + c) = *(const f32x4*)(xr + c) + g2v[i] * sacc[i]; }
    }
}

constexpr int SMEM_BYTES = 75 * 1024;
__global__ void __launch_bounds__(NTHR, 2) k_prep(Params p) { SMEM_DECL; phase_prep(p, blockIdx.x, gridDim.x, smem); }
__global__ void __launch_bounds__(NTHR, 2) k_convert(Params p, int layer) { SMEM_DECL; phase_convert(p, layer, blockIdx.x, gridDim.x, smem); }
__global__ void __launch_bounds__(NTHR, 2) k_norm(Params p, int layer, int which, int clayer) { phase_norm(p, layer, which, blockIdx.x, gridDim.x, clayer); }
__global__ void __launch_bounds__(NTHR, 2) k_final(Params p) { phase_final(p, blockIdx.x, gridDim.x); }
__global__ void __launch_bounds__(NTHR, 2) k_proj(Params p, int layer) { SMEM_DECL; phase_proj(p, layer, blockIdx.x, gridDim.x, smem); }
__global__ void __launch_bounds__(NTHR, 2) k_scan(Params p, int layer) { SMEM_DECL; phase_scan(p, layer, blockIdx.x, gridDim.x, smem); }
__global__ void __launch_bounds__(NTHR, 2) k_mla(Params p, int layer) { SMEM_DECL; phase_mla(p, layer, blockIdx.x, gridDim.x, smem); }
__global__ void __launch_bounds__(NTHR, 2) k_attn(Params p, int layer) { SMEM_DECL; phase_attn(p, layer, blockIdx.x, gridDim.x, smem); }
__global__ void __launch_bounds__(NTHR, 2) k_merge(Params p, int layer) { phase_merge(p, layer, blockIdx.x, gridDim.x); }
__global__ void __launch_bounds__(NTHR, 2) k_outproj(Params p, int layer) { SMEM_DECL; phase_outproj(p, layer, blockIdx.x, gridDim.x, smem); }
__global__ void __launch_bounds__(NTHR, 2) k_router(Params p, int layer) { SMEM_DECL; phase_router(p, layer, blockIdx.x, gridDim.x, smem); }
__global__ void __launch_bounds__(NTHR, 2) k_topk(Params p, int layer) { SMEM_DECL; phase_topk(p, layer, blockIdx.x, gridDim.x, smem); }
__global__ void __launch_bounds__(NTHR, 2) k_gateup(Params p, int layer) { SMEM_DECL; phase_gateup(p, layer, blockIdx.x, gridDim.x, smem); }
__global__ void __launch_bounds__(NTHR, 2) k_down(Params p, int layer) { SMEM_DECL; phase_down(p, layer, blockIdx.x, gridDim.x, smem); }

#ifdef EMU
#define GRID_SYNC() emu::grid_sync()
#define GRID_SYNC_CG() emu::grid_sync()
#else
#define GRID_SYNC_CG() cooperative_groups::this_grid().sync()
#define XB_TMO      128
#define XB_XCNT(j)  (256  + 64 * (j))
#define XB_XSUB(j)  (1280 + 64 * (j))
#define XB_XGEN(j)  (2304 + 64 * (j))
#define XB_TOP      3328
#define XB_TOPGEN   3392
#define XCD_BAR_WORDS 3456
#define XB_SPIN_CAP (1u << 22)
DEV unsigned xb_ld(unsigned* p) { return __hip_atomic_load(p, __ATOMIC_RELAXED, __HIP_MEMORY_SCOPE_AGENT); }
DEV unsigned xb_add(unsigned* p, unsigned v) { return __hip_atomic_fetch_add(p, v, __ATOMIC_RELAXED, __HIP_MEMORY_SCOPE_AGENT); }
DEV unsigned xb_xcc_id() { return (unsigned)__builtin_amdgcn_s_getreg((3 << 11) | 20) & 0xFu; }
#define XB_SPIN(cond, bar) do { unsigned _sp = 0; while (cond) { __builtin_amdgcn_s_sleep(1); \
    if ((++_sp & 255u) == 0u) { if (xb_ld(&(bar)[XB_TMO])) break; if (_sp > XB_SPIN_CAP) { atomicAdd(&(bar)[XB_TMO], 1u); break; } } } } while (0)
struct XcdBarrier { unsigned* bar; unsigned x; volatile unsigned* st; };
DEV XcdBarrier xcd_barrier_post(unsigned* bar, volatile unsigned* st) {
    XcdBarrier b; b.bar = bar; b.x = xb_xcc_id(); b.st = st;
    if (threadIdx.x == 0) (void)xb_add(&bar[XB_XCNT(b.x)], 1u);
    return b;
}
DEV void xcd_barrier_complete(unsigned* bar, unsigned x, unsigned& nloc, unsigned& nx) {
    const unsigned G = gridDim.x;
    unsigned sum, cnt, mine, sp = 0u;
    for (;;) {
        sum = 0u; cnt = 0u; mine = 0u;
#pragma unroll
        for (unsigned j = 0; j < 16; ++j) { const unsigned c = xb_ld(&bar[XB_XCNT(j)]); sum += c; cnt += (c > 0u) ? 1u : 0u; mine = (j == x) ? c : mine; }
        if (sum == G) break;
        __builtin_amdgcn_s_sleep(1);
        if ((++sp & 255u) == 0u) { if (xb_ld(&bar[XB_TMO])) break; if (sp > XB_SPIN_CAP) { atomicAdd(&bar[XB_TMO], 1u); break; } }
    }
    nloc = mine > 0u ? mine : 1u; nx = cnt > 0u ? cnt : 1u;
}
DEV void xcd_barrier(const XcdBarrier& b) {
    asm volatile("s_waitcnt vmcnt(0)" ::: "memory");
    __syncthreads();
    if (threadIdx.x == 0) {
        unsigned* bar = b.bar;
        __builtin_amdgcn_s_waitcnt(0);
        unsigned nloc = b.st[0], nx = b.st[1];
        if (nloc == 0u) { xcd_barrier_complete(bar, b.x, nloc, nx); b.st[0] = nloc; b.st[1] = nx; }
        const unsigned old = xb_add(&bar[XB_XSUB(b.x)], 1u);
        const unsigned gen = old / nloc;
        if (old + 1u == (gen + 1u) * nloc) {
            __builtin_amdgcn_fence(__ATOMIC_RELEASE, "agent");
            asm volatile("s_waitcnt vmcnt(0)" ::: "memory");
            const unsigned og = xb_add(&bar[XB_TOP], 1u);
            const unsigned tg = og / nx;
            if (og + 1u == (tg + 1u) * nx) xb_add(&bar[XB_TOPGEN], 1u);
            else XB_SPIN(xb_ld(&bar[XB_TOPGEN]) == tg, bar);
            __builtin_amdgcn_fence(__ATOMIC_ACQUIRE, "agent");
            xb_add(&bar[XB_XGEN(b.x)], 1u);
            asm volatile("s_waitcnt vmcnt(0)" ::: "memory");
        } else {
            XB_SPIN(xb_ld(&bar[XB_XGEN(b.x)]) == gen, bar);
            __builtin_amdgcn_fence(__ATOMIC_ACQUIRE, "agent");
            asm volatile("s_waitcnt vmcnt(0)" ::: "memory");
        }
    }
    __syncthreads();
}
#define GRID_SYNC() xcd_barrier(xb)
#endif
DEV void phase_scan_mla(const Params& p, int layer, int bid, int nb, char* smem) {
    const int nchains = BATCH * 4 * 2 * 2;
    int nscan = nb / 2 < nchains ? nb / 2 : nchains; if (nscan < 1) nscan = 1;
    if (nb - nscan < 1) { phase_scan(p, layer, bid, nb, smem); phase_mla(p, layer, bid, nb, smem); return; }
    if (bid < nscan) phase_scan(p, layer, bid, nscan, smem); else phase_mla(p, layer, bid - nscan, nb - nscan, smem);
}
__global__ void __launch_bounds__(NTHR, 2) k_mega(Params p) {
    SMEM_DECL;
    const int bid = blockIdx.x, nb = gridDim.x;
#ifndef EMU
    volatile unsigned* xb_st = (volatile unsigned*)(smem + SMEM_BYTES - 16);
    if (threadIdx.x == 0) { xb_st[0] = 0u; xb_st[1] = 0u; }
    __syncthreads();
    XcdBarrier xb = xcd_barrier_post((unsigned*)(p.ws + OFF_BAR), xb_st);
#endif
    phase_prep(p, bid, nb, smem);
    if (PROBE == 30) { __syncthreads(); phase_prep(p, bid, nb, smem); __syncthreads(); phase_prep(p, bid, nb, smem); }
#pragma nounroll
    for (int l = 0; l < 2; ++l) {
        if (l == 0) { phase_convert(p, l, bid, nb, smem, 1); GRID_SYNC_CG(); }
        phase_norm(p, l, 0, bid, nb, l - 1);
        GRID_SYNC();
        if (PROBE == 1) { phase_convert(p, l, bid, nb, smem); phase_norm(p, l, 0, bid, nb); GRID_SYNC(); }
        phase_proj(p, l, bid, nb, smem);
        phase_convert(p, l, bid, nb, smem, 2, (unsigned*)(p.ws + OFF_QCTR) + 16 * l);
        GRID_SYNC();
        if (PROBE == 2) { phase_proj(p, l, bid, nb, smem); GRID_SYNC(); }
        {
            const int nchains = BATCH * 4 * 2 * 2;
            if (nb >= 2 * nchains) {
                if (bid < nchains) phase_scan(p, l, bid, nchains, smem); else phase_mla(p, l, bid - nchains, nb - nchains, smem);
                phase_convert(p, l, bid, nb, smem, 2, (unsigned*)(p.ws + OFF_QCTR) + 16 * l);
            } else {
                phase_scan(p, l, bid, nb, smem); phase_convert(p, l, bid, nb, smem, 2, (unsigned*)(p.ws + OFF_QCTR) + 16 * l);
                GRID_SYNC();
                phase_mla(p, l, bid, nb, smem);
            }
        }
        GRID_SYNC();
        if (PROBE == 3) { phase_scan(p, l, bid, nb, smem); GRID_SYNC(); }
        if (PROBE == 17) { const int nchains = BATCH * 4 * 2 * 2; if (bid < nchains) phase_scan(p, l, bid, nchains, smem); else phase_convert(p, l, bid - nchains, nb - nchains, smem, 2); GRID_SYNC(); }
        if (PROBE == 18) { const int nchains = BATCH * 4 * 2 * 2; if (bid >= nchains) phase_convert(p, l, bid - nchains, nb - nchains, smem, 2); GRID_SYNC(); }
        if (PROBE == 14) { phase_scan_probe<0>(p, l, bid, nb, smem); GRID_SYNC(); }
        if (PROBE == 15) { phase_scan_probe<1>(p, l, bid, nb, smem); GRID_SYNC(); }
        if (PROBE == 16) { phase_scan_probe<2>(p, l, bid, nb, smem); GRID_SYNC(); }
        if (PROBE == 8) { phase_mla(p, l, bid, nb, smem); GRID_SYNC(); }
        {
            if (blockIdx.x >= gridDim.x / 2) phase_merge(p, l, bid, nb);
            phase_attn(p, l, bid, nb, smem);
            if (blockIdx.x < gridDim.x / 2) phase_merge(p, l, bid, nb);
        }
        GRID_SYNC();
        if (PROBE == 4) { phase_attn(p, l, bid, nb, smem); GRID_SYNC(); }
        if (PROBE == 19) { phase_attn_probe<0>(p, l, bid, nb, smem); GRID_SYNC(); }
        if (PROBE == 20) { phase_attn_probe<1>(p, l, bid, nb, smem); GRID_SYNC(); }
        if (PROBE == 21) { phase_attn_probe<2>(p, l, bid, nb, smem); GRID_SYNC(); }
        phase_outproj(p, l, bid, nb, smem);
        GRID_SYNC();
        phase_norm(p, l, 1, bid, nb);
        GRID_SYNC();
        phase_router(p, l, bid, nb, smem);
        GRID_SYNC();
        phase_topk(p, l, bid, nb, smem);
        GRID_SYNC();
        if (PROBE == 5) { phase_norm(p, l, 1, bid, nb); GRID_SYNC(); phase_router(p, l, bid, nb, smem); GRID_SYNC(); phase_topk(p, l, bid, nb, smem); GRID_SYNC(); }
        phase_gateup(p, l, bid, nb, smem);
        GRID_SYNC();
        if (PROBE == 6) { phase_gateup(p, l, bid, nb, smem); GRID_SYNC(); }
        if (PROBE == 11) { phase_gateup_probe<1>(p, l, bid, nb, smem); GRID_SYNC(); }
        if (PROBE == 12) { phase_gateup_probe<2>(p, l, bid, nb, smem); GRID_SYNC(); }
        if (PROBE == 13) { phase_gateup_probe<0>(p, l, bid, nb, smem); GRID_SYNC(); }
        if (PROBE == 7) { for (int q = 0; q < 10; ++q) GRID_SYNC(); }
        phase_down(p, l, bid, nb, smem);
        if (l == 0) phase_convert(p, 1, bid, nb, smem, 1, (unsigned*)(p.ws + OFF_QCTR) + 32);
        GRID_SYNC();
        if (PROBE == 10) { phase_down(p, l, bid, nb, smem); GRID_SYNC(); }
    }
    phase_final(p, bid, nb);
}

#ifdef EMU
void emu_dump(const char* name, const void* ptr, size_t bytes);
#define DUMP(name, off, bytes) emu_dump(name, p.ws + (off), bytes)
#else
#define DUMP(name, off, bytes)
#endif

extern "C" void kernel_launch(void* const* d_in, const int* in_sizes, int n_in, void* d_out, int out_size, void* d_ws, size_t ws_size, hipStream_t stream) {
    Params p{};
    const float** f = (const float**)&p;
    for (int i = 0; i < 26; ++i) f[i] = (const float*)d_in[i];
    p.out = (float*)d_out; p.ws = (char*)d_ws;
    if (ws_size < WS_TOTAL) { fprintf(stderr, "workspace too small: %zu < %zu\n", ws_size, (size_t)WS_TOTAL); return; }
#ifdef EMU
    if (getenv("EMU_MEGA")) { memset(p.ws + OFF_BAR, 0, 16384 + 256); emu::launch(dim3(getenv("EMU_NB") ? atoi(getenv("EMU_NB")) : 16), dim3(NTHR), SMEM_BYTES, true, [=]() { k_mega(p); }); return; }
#endif
#if !defined(MULTI_LAUNCH) && !defined(EMU)
    static int grid_blocks = 0;
    if (!grid_blocks) {
        int dev = 0, cus = 0, per_cu = 0;
        (void)hipGetDevice(&dev);
        (void)hipDeviceGetAttribute(&cus, hipDeviceAttributeMultiprocessorCount, dev);
        (void)hipFuncSetAttribute((const void*)k_mega, hipFuncAttributeMaxDynamicSharedMemorySize, SMEM_BYTES);
        (void)hipOccupancyMaxActiveBlocksPerMultiprocessor(&per_cu, k_mega, NTHR, SMEM_BYTES);
        if (per_cu > 2) per_cu = 2;
        if (per_cu < 1) per_cu = 1;
        grid_blocks = cus * per_cu;
    }
    (void)hipMemsetAsync(p.ws + OFF_BAR, 0, 16384 + 256, stream);
    void* args[] = {(void*)&p};
    hipError_t e = hipLaunchCooperativeKernel((const void*)k_mega, dim3(grid_blocks), dim3(NTHR), args, SMEM_BYTES, stream);
    if (e != hipSuccess) fprintf(stderr, "cooperative launch failed: %s (grid %d)\n", hipGetErrorString(e), grid_blocks);
#else
    const int G = 512;
#ifndef EMU
    static bool attr_done = false;
    if (!attr_done) {
        attr_done = true;
        const void* ks[] = {(const void*)k_prep, (const void*)k_convert, (const void*)k_proj, (const void*)k_scan, (const void*)k_mla, (const void*)k_attn,
                            (const void*)k_outproj, (const void*)k_router, (const void*)k_topk, (const void*)k_gateup, (const void*)k_down};
        for (const void* k : ks) (void)hipFuncSetAttribute(k, hipFuncAttributeMaxDynamicSharedMemorySize, SMEM_BYTES);
    }
#endif
    LAUNCH(k_prep, 384, SMEM_BYTES, stream, p);
    for (int l = 0; l < 2; ++l) {
        char nm[64];
        LAUNCH(k_convert, G * 2, SMEM_BYTES, stream, p, l);
        LAUNCH(k_norm, G * 2, 0, stream, p, l, 0, l - 1);
        snprintf(nm, 64, "L%d_h", l); DUMP(nm, OFF_H, (size_t)R * 1024 * 2);
        LAUNCH(k_proj, G * 2, SMEM_BYTES, stream, p, l);
        snprintf(nm, 64, "L%d_projb", l); DUMP(nm, OFF_PB, (size_t)R * PBW * 2);
        snprintf(nm, 64, "L%d_pref", l); DUMP(nm, OFF_PF, (size_t)R * 512 * 4);
        snprintf(nm, 64, "L%d_gates", l); DUMP(nm, OFF_GT, (size_t)R * 16 * 4);
        LAUNCH(k_scan, BATCH * 16, SMEM_BYTES, stream, p, l);
        snprintf(nm, 64, "L%d_scan", l); DUMP(nm, OFF_H, (size_t)4 * R * 256 * 2);
        LAUNCH(k_mla, G * 2, SMEM_BYTES, stream, p, l);
        snprintf(nm, 64, "L%d_qkv", l); DUMP(nm, OFF_QKV, 2 * SZ_Q + SZ_V);
        LAUNCH(k_attn, G * 2, SMEM_BYTES, stream, p, l);
        LAUNCH(k_merge, G * 2, 0, stream, p, l);
        snprintf(nm, 64, "L%d_y", l); DUMP(nm, OFF_PF, (size_t)R * 1024 * 2);
        LAUNCH(k_outproj, G * 2, SMEM_BYTES, stream, p, l);
        LAUNCH(k_norm, G * 2, 0, stream, p, l, 1, -1);
        snprintf(nm, 64, "L%d_h2", l); DUMP(nm, OFF_H, (size_t)R * 1024 * 2);
        LAUNCH(k_router, G, SMEM_BYTES, stream, p, l);
        snprintf(nm, 64, "L%d_aff", l); DUMP(nm, OFF_AFF, (size_t)R * 16 * 4);
        LAUNCH(k_topk, BATCH * NEXP * 2, SMEM_BYTES, stream, p, l);
        LAUNCH(k_gateup, G * 2, SMEM_BYTES, stream, p, l);
        LAUNCH(k_down, G * 2, SMEM_BYTES, stream, p, l);
    }
    LAUNCH(k_final, G * 2, 0, stream, p);
#endif
}
```
